# Optimizing an MI355X kernel written in HIP

```python
import math
import jax, jax.numpy as jnp
from jax import lax
import numpy as np

D_MODEL = 2048
BATCH = 2
SEQ = 4096
DEPTH = 1

BRANCH_W = D_MODEL // 2
HEAD_DIM = 128
N_HEADS_A = BRANCH_W // HEAD_DIM
DH_A = HEAD_DIM // 2
DV_A = HEAD_DIM
N_HEADS_B = BRANCH_W // HEAD_DIM
N_KV_B = N_HEADS_B // 4
GROUP_B = N_HEADS_B // N_KV_B
DH_B = HEAD_DIM
ROPE_THETA = 10000.0
GRID_W = 64
Q_BLOCK = 128
EPS = 1e-6

COL_SIZES = (
    N_HEADS_A * 2 * DH_A,
    N_HEADS_A * 2 * DH_A,
    N_HEADS_A * DV_A,
    BRANCH_W,
    N_HEADS_B * DH_B,
    N_KV_B * DH_B,
    N_KV_B * DH_B,
    BRANCH_W,
    D_MODEL,
    D_MODEL,
)
COL_TOTAL = int(sum(COL_SIZES))
SPLIT_POINTS = tuple(int(c) for c in np.cumsum(COL_SIZES)[:-1])

kernel_name = "hybrid_gated_diffattn_axialgqa_block"


def rmsnorm(x, g):
    xf = x.astype(jnp.float32)
    y = xf * lax.rsqrt(jnp.mean(xf * xf, axis=-1, keepdims=True) + EPS)
    return (y * g.astype(jnp.float32)).astype(x.dtype)


def rope_angles(pos, dim):
    inv = 1.0 / (ROPE_THETA ** (jnp.arange(0, dim, 2, dtype=jnp.float32) / dim))
    return pos.astype(jnp.float32)[:, None] * inv[None, :]


def apply_rope(x, ang):
    cos = jnp.cos(ang)[None, :, None, :]
    sin = jnp.sin(ang)[None, :, None, :]
    xf = x.astype(jnp.float32)
    x1, x2 = jnp.split(xf, 2, axis=-1)
    return jnp.concatenate([x1 * cos - x2 * sin, x2 * cos + x1 * sin], axis=-1).astype(x.dtype)


def to_blocks(t):
    s, d = t.shape[-2], t.shape[-1]
    t = t.reshape(t.shape[:-2] + (s // Q_BLOCK, Q_BLOCK, d))
    return jnp.moveaxis(t, -3, 0)


def from_blocks(t):
    t = jnp.moveaxis(t, 0, -3)
    return t.reshape(t.shape[:-3] + (t.shape[-3] * Q_BLOCK, t.shape[-1]))


def diff_attention(q1, q2, k1, k2, v, lam):
    scale = DH_A ** -0.5

    def block(args):
        q1b, q2b = args
        s1 = jnp.einsum('bhqd,bhkd->bhqk', q1b, k1, preferred_element_type=jnp.float32) * scale
        s2 = jnp.einsum('bhqd,bhkd->bhqk', q2b, k2, preferred_element_type=jnp.float32) * scale
        p = jax.nn.softmax(s1, axis=-1) - lam * jax.nn.softmax(s2, axis=-1)
        return jnp.einsum('bhqk,bhkd->bhqd', p.astype(v.dtype), v)

    o = lax.map(block, (to_blocks(q1), to_blocks(q2)))
    return from_blocks(o)


def gqa_attention(q, k, v):
    scale = DH_B ** -0.5

    def block(qb):
        s = jnp.einsum('bkgqd,bksd->bkgqs', qb, k, preferred_element_type=jnp.float32) * scale
        p = jax.nn.softmax(s, axis=-1)
        return jnp.einsum('bkgqs,bksd->bkgqd', p.astype(v.dtype), v)

    o = lax.map(block, to_blocks(q))
    return from_blocks(o)


def setup_inputs(seed: int = 0) -> dict:
    key = jax.random.key(seed)
    ks = jax.random.split(key, 16)
    f32 = jnp.float32
    x = jax.random.normal(ks[0], (BATCH, SEQ, D_MODEL), f32)
    norm_g = 1.0 + 0.01 * jax.random.normal(ks[1], (DEPTH, D_MODEL), f32)
    w_in = jax.random.normal(ks[2], (DEPTH, D_MODEL, COL_TOTAL), f32) * D_MODEL ** -0.5
    lambda_q1 = 0.1 * jax.random.normal(ks[3], (DEPTH, DH_A), f32)
    lambda_k1 = 0.1 * jax.random.normal(ks[4], (DEPTH, DH_A), f32)
    lambda_q2 = 0.1 * jax.random.normal(ks[5], (DEPTH, DH_A), f32)
    lambda_k2 = 0.1 * jax.random.normal(ks[6], (DEPTH, DH_A), f32)
    subln_g = 1.0 + 0.01 * jax.random.normal(ks[7], (DEPTH, DV_A), f32)
    q_norm_g = 1.0 + 0.01 * jax.random.normal(ks[8], (DEPTH, DH_B), f32)
    k_norm_g = 1.0 + 0.01 * jax.random.normal(ks[9], (DEPTH, DH_B), f32)
    w_out_a = jax.random.normal(ks[10], (DEPTH, BRANCH_W, D_MODEL), f32) * BRANCH_W ** -0.5
    w_out_b = jax.random.normal(ks[11], (DEPTH, BRANCH_W, D_MODEL), f32) * BRANCH_W ** -0.5
    w_o = jax.random.normal(ks[12], (DEPTH, D_MODEL, D_MODEL), f32) * D_MODEL ** -0.5
    final_g = 1.0 + 0.01 * jax.random.normal(ks[13], (D_MODEL,), f32)
    return {"x": x, "norm_g": norm_g, "w_in": w_in,
            "lambda_q1": lambda_q1, "lambda_k1": lambda_k1,
            "lambda_q2": lambda_q2, "lambda_k2": lambda_k2,
            "subln_g": subln_g, "q_norm_g": q_norm_g, "k_norm_g": k_norm_g,
            "w_out_a": w_out_a, "w_out_b": w_out_b, "w_o": w_o, "final_g": final_g}


def reference(x, norm_g, w_in, lambda_q1, lambda_k1, lambda_q2, lambda_k2,
              subln_g, q_norm_g, k_norm_g, w_out_a, w_out_b, w_o, final_g):
    B, S, _ = x.shape
    rows = S // GRID_W
    ang_1d = rope_angles(jnp.arange(S), DH_A)
    pos_row = jnp.repeat(jnp.arange(rows), GRID_W)
    pos_col = jnp.tile(jnp.arange(GRID_W), rows)
    ang_row = rope_angles(pos_row, DH_B // 2)
    ang_col = rope_angles(pos_col, DH_B // 2)

    def axial_rope(t):
        half = DH_B // 2
        return jnp.concatenate([apply_rope(t[..., :half], ang_row),
                                apply_rope(t[..., half:], ang_col)], axis=-1)

    for l in range(DEPTH):
        lam_init = 0.8 - 0.6 * math.exp(-0.3 * l)
        h = rmsnorm(x, norm_g[l])
        proj = jnp.einsum('bsd,dc->bsc', h, w_in[l])
        qa, ka, va, za, qb, kb, vb, zb, ga, gb = jnp.split(proj, SPLIT_POINTS, axis=-1)

        qa = apply_rope(qa.reshape(B, S, 2 * N_HEADS_A, DH_A), ang_1d)
        ka = apply_rope(ka.reshape(B, S, 2 * N_HEADS_A, DH_A), ang_1d)
        qa = qa.reshape(B, S, N_HEADS_A, 2, DH_A).transpose(3, 0, 2, 1, 4)
        ka = ka.reshape(B, S, N_HEADS_A, 2, DH_A).transpose(3, 0, 2, 1, 4)
        va = va.reshape(B, S, N_HEADS_A, DV_A).transpose(0, 2, 1, 3)
        lam = (jnp.exp(jnp.sum(lambda_q1[l].astype(jnp.float32) * lambda_k1[l].astype(jnp.float32)))
               - jnp.exp(jnp.sum(lambda_q2[l].astype(jnp.float32) * lambda_k2[l].astype(jnp.float32)))
               + lam_init)
        oa = diff_attention(qa[0], qa[1], ka[0], ka[1], va, lam)
        oa = rmsnorm(oa, subln_g[l]) * (1.0 - lam_init)
        oa = oa.transpose(0, 2, 1, 3).reshape(B, S, BRANCH_W)
        ya = jnp.einsum('bsc,cd->bsd', oa * jax.nn.silu(za), w_out_a[l])

        qb = axial_rope(rmsnorm(qb.reshape(B, S, N_HEADS_B, DH_B), q_norm_g[l]))
        kb = axial_rope(rmsnorm(kb.reshape(B, S, N_KV_B, DH_B), k_norm_g[l]))
        vb = vb.reshape(B, S, N_KV_B, DH_B)
        qb = qb.reshape(B, S, N_KV_B, GROUP_B, DH_B).transpose(0, 2, 3, 1, 4)
        kb = kb.transpose(0, 2, 1, 3)
        vb = vb.transpose(0, 2, 1, 3)
        ob = gqa_attention(qb, kb, vb)
        ob = ob.transpose(0, 3, 1, 2, 4).reshape(B, S, BRANCH_W)
        yb = jnp.einsum('bsc,cd->bsd', ob * jax.nn.silu(zb), w_out_b[l])

        merged = jax.nn.sigmoid(ga) * ya + jax.nn.sigmoid(gb) * yb
        x = x + jnp.einsum('bsd,de->bse', merged, w_o[l])

    return rmsnorm(x, final_g)
```

```cpp
#include <hip/hip_runtime.h>
#include <hip/hip_cooperative_groups.h>
#include <cstdio>
#include <cstdint>
namespace cg = cooperative_groups;

#ifndef MK_LAUNCHES
#define MK_LAUNCHES 6
#endif

typedef unsigned short bf16_t;
using bf16x8 = __attribute__((ext_vector_type(8))) short;
using s16x4  = __attribute__((ext_vector_type(4))) short;
using f32x16 = __attribute__((ext_vector_type(16))) float;
using f32x4  = __attribute__((ext_vector_type(4))) float;
using u32x4  = __attribute__((ext_vector_type(4))) unsigned;
using u32x2  = __attribute__((ext_vector_type(2))) unsigned;

constexpr int MTOK = 8192, SEQ = 4096, DM = 2048, CT = 10752, BW = 1024;
constexpr int C_QA = 0, C_KA = 1024, C_VA = 2048, C_ZA = 3072, C_QB = 4096, C_KB = 5120, C_VB = 5376, C_ZB = 5632, C_GA = 6656, C_GB = 8704;
constexpr float EPS = 1e-6f;
constexpr int LDS_BYTES = 131072;

struct Params {
  const float *x, *norm_g, *w_in, *lq1, *lk1, *lq2, *lk2, *subln_g, *qn_g, *kn_g, *w_out_a, *w_out_b, *w_o, *final_g;
  float* out;
  bf16_t *h, *winT, *waT, *wbT, *woT, *proj, *U, *merged;
  float* o1;
  float2* rope;
  int phase_lo, phase_hi;
};

#define SBAR() __builtin_amdgcn_sched_barrier(0)
__device__ __forceinline__ int crow(int r, int hi) { return (r & 3) + 8 * (r >> 2) + 4 * hi; }
__device__ __forceinline__ unsigned cvtpk(float lo, float hi) {
  unsigned r; asm volatile("v_cvt_pk_bf16_f32 %0, %1, %2" : "=v"(r) : "v"(lo), "v"(hi)); return r;
}
__device__ __forceinline__ float bf2f(bf16_t v) { return __uint_as_float(((unsigned)v) << 16); }
__device__ __forceinline__ bf16_t f2bf(float f) { return (bf16_t)(cvtpk(f, f) & 0xffffu); }
__device__ __forceinline__ float sigmoidf_(float v) { return 1.f / (1.f + __expf(-v)); }

__device__ __forceinline__ void transpose_cvt_tile(const float* __restrict__ W, bf16_t* __restrict__ Wt, int K, int N, int tile, float* tl) {
  const int tid = threadIdx.x;
  const int ntn = N >> 6;
  const int n0 = (tile % ntn) * 64, k0 = (tile / ntn) * 64;
  const int r = tid >> 4, c4 = (tid & 15) * 4;
#pragma unroll
  for (int j = 0; j < 2; ++j) {
    const f32x4 v = *(const f32x4*)(W + (size_t)(k0 + r + 32 * j) * N + n0 + c4);
    float* d = tl + (r + 32 * j) * 65 + c4;
    d[0] = v[0]; d[1] = v[1]; d[2] = v[2]; d[3] = v[3];
  }
  __syncthreads();
  const int n = tid >> 3, kc = (tid & 7) * 8;
  u32x4 w;
  w[0] = cvtpk(tl[(kc + 0) * 65 + n], tl[(kc + 1) * 65 + n]);
  w[1] = cvtpk(tl[(kc + 2) * 65 + n], tl[(kc + 3) * 65 + n]);
  w[2] = cvtpk(tl[(kc + 4) * 65 + n], tl[(kc + 5) * 65 + n]);
  w[3] = cvtpk(tl[(kc + 6) * 65 + n], tl[(kc + 7) * 65 + n]);
  *(u32x4*)(Wt + (size_t)(n0 + n) * K + k0 + kc) = w;
  __syncthreads();
}

__device__ __forceinline__ void phase_prologue(const Params& p, char* lds) {
  const int tid = threadIdx.x, wid = tid >> 6, lane = tid & 63;
  for (int i = blockIdx.x * 512 + tid; i < SEQ * 32; i += gridDim.x * 512) {
    const int pos = i >> 5, f = i & 31;
    const float inv = 1.0f / exp2f((float)f * (13.287712379549449f / 32.0f));
    const float ang = (float)pos * inv;
    const double rev = (double)ang * 0.15915494309189535;
    const float fr = (float)(rev - rint(rev));
    float2 cs; cs.x = __builtin_amdgcn_cosf(fr); cs.y = __builtin_amdgcn_sinf(fr);
    p.rope[i] = cs;
  }
  for (int row = blockIdx.x * 8 + wid; row < MTOK; row += gridDim.x * 8) {
    const float* xr = p.x + (size_t)row * DM;
    f32x4 v[8]; float ss = 0.f;
#pragma unroll
    for (int j = 0; j < 8; ++j) { v[j] = *(const f32x4*)(xr + j * 256 + lane * 4); ss += v[j][0] * v[j][0] + v[j][1] * v[j][1] + v[j][2] * v[j][2] + v[j][3] * v[j][3]; }
#pragma unroll
    for (int m = 1; m < 64; m <<= 1) ss += __shfl_xor(ss, m);
    const float rinv = rsqrtf(ss * (1.0f / DM) + EPS);
    bf16_t* hr = p.h + (size_t)row * DM;
#pragma unroll
    for (int j = 0; j < 8; ++j) {
      const f32x4 g = *(const f32x4*)(p.norm_g + j * 256 + lane * 4);
      u32x2 w; w[0] = cvtpk(v[j][0] * rinv * g[0], v[j][1] * rinv * g[1]); w[1] = cvtpk(v[j][2] * rinv * g[2], v[j][3] * rinv * g[3]);
      *(u32x2*)(hr + j * 256 + lane * 4) = w;
    }
  }
  float* tl = (float*)lds;
  constexpr int T_IN = (DM / 64) * (CT / 64), T_OA = (BW / 64) * (DM / 64), T_WO = (DM / 64) * (DM / 64);
  for (int t = blockIdx.x; t < T_IN + 2 * T_OA + T_WO; t += gridDim.x) {
    if (t < T_IN) transpose_cvt_tile(p.w_in, p.winT, DM, CT, t, tl);
    else if (t < T_IN + T_OA) transpose_cvt_tile(p.w_out_a, p.waT, BW, DM, t - T_IN, tl);
    else if (t < T_IN + 2 * T_OA) transpose_cvt_tile(p.w_out_b, p.wbT, BW, DM, t - T_IN - T_OA, tl);
    else transpose_cvt_tile(p.w_o, p.woT, DM, DM, t - T_IN - 2 * T_OA, tl);
  }
}

template <int NI>
__device__ __forceinline__ void gemm_mainloop(const bf16_t* __restrict__ A, int lda, const bf16_t* __restrict__ Bt, int ldb, int K,
                                              f32x16 (&acc)[2][NI], char* lds) {
  constexpr int BN = NI * 64;
  constexpr int A_BYTES = 256 * 128, B_BYTES = BN * 128;
  char* As = lds; char* Bs = lds + 2 * A_BYTES;
  const int tid = threadIdx.x, wid = tid >> 6, lane = tid & 63, r32 = lane & 31, hi = lane >> 5, wm = wid >> 1, wn = wid & 1;
  const int srow = tid >> 3, sch = tid & 7;
  const int soff = srow * 128 + ((sch ^ ((srow >> 1) & 7)) << 4);
  const unsigned goA = (unsigned)(srow * lda + sch * 8) * 2u, goB = (unsigned)(srow * ldb + sch * 8) * 2u;
  const char* Ab0 = (const char*)A; const char* Bb0 = (const char*)Bt;
  bf16x8 ra[4], rb[NI];
  const int sw = (r32 >> 1) & 7;
  const int aoff = (wm * 64 + r32) * 128, boff = (wn * (BN / 2) + r32) * 128;
  const int nt = K >> 6;
#pragma unroll
  for (int i = 0; i < 4; ++i) ra[i] = *(const bf16x8*)(Ab0 + (size_t)(64 * i) * lda * 2 + goA);
#pragma unroll
  for (int i = 0; i < NI; ++i) rb[i] = *(const bf16x8*)(Bb0 + (size_t)(64 * i) * ldb * 2 + goB);
#pragma unroll
  for (int i = 0; i < 4; ++i) *(bf16x8*)(As + soff + i * 8192) = ra[i];
#pragma unroll
  for (int i = 0; i < NI; ++i) *(bf16x8*)(Bs + soff + i * 8192) = rb[i];
  __syncthreads();
  for (int kt = 0; kt < nt; ++kt) {
    const int buf = kt & 1;
    if (kt + 1 < nt) {
      const char* An = Ab0 + (size_t)(kt + 1) * 128; const char* Bn = Bb0 + (size_t)(kt + 1) * 128;
#pragma unroll
      for (int i = 0; i < 4; ++i) ra[i] = *(const bf16x8*)(An + (size_t)(64 * i) * lda * 2 + goA);
#pragma unroll
      for (int i = 0; i < NI; ++i) rb[i] = *(const bf16x8*)(Bn + (size_t)(64 * i) * ldb * 2 + goB);
    }
    const char* Ab = As + buf * A_BYTES + aoff; const char* Bb = Bs + buf * B_BYTES + boff;
#pragma unroll
    for (int kk = 0; kk < 4; ++kk) {
      const int co = ((kk * 2 + hi) ^ sw) << 4;
      bf16x8 af[2], bfr[NI];
#pragma unroll
      for (int mi = 0; mi < 2; ++mi) af[mi] = *(const bf16x8*)(Ab + mi * 4096 + co);
#pragma unroll
      for (int ni = 0; ni < NI; ++ni) bfr[ni] = *(const bf16x8*)(Bb + ni * 4096 + co);
#pragma unroll
      for (int mi = 0; mi < 2; ++mi)
#pragma unroll
        for (int ni = 0; ni < NI; ++ni) acc[mi][ni] = __builtin_amdgcn_mfma_f32_32x32x16_bf16(af[mi], bfr[ni], acc[mi][ni], 0, 0, 0);
    }
    if (kt + 1 < nt) {
#pragma unroll
      for (int i = 0; i < 4; ++i) *(bf16x8*)(As + (buf ^ 1) * A_BYTES + soff + i * 8192) = ra[i];
#pragma unroll
      for (int i = 0; i < NI; ++i) *(bf16x8*)(Bs + (buf ^ 1) * B_BYTES + soff + i * 8192) = rb[i];
    }
    __syncthreads();
  }
}

__device__ __forceinline__ int launder(int x) { asm volatile("" : "+v"(x)); return x; }

template <int TYPE>
__device__ __forceinline__ void epi1(const Params& p, const f32x16 (&acc)[2][4], int rowb, int col0, int r32, int hi, const float* g) {
  float gv[4] = {1.f, 1.f, 1.f, 1.f};
  if (TYPE == 1) {
#pragma unroll
    for (int ni = 0; ni < 4; ++ni) gv[ni] = g[ni * 32 + r32];
  }
  const unsigned cofs = (unsigned)(col0 + r32);
#pragma unroll
  for (int mi = 0; mi < 2; ++mi)
#pragma unroll
    for (int r = 0; r < 16; ++r) {
      const int row = rowb + mi * 32 + crow(r, hi);
      const int s = row & (SEQ - 1);
      float v[4];
#pragma unroll
      for (int ni = 0; ni < 4; ++ni) v[ni] = acc[mi][ni][r];
      if (TYPE == 0) {
        const float2 cs = p.rope[s * 32 + r32];
        const float a0 = v[0] * cs.x - v[1] * cs.y, a1 = v[1] * cs.x + v[0] * cs.y;
        const float a2 = v[2] * cs.x - v[3] * cs.y, a3 = v[3] * cs.x + v[2] * cs.y;
        v[0] = a0; v[1] = a1; v[2] = a2; v[3] = a3;
      } else if (TYPE == 1) {
        const float2 c0 = p.rope[(s >> 6) * 32 + r32], c1 = p.rope[(s & 63) * 32 + r32];
        float ss = v[0] * v[0] + v[1] * v[1] + v[2] * v[2] + v[3] * v[3];
#pragma unroll
        for (int m = 1; m < 32; m <<= 1) ss += __shfl_xor(ss, m);
        const float rinv = rsqrtf(ss * (1.0f / 128.0f) + EPS);
#pragma unroll
        for (int ni = 0; ni < 4; ++ni) v[ni] = v[ni] * rinv * gv[ni];
        const float a0 = v[0] * c0.x - v[1] * c0.y, a1 = v[1] * c0.x + v[0] * c0.y;
        const float a2 = v[2] * c1.x - v[3] * c1.y, a3 = v[3] * c1.x + v[2] * c1.y;
        v[0] = a0; v[1] = a1; v[2] = a2; v[3] = a3;
      } else if (TYPE == 2) {
#pragma unroll
        for (int ni = 0; ni < 4; ++ni) v[ni] = v[ni] * sigmoidf_(v[ni]);
      } else if (TYPE == 3) {
#pragma unroll
        for (int ni = 0; ni < 4; ++ni) v[ni] = sigmoidf_(v[ni]);
      }
      bf16_t* dst = p.proj + (size_t)row * CT + cofs;
#pragma unroll
      for (int ni = 0; ni < 4; ++ni) dst[ni * 32] = f2bf(v[ni]);
      if ((r & 3) == 3) asm volatile("" ::: "memory");
    }
}

__device__ __forceinline__ void phase_gemm1(const Params& p, char* lds) {
  const int tid = threadIdx.x, wid = tid >> 6, lane = tid & 63, wm = wid >> 1, wn = wid & 1;
  constexpr int NT = (MTOK / 256) * (CT / 256);
  for (int t = blockIdx.x; t < NT; t += gridDim.x) {
    const int pm = t & 31, pn = t >> 5;
    f32x16 acc[2][4];
#pragma unroll
    for (int mi = 0; mi < 2; ++mi)
#pragma unroll
      for (int ni = 0; ni < 4; ++ni) acc[mi][ni] = f32x16{};
    gemm_mainloop<4>(p.h + (size_t)pm * 256 * DM, DM, p.winT + (size_t)pn * 256 * DM, DM, DM, acc, lds);
    const int l2 = launder(lane), r32 = l2 & 31, hi = l2 >> 5;
    const int col0 = pn * 256 + wn * 128;
    const int rowb = pm * 256 + wm * 64;
    if (col0 < C_VA) epi1<0>(p, acc, rowb, col0, r32, hi, nullptr);
    else if (col0 >= C_QB && col0 < C_KB) epi1<1>(p, acc, rowb, col0, r32, hi, p.qn_g);
    else if (col0 >= C_KB && col0 < C_VB) epi1<1>(p, acc, rowb, col0, r32, hi, p.kn_g);
    else if ((col0 >= C_ZA && col0 < C_QB) || (col0 >= C_ZB && col0 < C_GA)) epi1<2>(p, acc, rowb, col0, r32, hi, nullptr);
    else if (col0 >= C_GA) epi1<3>(p, acc, rowb, col0, r32, hi, nullptr);
    else epi1<4>(p, acc, rowb, col0, r32, hi, nullptr);
  }
}

__device__ __forceinline__ void phase_gemm2(const Params& p, char* lds) {
  const int tid = threadIdx.x, wid = tid >> 6, lane = tid & 63, wm = wid >> 1, wn = wid & 1;
  constexpr int NT = (MTOK / 256) * (DM / 128);
  for (int t = blockIdx.x; t < NT; t += gridDim.x) {
    const int pm = t & 31, pn = t >> 5;
    f32x16 accA[2][2], accB[2][2];
#pragma unroll
    for (int mi = 0; mi < 2; ++mi)
#pragma unroll
      for (int ni = 0; ni < 2; ++ni) { accA[mi][ni] = f32x16{}; accB[mi][ni] = f32x16{}; }
    gemm_mainloop<2>(p.U + (size_t)pm * 256 * DM, DM, p.waT + (size_t)pn * 128 * BW, BW, BW, accA, lds);
    gemm_mainloop<2>(p.U + (size_t)pm * 256 * DM + BW, DM, p.wbT + (size_t)pn * 128 * BW, BW, BW, accB, lds);
    const int l2 = launder(lane), r32 = l2 & 31, hi = l2 >> 5;
    const int col0 = pn * 128 + wn * 64 + r32;
    const int rowb = pm * 256 + wm * 64;
#pragma unroll
    for (int mi = 0; mi < 2; ++mi)
#pragma unroll
      for (int r = 0; r < 16; ++r) {
        const size_t row = (size_t)(rowb + mi * 32 + crow(r, hi));
        const bf16_t* gp = p.proj + row * CT + col0;
        bf16_t* dst = p.merged + row * DM + col0;
#pragma unroll
        for (int ni = 0; ni < 2; ++ni) {
          const float sa = bf2f(gp[C_GA + ni * 32]), sb = bf2f(gp[C_GB + ni * 32]);
          dst[ni * 32] = f2bf(sa * accA[mi][ni][r] + sb * accB[mi][ni][r]);
        }
        if ((r & 1) == 1) asm volatile("" ::: "memory");
      }
  }
}

__device__ __forceinline__ void phase_gemm3(const Params& p, char* lds) {
  const int tid = threadIdx.x, wid = tid >> 6, lane = tid & 63, wm = wid >> 1, wn = wid & 1;
  constexpr int NT = (MTOK / 256) * (DM / 256);
  for (int t = blockIdx.x; t < NT; t += gridDim.x) {
    const int pm = t & 31, pn = t >> 5;
    f32x16 acc[2][4];
#pragma unroll
    for (int mi = 0; mi < 2; ++mi)
#pragma unroll
      for (int ni = 0; ni < 4; ++ni) acc[mi][ni] = f32x16{};
    gemm_mainloop<4>(p.merged + (size_t)pm * 256 * DM, DM, p.woT + (size_t)pn * 256 * DM, DM, DM, acc, lds);
    const int l2 = launder(lane), r32 = l2 & 31, hi = l2 >> 5;
    const int col0 = pn * 256 + wn * 128 + r32;
    const int rowb = pm * 256 + wm * 64;
#pragma unroll
    for (int mi = 0; mi < 2; ++mi)
#pragma unroll
      for (int r = 0; r < 16; ++r) {
        const size_t off = (size_t)(rowb + mi * 32 + crow(r, hi)) * DM + col0;
#pragma unroll
        for (int ni = 0; ni < 4; ++ni) p.out[off + ni * 32] = p.x[off + ni * 32] + acc[mi][ni][r];
        if ((r & 3) == 3) asm volatile("" ::: "memory");
      }
  }
}

__device__ __forceinline__ void phase_final(const Params& p) {
  const int tid = threadIdx.x, wid = tid >> 6, lane = tid & 63;
  for (int row = blockIdx.x * 8 + wid; row < MTOK; row += gridDim.x * 8) {
    float* xr = p.out + (size_t)row * DM;
    f32x4 v[8]; float ss = 0.f;
#pragma unroll
    for (int j = 0; j < 8; ++j) { v[j] = *(const f32x4*)(xr + j * 256 + lane * 4); ss += v[j][0] * v[j][0] + v[j][1] * v[j][1] + v[j][2] * v[j][2] + v[j][3] * v[j][3]; }
#pragma unroll
    for (int m = 1; m < 64; m <<= 1) ss += __shfl_xor(ss, m);
    const float rinv = rsqrtf(ss * (1.0f / DM) + EPS);
#pragma unroll
    for (int j = 0; j < 8; ++j) {
      const f32x4 g = *(const f32x4*)(p.final_g + j * 256 + lane * 4);
      f32x4 o; o[0] = v[j][0] * rinv * g[0]; o[1] = v[j][1] * rinv * g[1]; o[2] = v[j][2] * rinv * g[2]; o[3] = v[j][3] * rinv * g[3];
      *(f32x4*)(xr + j * 256 + lane * 4) = o;
    }
  }
}

constexpr int KVBLK = 64;
constexpr size_t SHM_V = KVBLK * 128 * 2, SHM_K = KVBLK * 128 * 2;
constexpr float THR = 8.f;
#define KSWZ(row, colB) ((row) * 256 + ((colB) ^ (((row) & 7) << 4)))

template <int DQK> struct AttnC { static constexpr float SCALE = (DQK == 64) ? 0.125f : 0.088388347648318440f; };

template <int DQK>
__device__ __forceinline__ void partialSM(f32x16& p0, f32x16& p1, float& m_reg, float& mn, float& alpha) {
  constexpr float SCALE = AttnC<DQK>::SCALE;
  constexpr float C = SCALE * 1.4426950408889634f;
  float pmax = p0[0];
#pragma unroll
  for (int r = 1; r < 16; ++r) pmax = fmaxf(pmax, p0[r]);
#pragma unroll
  for (int r = 0; r < 16; ++r) pmax = fmaxf(pmax, p1[r]);
  { auto rr = __builtin_amdgcn_permlane32_swap(__float_as_uint(pmax), __float_as_uint(pmax), false, false);
    pmax = fmaxf(__uint_as_float(rr[0]), __uint_as_float(rr[1])); }
  if (__builtin_expect(__all(pmax - m_reg <= THR / SCALE), 1)) { mn = m_reg; alpha = 1.f; }
  else { mn = fmaxf(m_reg, pmax); alpha = __builtin_amdgcn_exp2f((m_reg - mn) * C); m_reg = mn; }
  const float mnC = -mn * C;
#pragma unroll
  for (int r = 0; r < 16; ++r) p0[r] = fmaf(p0[r], C, mnC);
#pragma unroll
  for (int r = 0; r < 16; ++r) p1[r] = fmaf(p1[r], C, mnC);
#pragma unroll
  for (int r = 0; r < 16; ++r) p0[r] = __builtin_amdgcn_exp2f(p0[r]);
}
__device__ __forceinline__ void finishSM(f32x16& p0, f32x16& p1, float alpha, float& l_reg, bf16x8& pa0, bf16x8& pa1, bf16x8& pa2, bf16x8& pa3) {
#pragma unroll
  for (int r = 0; r < 16; ++r) p1[r] = __builtin_amdgcn_exp2f(p1[r]);
  float ps = 0;
#pragma unroll
  for (int r = 0; r < 16; ++r) ps += p0[r];
#pragma unroll
  for (int r = 0; r < 16; ++r) ps += p1[r];
  { auto rr = __builtin_amdgcn_permlane32_swap(__float_as_uint(ps), __float_as_uint(ps), false, false);
    ps = __uint_as_float(rr[0]) + __uint_as_float(rr[1]); }
  l_reg = l_reg * alpha + ps;
#define PK4(P, BASE, OUT) do { unsigned a0 = cvtpk(P[BASE + 0], P[BASE + 1]), a1 = cvtpk(P[BASE + 2], P[BASE + 3]);   \
    unsigned b0 = cvtpk(P[BASE + 4], P[BASE + 5]), b1 = cvtpk(P[BASE + 6], P[BASE + 7]);                              \
    auto r0 = __builtin_amdgcn_permlane32_swap(a0, b0, false, false); auto r1 = __builtin_amdgcn_permlane32_swap(a1, b1, false, false); \
    u32x4 w = {r0[0], r1[0], r0[1], r1[1]}; OUT = *reinterpret_cast<bf16x8*>(&w); } while (0)
  PK4(p0, 0, pa0); PK4(p0, 8, pa1); PK4(p1, 0, pa2); PK4(p1, 8, pa3);
#undef PK4
}
template <int DQK>
__device__ __forceinline__ void qkt(f32x16& p0, f32x16& p1, const char* Ks, const bf16x8* qr, int r32, int hi) {
  p0 = f32x16{}; p1 = f32x16{};
#pragma unroll
  for (int d0 = 0; d0 < DQK / 16; ++d0) { const int cb = (d0 * 16 + hi * 8) * 2;
    bf16x8 b0 = *reinterpret_cast<const bf16x8*>(Ks + KSWZ(r32, cb));
    bf16x8 b1 = *reinterpret_cast<const bf16x8*>(Ks + KSWZ(32 + r32, cb));
    p0 = __builtin_amdgcn_mfma_f32_32x32x16_bf16(b0, qr[d0], p0, 0, 0, 0);
    p1 = __builtin_amdgcn_mfma_f32_32x32x16_bf16(b1, qr[d0], p1, 0, 0, 0); }
}
__device__ __forceinline__ int v_st(int k, int c) { const int kk = (k & ~0xC) | ((k & 4) << 1) | ((k & 8) >> 1); return ((kk >> 3) * 4 + (c >> 5)) * 512 + ((kk & 7) * 32 + (c & 31)) * 2; }
__device__ __forceinline__ int v_rd_base(int lane) { return ((lane & 3) << 3) | (((lane >> 2) & 3) << 6) | (((lane >> 4) & 1) << 5) | (((lane >> 5) & 1) << 8); }
constexpr int v_rd_off(int d0, int ks, int half) { return d0 * 512 + ks * 4096 + half * 2048; }
template <int OFF> __device__ __forceinline__ s16x4 tr_read(int vb) {
  s16x4 r; asm volatile("ds_read_b64_tr_b16 %0, %1 offset:%2" : "=&v"(r) : "v"(vb), "i"(OFF) : "memory"); return r;
}
template <int D0> __device__ __forceinline__ void pv_one(f32x16& od, int vb, bf16x8 pa0, bf16x8 pa1, bf16x8 pa2, bf16x8 pa3) {
  const s16x4 l0 = tr_read<v_rd_off(D0, 0, 0)>(vb), h0 = tr_read<v_rd_off(D0, 0, 1)>(vb), l1 = tr_read<v_rd_off(D0, 1, 0)>(vb), h1 = tr_read<v_rd_off(D0, 1, 1)>(vb);
  const s16x4 l2 = tr_read<v_rd_off(D0, 2, 0)>(vb), h2 = tr_read<v_rd_off(D0, 2, 1)>(vb), l3 = tr_read<v_rd_off(D0, 3, 0)>(vb), h3 = tr_read<v_rd_off(D0, 3, 1)>(vb);
  asm volatile("s_waitcnt lgkmcnt(0)" ::: "memory"); SBAR();
#define PK(L, H) (bf16x8){L[0], L[1], L[2], L[3], H[0], H[1], H[2], H[3]}
  od = __builtin_amdgcn_mfma_f32_32x32x16_bf16(pa0, PK(l0, h0), od, 0, 0, 0);
  od = __builtin_amdgcn_mfma_f32_32x32x16_bf16(pa1, PK(l1, h1), od, 0, 0, 0);
  od = __builtin_amdgcn_mfma_f32_32x32x16_bf16(pa2, PK(l2, h2), od, 0, 0, 0);
  od = __builtin_amdgcn_mfma_f32_32x32x16_bf16(pa3, PK(l3, h3), od, 0, 0, 0);
#undef PK
}
__device__ __forceinline__ void pv_d0(f32x16 (&o)[4], int vb, bf16x8 pa0, bf16x8 pa1, bf16x8 pa2, bf16x8 pa3) {
  pv_one<0>(o[0], vb, pa0, pa1, pa2, pa3); pv_one<1>(o[1], vb, pa0, pa1, pa2, pa3); pv_one<2>(o[2], vb, pa0, pa1, pa2, pa3); pv_one<3>(o[3], vb, pa0, pa1, pa2, pa3);
}

template <int DQK>
__device__ __forceinline__ void attn_body(const bf16_t* __restrict__ Qb, const bf16_t* __restrict__ Kh, const bf16_t* __restrict__ Vh,
                                          char* lds, f32x16 (&o)[4], float& l_out) {
  constexpr int LD = CT;
  constexpr int NQ = DQK / 16;
  const int tid = threadIdx.x, wid = tid >> 6, lane = tid & 63, r32 = lane & 31, hi = lane >> 5;
  char* V_lds = lds; char* K_lds = lds + 2 * SHM_V;
  float* ws = (float*)(lds + 2 * SHM_V + 2 * SHM_K) + wid * 64; float* al_l = ws + 32;
  float m_reg = -1e30f, l_reg = 0;
#pragma unroll
  for (int d = 0; d < 4; ++d) o[d] = f32x16{};
  bf16x8 qr[NQ];
  const bf16_t* Qw = Qb + (size_t)(wid * 32 + r32) * LD + hi * 8;
#pragma unroll
  for (int d0 = 0; d0 < NQ; ++d0) qr[d0] = *(const bf16x8*)(Qw + d0 * 16);
  const int sr = tid >> 4, sc = (tid & 15) * 8, vst0 = v_st(sr, sc), vst1 = v_st(32 + sr, sc);
  const int ksr = (DQK == 128) ? sr : (tid >> 3), ksc = (DQK == 128) ? sc : ((tid & 7) * 8);
  const int vb0 = (int)(uintptr_t)V_lds + v_rd_base(lane);
  struct { bf16x8 vs0, vs1, ks0, ks1; } sr_[2];
  const unsigned vgo = (unsigned)(sr * LD + sc) * 2u, kgo = (unsigned)(ksr * LD + ksc) * 2u;
#define SLOAD(i, k0) do { const char* vb_ = (const char*)Vh + (size_t)(k0) * (LD * 2); const char* kb_ = (const char*)Kh + (size_t)(k0) * (LD * 2); \
    sr_[i].vs0 = *(const bf16x8*)(vb_ + vgo); sr_[i].vs1 = *(const bf16x8*)(vb_ + (size_t)32 * LD * 2 + vgo); \
    sr_[i].ks0 = *(const bf16x8*)(kb_ + kgo); \
    if constexpr (DQK == 128) sr_[i].ks1 = *(const bf16x8*)(kb_ + (size_t)32 * LD * 2 + kgo); } while (0)
#define SWRITE(b, i) do { *(bf16x8*)(V_lds + (b) * SHM_V + vst0) = sr_[i].vs0;          \
    *(bf16x8*)(V_lds + (b) * SHM_V + vst1) = sr_[i].vs1; const int kc = ksc * 2;               \
    *(bf16x8*)(K_lds + (b) * SHM_K + KSWZ(ksr, kc)) = sr_[i].ks0;                       \
    if constexpr (DQK == 128) *(bf16x8*)(K_lds + (b) * SHM_K + KSWZ(32 + ksr, kc)) = sr_[i].ks1; } while (0)
#define SWAIT() do { if constexpr (DQK == 128) asm volatile("s_waitcnt vmcnt(4)" ::: "memory"); else asm volatile("s_waitcnt vmcnt(3)" ::: "memory"); } while (0)
#define RESC(a) do { if (__any((a) < 1.f)) { if (hi == 0) al_l[r32] = (a); asm volatile("s_waitcnt lgkmcnt(0)" ::: "memory"); \
    _Pragma("unroll") for (int d = 0; d < 4; ++d) _Pragma("unroll") for (int r = 0; r < 16; ++r) o[d][r] *= al_l[crow(r, hi)]; } } while (0)
  f32x16 pA0, pA1, pB0, pB1; float mnA, mnB, alA, alB; bf16x8 pa0, pa1, pa2, pa3; constexpr int NT = SEQ / KVBLK;
  constexpr int SE = 0, SO = 1;
  SLOAD(SE, 0); asm volatile("s_waitcnt vmcnt(0)" ::: "memory"); SWRITE(0, SE); __syncthreads();
  qkt<DQK>(pA0, pA1, K_lds, qr, r32, hi); partialSM<DQK>(pA0, pA1, m_reg, mnA, alA);
  SLOAD(SO, KVBLK); SLOAD(SE, 2 * KVBLK);
  SWAIT(); SWRITE(1, SO); __syncthreads();
  for (int j = 1; j + 1 < NT; j += 2) {
    SBAR(); qkt<DQK>(pB0, pB1, K_lds + SHM_K, qr, r32, hi);
    finishSM(pA0, pA1, alA, l_reg, pa0, pa1, pa2, pa3); SBAR();
    SLOAD(SO, (j + 2) * KVBLK); SBAR();
    pv_d0(o, vb0, pa0, pa1, pa2, pa3); partialSM<DQK>(pB0, pB1, m_reg, mnB, alB);
    __syncthreads(); SWAIT(); SWRITE(0, SE);
    RESC(alB); __syncthreads();
    SBAR(); qkt<DQK>(pA0, pA1, K_lds, qr, r32, hi);
    finishSM(pB0, pB1, alB, l_reg, pa0, pa1, pa2, pa3); SBAR();
    if (j + 3 < NT) SLOAD(SE, (j + 3) * KVBLK); SBAR();
    pv_d0(o, vb0 + (int)SHM_V, pa0, pa1, pa2, pa3); partialSM<DQK>(pA0, pA1, m_reg, mnA, alA);
    __syncthreads(); SWAIT(); SWRITE(1, SO);
    RESC(alA); __syncthreads();
  }
  SBAR(); qkt<DQK>(pB0, pB1, K_lds + SHM_K, qr, r32, hi);
  finishSM(pA0, pA1, alA, l_reg, pa0, pa1, pa2, pa3); SBAR();
  pv_d0(o, vb0, pa0, pa1, pa2, pa3); partialSM<DQK>(pB0, pB1, m_reg, mnB, alB);
  __syncthreads(); RESC(alB);
  finishSM(pB0, pB1, alB, l_reg, pa0, pa1, pa2, pa3); SBAR();
  pv_d0(o, vb0 + (int)SHM_V, pa0, pa1, pa2, pa3);
  l_out = l_reg;
#undef SLOAD
#undef SWRITE
#undef SWAIT
#undef RESC
}

__device__ __forceinline__ void attn_rli(float l_reg, char* lds, float (&rli)[16]) {
  const int tid = threadIdx.x, wid = tid >> 6, lane = tid & 63, r32 = lane & 31, hi = lane >> 5;
  float* li_l = (float*)(lds + 2 * SHM_V + 2 * SHM_K) + wid * 64;
  if (hi == 0) li_l[r32] = l_reg;
  asm volatile("s_waitcnt lgkmcnt(0)" ::: "memory");
#pragma unroll
  for (int r = 0; r < 16; ++r) rli[r] = __builtin_amdgcn_rcpf(li_l[crow(r, hi)]);
  asm volatile("s_waitcnt lgkmcnt(0)" ::: "memory");
}

__device__ __forceinline__ void phase_attn(const Params& p, char* lds) {
  const int tid = threadIdx.x, wid = tid >> 6, lane = tid & 63;
  for (int it = blockIdx.x; it < 512; it += gridDim.x) {
    const int j = it & 255, xcd = j & 7, slot = j >> 3;
    const int bh = xcd * 2 + (slot >> 4), qblk = slot & 15;
    const int b = bh >> 3, h = bh & 7;
    const size_t tok0 = (size_t)b * SEQ;
    const size_t rowq = tok0 + qblk * 256;
    const int rowbase = (int)rowq + wid * 32;
    f32x16 o[4]; float l_reg; float rli[16];
    if (it < 256) {
      const int kvh = h >> 2;
      attn_body<128>(p.proj + rowq * CT + C_QB + h * 128, p.proj + tok0 * CT + C_KB + kvh * 128, p.proj + tok0 * CT + C_VB + kvh * 128, lds, o, l_reg);
      attn_rli(l_reg, lds, rli);
      const int l2 = launder(lane), r32 = l2 & 31, hi = l2 >> 5;
#pragma unroll
      for (int r = 0; r < 16; ++r) {
        const size_t row = (size_t)(rowbase + crow(r, hi));
        const bf16_t* zp = p.proj + row * CT + C_ZB + h * 128 + r32;
        bf16_t* up = p.U + row * DM + BW + h * 128 + r32;
#pragma unroll
        for (int d0 = 0; d0 < 4; ++d0) up[d0 * 32] = f2bf(o[d0][r] * rli[r] * bf2f(zp[d0 * 32]));
        if ((r & 3) == 3) asm volatile("" ::: "memory");
      }
    } else {
      const bf16_t* Vp = p.proj + tok0 * CT + C_VA + h * 128;
      attn_body<64>(p.proj + rowq * CT + C_QA + h * 128, p.proj + tok0 * CT + C_KA + h * 128, Vp, lds, o, l_reg);
      attn_rli(l_reg, lds, rli);
      {
        const int l2 = launder(lane), r32 = l2 & 31, hi = l2 >> 5;
#pragma unroll
        for (int r = 0; r < 16; ++r) {
          float* op = p.o1 + (size_t)(rowbase + crow(r, hi)) * BW + h * 128 + r32;
#pragma unroll
          for (int d0 = 0; d0 < 4; ++d0) op[d0 * 32] = o[d0][r] * rli[r];
        }
      }
      asm volatile("" ::: "memory");
      attn_body<64>(p.proj + rowq * CT + C_QA + h * 128 + 64, p.proj + tok0 * CT + C_KA + h * 128 + 64, Vp, lds, o, l_reg);
      attn_rli(l_reg, lds, rli);
      const int l2 = launder(lane), r32 = l2 & 31, hi = l2 >> 5;
      float d1 = 0.f, d2 = 0.f;
      for (int i = 0; i < 64; ++i) { d1 += p.lq1[i] * p.lk1[i]; d2 += p.lq2[i] * p.lk2[i]; }
      const float lam = __expf(d1) - __expf(d2) + 0.2f;
      float sg[4];
#pragma unroll
      for (int d0 = 0; d0 < 4; ++d0) sg[d0] = p.subln_g[d0 * 32 + r32] * 0.8f;
#pragma unroll
      for (int r = 0; r < 16; ++r) {
        const size_t row = (size_t)(rowbase + crow(r, hi));
        const float* op = p.o1 + row * BW + h * 128 + r32;
        float t[4]; float ss = 0.f;
#pragma unroll
        for (int d0 = 0; d0 < 4; ++d0) { t[d0] = op[d0 * 32] - lam * (o[d0][r] * rli[r]); ss += t[d0] * t[d0]; }
#pragma unroll
        for (int m = 1; m < 32; m <<= 1) ss += __shfl_xor(ss, m);
        const float rinv = rsqrtf(ss * (1.0f / 128.0f) + EPS);
        const bf16_t* zp = p.proj + row * CT + C_ZA + h * 128 + r32;
        bf16_t* up = p.U + row * DM + h * 128 + r32;
#pragma unroll
        for (int d0 = 0; d0 < 4; ++d0) up[d0 * 32] = f2bf(t[d0] * rinv * sg[d0] * bf2f(zp[d0 * 32]));
        if ((r & 3) == 3) asm volatile("" ::: "memory");
      }
    }
    __syncthreads();
  }
}

__global__ void __launch_bounds__(512) mega(Params p) {
  extern __shared__ __attribute__((aligned(16))) char lds[];
  cg::grid_group grid = cg::this_grid();
  const int lo = p.phase_lo, hi = p.phase_hi;
#ifndef NO_P0
  if (lo <= 0 && 0 <= hi) phase_prologue(p, lds);
#endif
  if (lo <= 0 && 1 <= hi) grid.sync();
#ifndef NO_P1
  if (lo <= 1 && 1 <= hi) phase_gemm1(p, lds);
#endif
  if (lo <= 1 && 2 <= hi) grid.sync();
#ifndef NO_P2
  if (lo <= 2 && 2 <= hi) phase_attn(p, lds);
#endif
  if (lo <= 2 && 3 <= hi) grid.sync();
#ifndef NO_P3
  if (lo <= 3 && 3 <= hi) phase_gemm2(p, lds);
#endif
  if (lo <= 3 && 4 <= hi) grid.sync();
#ifndef NO_P4
  if (lo <= 4 && 4 <= hi) phase_gemm3(p, lds);
#endif
  if (lo <= 4 && 5 <= hi) grid.sync();
#ifndef NO_P5
  if (lo <= 5 && 5 <= hi) phase_final(p);
#endif
}

extern "C" void kernel_launch(void* const* d_in, const int* in_sizes, int n_in, void* d_out, int out_size, void* d_ws, size_t ws_size, hipStream_t stream) {
  static int grid_blocks = 0;
  if (!grid_blocks) {
    hipFuncSetAttribute((const void*)mega, hipFuncAttributeMaxDynamicSharedMemorySize, LDS_BYTES);
    int dev = 0, cus = 0, per_cu = 0;
    hipGetDevice(&dev);
    hipDeviceGetAttribute(&cus, hipDeviceAttributeMultiprocessorCount, dev);
    hipOccupancyMaxActiveBlocksPerMultiprocessor(&per_cu, mega, 512, LDS_BYTES);
    if (per_cu < 1) { fprintf(stderr, "occupancy query returned %d\n", per_cu); per_cu = 1; }
    grid_blocks = cus * per_cu;
    if (grid_blocks > 256) grid_blocks = 256;
  }
  Params p{};
  p.x = (const float*)d_in[0]; p.norm_g = (const float*)d_in[1]; p.w_in = (const float*)d_in[2];
  p.lq1 = (const float*)d_in[3]; p.lk1 = (const float*)d_in[4]; p.lq2 = (const float*)d_in[5]; p.lk2 = (const float*)d_in[6];
  p.subln_g = (const float*)d_in[7]; p.qn_g = (const float*)d_in[8]; p.kn_g = (const float*)d_in[9];
  p.w_out_a = (const float*)d_in[10]; p.w_out_b = (const float*)d_in[11]; p.w_o = (const float*)d_in[12]; p.final_g = (const float*)d_in[13];
  p.out = (float*)d_out;
  char* w = (char*)d_ws; size_t off = 0;
  auto take = [&](size_t bytes) { char* r = w + off; off += (bytes + 255) & ~(size_t)255; return r; };
  p.h      = (bf16_t*)take((size_t)MTOK * DM * 2);
  p.o1     = (float*)p.h;
  p.merged = (bf16_t*)p.h;
  p.winT   = (bf16_t*)take((size_t)CT * DM * 2);
  p.waT    = (bf16_t*)take((size_t)DM * BW * 2);
  p.wbT    = (bf16_t*)take((size_t)DM * BW * 2);
  p.woT    = (bf16_t*)take((size_t)DM * DM * 2);
  p.proj   = (bf16_t*)take((size_t)MTOK * CT * 2);
  p.U      = (bf16_t*)take((size_t)MTOK * DM * 2);
  p.rope   = (float2*)take((size_t)SEQ * 32 * 8);
  if (off > ws_size) { fprintf(stderr, "workspace too small: need %zu have %zu\n", off, ws_size); return; }
#if MK_LAUNCHES == 1
  p.phase_lo = 0; p.phase_hi = 5;
  void* args[] = {&p};
  hipError_t e = hipLaunchCooperativeKernel((void*)mega, dim3(grid_blocks), dim3(512), args, LDS_BYTES, stream);
  if (e != hipSuccess) fprintf(stderr, "cooperative launch failed: %s (grid %d)\n", hipGetErrorString(e), grid_blocks);
#else
  for (int ph = 0; ph <= 5; ++ph) {
    p.phase_lo = ph; p.phase_hi = ph;
    hipLaunchKernelGGL(mega, dim3(grid_blocks), dim3(512), LDS_BYTES, stream, p);
  }
#endif
}
```

```cpp
#include <hip/hip_runtime.h>
#include <hip/hip_cooperative_groups.h>
#include <cstdio>
#include <cstdint>
namespace cg = cooperative_groups;

#ifndef MK_LAUNCHES
#define MK_LAUNCHES 1
#endif

typedef unsigned short bf16_t;
using bf16x8 = __attribute__((ext_vector_type(8))) short;
using s16x4  = __attribute__((ext_vector_type(4))) short;
using f32x16 = __attribute__((ext_vector_type(16))) float;
using f32x4  = __attribute__((ext_vector_type(4))) float;
using u32x4  = __attribute__((ext_vector_type(4))) unsigned;
using u32x2  = __attribute__((ext_vector_type(2))) unsigned;

constexpr int MTOK = 8192, SEQ = 4096, DM = 2048, CT = 10752, BW = 1024;
constexpr int C_QA = 0, C_KA = 1024, C_VA = 2048, C_ZA = 3072, C_QB = 4096, C_KB = 5120, C_VB = 5376, C_ZB = 5632, C_GA = 6656, C_GB = 8704;
constexpr float EPS = 1e-6f;
constexpr int LDS_BYTES = 131072 + 64 + 4096;

struct Params {
  const float *x, *norm_g, *w_in, *lq1, *lk1, *lq2, *lk2, *subln_g, *qn_g, *kn_g, *w_out_a, *w_out_b, *w_o, *final_g;
  float* out;
  bf16_t *h, *winT, *waT, *wbT, *woT, *proj, *U, *merged;
  float* o1;
  float2* rope;
  float* ssq;
  unsigned* bar;
  bf16_t* gbuf;
  void* pad0;
  int phase_lo, phase_hi;
};

#define SBAR() __builtin_amdgcn_sched_barrier(0)
#define LAS __attribute__((address_space(3)))
__device__ __forceinline__ int crow(int r, int hi) { return (r & 3) + 8 * (r >> 2) + 4 * hi; }
__device__ __forceinline__ unsigned cvtpk(float lo, float hi) {
  unsigned r; asm volatile("v_cvt_pk_bf16_f32 %0, %1, %2" : "=v"(r) : "v"(lo), "v"(hi)); return r;
}
__device__ __forceinline__ float bf2f(bf16_t v) { return __uint_as_float(((unsigned)v) << 16); }
__device__ __forceinline__ bf16_t f2bf(float f) { return (bf16_t)(cvtpk(f, f) & 0xffffu); }
__device__ __forceinline__ float sigmoidf_(float v) { return 1.f / (1.f + __expf(-v)); }

__device__ __forceinline__ void transpose_cvt_strip(const float* __restrict__ W, bf16_t* __restrict__ Wt, int K, int N, int strip, float* tl) {
  const int tid = threadIdx.x;
  const int nsn = N >> 7;
  const int n0 = (strip % nsn) * 128, k0 = (strip / nsn) * 64;
  const int r = tid >> 5, c4 = (tid & 31) * 4;
  f32x4 v[4];
#pragma unroll
  for (int j = 0; j < 4; ++j) v[j] = __builtin_nontemporal_load((const f32x4*)(W + (size_t)(k0 + r + 16 * j) * N + n0 + c4));
#pragma unroll
  for (int j = 0; j < 4; ++j) { float* d = tl + (r + 16 * j) * 129 + c4; d[0] = v[j][0]; d[1] = v[j][1]; d[2] = v[j][2]; d[3] = v[j][3]; }
  __syncthreads();
#pragma unroll
  for (int i = 0; i < 2; ++i) {
    const int id = tid + 512 * i, n = id >> 3, kc = (id & 7) * 8;
    u32x4 w;
    w[0] = cvtpk(tl[(kc + 0) * 129 + n], tl[(kc + 1) * 129 + n]);
    w[1] = cvtpk(tl[(kc + 2) * 129 + n], tl[(kc + 3) * 129 + n]);
    w[2] = cvtpk(tl[(kc + 4) * 129 + n], tl[(kc + 5) * 129 + n]);
    w[3] = cvtpk(tl[(kc + 6) * 129 + n], tl[(kc + 7) * 129 + n]);
    *(u32x4*)(Wt + (size_t)(n0 + n) * K + k0 + kc) = w;
  }
  __syncthreads();
}
__device__ __forceinline__ void transpose_late_weights(const Params& p, char* lds, int worker, int nworkers) {
  float* tl = (float*)lds;
  constexpr int S_OA = (BW / 64) * (DM / 128), S_WO = (DM / 64) * (DM / 128);
  for (int t = worker; t < 2 * S_OA + S_WO; t += nworkers) {
    if (t < S_OA) transpose_cvt_strip(p.w_out_a, p.waT, BW, DM, t, tl);
    else if (t < 2 * S_OA) transpose_cvt_strip(p.w_out_b, p.wbT, BW, DM, t - S_OA, tl);
    else transpose_cvt_strip(p.w_o, p.woT, DM, DM, t - 2 * S_OA, tl);
  }
}

__device__ __forceinline__ void phase_prologue(const Params& p, char* lds) {
  const int tid = threadIdx.x, wid = tid >> 6, lane = tid & 63;
  for (int i = blockIdx.x * 512 + tid; i < SEQ * 32; i += gridDim.x * 512) {
    const int pos = i >> 5, f = i & 31;
    const float inv = 1.0f / exp2f((float)f * (13.287712379549449f / 32.0f));
    const float ang = (float)pos * inv;
    const double rev = (double)ang * 0.15915494309189535;
    const float fr = (float)(rev - rint(rev));
    float2 cs; cs.x = __builtin_amdgcn_cosf(fr); cs.y = __builtin_amdgcn_sinf(fr);
    p.rope[i] = cs;
  }
  for (int row = blockIdx.x * 8 + wid; row < MTOK; row += gridDim.x * 8) {
    const float* xr = p.x + (size_t)row * DM;
    f32x4 v[8]; float ss = 0.f;
#pragma unroll
    for (int j = 0; j < 8; ++j) { v[j] = __builtin_nontemporal_load((const f32x4*)(xr + j * 256 + lane * 4)); ss += v[j][0] * v[j][0] + v[j][1] * v[j][1] + v[j][2] * v[j][2] + v[j][3] * v[j][3]; }
#pragma unroll
    for (int m = 1; m < 64; m <<= 1) ss += __shfl_xor(ss, m);
    const float rinv = rsqrtf(ss * (1.0f / DM) + EPS);
    bf16_t* hr = p.h + (size_t)row * DM;
#pragma unroll
    for (int j = 0; j < 8; ++j) {
      const f32x4 g = *(const f32x4*)(p.norm_g + j * 256 + lane * 4);
      u32x2 w; w[0] = cvtpk(v[j][0] * rinv * g[0], v[j][1] * rinv * g[1]); w[1] = cvtpk(v[j][2] * rinv * g[2], v[j][3] * rinv * g[3]);
      *(u32x2*)(hr + j * 256 + lane * 4) = w;
    }
  }
  float* tl = (float*)lds;
  constexpr int S_IN = (DM / 64) * (CT / 128);
  for (int t = blockIdx.x; t < S_IN; t += gridDim.x) transpose_cvt_strip(p.w_in, p.winT, DM, CT, t, tl);
}

template <int NI>
__device__ __forceinline__ void gemm_prefetch(const bf16_t* __restrict__ A, int lda, const bf16_t* __restrict__ Bt, int ldb, char* lds_) {
  constexpr int BN = NI * 64, NPB = BN / 128;
  constexpr int SA = 256 * 64, SB = BN * 64, STG = SA + SB;
  LAS char* lds = (LAS char*)lds_;
  const int tid = threadIdx.x, wid = __builtin_amdgcn_readfirstlane(tid >> 6);
  const int rowq = tid >> 2, lc = (tid & 3) ^ ((tid >> 4) & 3);
  const unsigned goA = (unsigned)(rowq * lda + lc * 8) * 2u, goB = (unsigned)(rowq * ldb + lc * 8) * 2u;
  const char* Ab0 = (const char*)A; const char* Bb0 = (const char*)Bt;
#pragma unroll
  for (int kt = 0; kt < 2; ++kt) {
    LAS char* sb_ = lds + kt * STG + wid * 1024;
#pragma unroll
    for (int i_ = 0; i_ < 2; ++i_) __builtin_amdgcn_global_load_lds((const unsigned*)(Ab0 + (size_t)kt * 64 + (size_t)(128 * i_) * lda * 2 + goA), (LAS unsigned*)(sb_ + i_ * 8192), 16, 0, 0);
#pragma unroll
    for (int i_ = 0; i_ < NPB; ++i_) __builtin_amdgcn_global_load_lds((const unsigned*)(Bb0 + (size_t)kt * 64 + (size_t)(128 * i_) * ldb * 2 + goB), (LAS unsigned*)(sb_ + SA + i_ * 8192), 16, 0, 0);
  }
}
template <int NI, bool PRE = false>
__device__ __forceinline__ void gemm_mainloop(const bf16_t* __restrict__ A, int lda, const bf16_t* __restrict__ Bt, int ldb, int K,
                                              f32x16 (&acc)[2][NI], char* lds_) {
  constexpr int BN = NI * 64, NPB = BN / 128;
  constexpr int SA = 256 * 64, SB = BN * 64, STG = SA + SB;
  constexpr int P = 2 + NPB;
  LAS char* lds = (LAS char*)lds_;
  const int tid = threadIdx.x, wid = __builtin_amdgcn_readfirstlane(tid >> 6), lane = tid & 63, r32 = lane & 31, hi = lane >> 5, wm = wid >> 1, wn = wid & 1;
  const int rowq = tid >> 2, lc = (tid & 3) ^ ((tid >> 4) & 3);
  const unsigned goA = (unsigned)(rowq * lda + lc * 8) * 2u, goB = (unsigned)(rowq * ldb + lc * 8) * 2u;
  const char* Ab0 = (const char*)A; const char* Bb0 = (const char*)Bt;
  const int nt = K >> 5;
#define G_ISSUE(kt_) do { const int st_ = (kt_) & 3; const char* An_ = Ab0 + (size_t)(kt_) * 64; const char* Bn_ = Bb0 + (size_t)(kt_) * 64; \
    LAS char* sb_ = lds + st_ * STG + wid * 1024; \
    _Pragma("unroll") for (int i_ = 0; i_ < 2; ++i_) __builtin_amdgcn_global_load_lds((const unsigned*)(An_ + (size_t)(128 * i_) * lda * 2 + goA), (LAS unsigned*)(sb_ + i_ * 8192), 16, 0, 0); \
    _Pragma("unroll") for (int i_ = 0; i_ < NPB; ++i_) __builtin_amdgcn_global_load_lds((const unsigned*)(Bn_ + (size_t)(128 * i_) * ldb * 2 + goB), (LAS unsigned*)(sb_ + SA + i_ * 8192), 16, 0, 0); } while (0)
#define G_PIECE(kt_, j_) do { const int st_ = (kt_) & 3; LAS char* sb_ = lds + st_ * STG + wid * 1024; \
    if ((j_) < 2) __builtin_amdgcn_global_load_lds((const unsigned*)(Ab0 + (size_t)(kt_) * 64 + (size_t)(128 * (j_)) * lda * 2 + goA), (LAS unsigned*)(sb_ + (j_) * 8192), 16, 0, 0); \
    else __builtin_amdgcn_global_load_lds((const unsigned*)(Bb0 + (size_t)(kt_) * 64 + (size_t)(128 * ((j_) - 2)) * ldb * 2 + goB), (LAS unsigned*)(sb_ + SA + ((j_) - 2) * 8192), 16, 0, 0); } while (0)
  if (!PRE) { asm volatile("s_waitcnt vmcnt(0)" ::: "memory"); G_ISSUE(0); G_ISSUE(1); }
  const int sw = (r32 >> 2) & 3;
  const int co0 = (hi ^ sw) << 4;
  const int aoff = (wm * 64 + r32) * 64, boff = SA + (wn * (BN / 2) + r32) * 64;
  constexpr int STEP = (2 * NI) / P;
#define DSR(dst, addr, OFF) asm volatile("ds_read_b128 %0, %1 offset:%2" : "=&v"(dst) : "v"(addr), "i"(OFF) : "memory")
#define DSR_SET(F, pa, pb) do { DSR(F.a[0], pa, 0); DSR(F.a[1], pa, 2048); _Pragma("unroll") for (int ni_ = 0; ni_ < NI; ++ni_) DSR(F.b[ni_], pb, ni_ * 2048); } while (0)
#define MMA_SET(F, KT_ISSUE) do { _Pragma("unroll") for (int mi_ = 0; mi_ < 2; ++mi_) _Pragma("unroll") for (int ni_ = 0; ni_ < NI; ++ni_) { \
      acc[mi_][ni_] = __builtin_amdgcn_mfma_f32_32x32x16_bf16(F.b[ni_], F.a[mi_], acc[mi_][ni_], 0, 0, 0); \
      const int idx_ = mi_ * NI + ni_; \
      if ((KT_ISSUE) >= 0 && (idx_ + 1) % STEP == 0 && (idx_ + 1) / STEP - 1 < P) { SBAR(); if (issue) G_PIECE((KT_ISSUE), (idx_ + 1) / STEP - 1); SBAR(); } } } while (0)
#define LWAIT(N) do { SBAR(); asm volatile("s_waitcnt lgkmcnt(%0)" :: "n"(N) : "memory"); SBAR(); } while (0)
  struct Frag { bf16x8 a[2]; bf16x8 b[NI]; };
  for (int kt = 0; kt < nt; kt += 2) {
    asm volatile("s_waitcnt vmcnt(0)" ::: "memory");
    __builtin_amdgcn_s_barrier();
    asm volatile("" ::: "memory");
    const bool issue = (kt + 2 < nt);
    const int sa_ = (int)(uintptr_t)(lds + (kt & 3) * STG), sb2_ = (int)(uintptr_t)(lds + ((kt + 1) & 3) * STG);
    Frag F0, F1;
    DSR_SET(F0, sa_ + aoff + co0, sa_ + boff + co0);
    DSR_SET(F1, sa_ + aoff + (co0 ^ 32), sa_ + boff + (co0 ^ 32));
    LWAIT(2 + NI);
    MMA_SET(F0, kt + 2);
    SBAR(); DSR_SET(F0, sb2_ + aoff + co0, sb2_ + boff + co0); SBAR();
    LWAIT(2 + NI);
    MMA_SET(F1, kt + 3);
    SBAR(); DSR_SET(F1, sb2_ + aoff + (co0 ^ 32), sb2_ + boff + (co0 ^ 32)); SBAR();
    LWAIT(2 + NI);
    MMA_SET(F0, -1);
    LWAIT(0);
    MMA_SET(F1, -1);
  }
#undef DSR
#undef DSR_SET
#undef MMA_SET
#undef LWAIT
  asm volatile("" ::: "memory");
  __builtin_amdgcn_s_barrier();
  asm volatile("" ::: "memory");
#undef G_ISSUE
#undef G_PIECE
}

namespace pg8 {
#define PG8_LAS __attribute__((address_space(3)))
typedef unsigned short bf16_t;
typedef short bf16x8 __attribute__((ext_vector_type(8)));
typedef float f32x4 __attribute__((ext_vector_type(4)));
typedef unsigned u32x4 __attribute__((ext_vector_type(4)));
constexpr int BM = 256, BK = 64, HALF = 128, HTB = HALF * BK * 2  , STAGE_BYTES = 8 * HTB, NXCD = 8, WGM = 8;

__host__ __device__ __forceinline__ int lds_byte(int r, int c) { const int st = (r >> 4) * 2 + (c >> 5), rr = r & 15, cc = c & 31, ob = rr * 64 + cc * 2; return st * 1024 + (ob ^ (((ob >> 9) & 1) << 5)); }
__host__ __device__ __forceinline__ void stage_rc(int b, int& R, int& C) { const int st = b / 1024, sb = b % 1024, swz = sb ^ (((sb >> 9) & 1) << 5); R = (st >> 1) * 16 + swz / 64; C = (st & 1) * 32 + (swz % 64) / 2; }
__host__ __device__ __forceinline__ int perm32(int rho) { const int n = rho >> 4, i = rho & 15; return 8 * (i >> 2) + 4 * n + (i & 3); }

struct Unit { int pm, pn; };
struct Gemm { const bf16_t* A; const bf16_t* Bt; int M, N, K; };

__device__ __forceinline__ unsigned cvt_pk_bf16(float lo, float hi) { unsigned r; asm volatile("v_cvt_pk_bf16_f32 %0, %1, %2" : "=v"(r) : "v"(lo), "v"(hi)); return r; }
template <class Epi, class Sched, bool ALIGN_EPI = false, bool SP2 = false>
__device__ __forceinline__ void gemm_phase(PG8_LAS unsigned char* lds, const Gemm g, const Sched& S, const Epi& E) {
    const int tid = threadIdx.x, wid = __builtin_amdgcn_readfirstlane(tid >> 6), lane = tid & 63, wr = wid >> 2, wc = wid & 3, fr = lane & 15, fq = lane >> 4;
    const int K = g.K, nt = K / BK;
    unsigned voffA[2], voffB[2];
#pragma unroll
    for (int i = 0; i < 2; ++i) { int R, C; stage_rc(tid * 16 + i * 8192, R, C); const int Rb = Epi::PERM ? ((R & ~31) + perm32(R & 31)) : R;
        voffA[i] = (unsigned)(R * K + C) * 2u; voffB[i] = (unsigned)(Rb * K + C) * 2u; }
    unsigned voffB1[2]; size_t hstepB = (size_t)HALF * K * 2;
#pragma unroll
    for (int i = 0; i < 2; ++i) { voffB1[i] = voffB[i];
        if constexpr (Epi::COLMAP) { int R, C; stage_rc(tid * 16 + i * 8192, R, C); const int c0 = 64 * (R >> 5) + perm32(R & 31);
            voffB[i] = (unsigned)(c0 * K + C) * 2u; voffB1[i] = (unsigned)((c0 + 32) * K + C) * 2u; } }
    if constexpr (Epi::COLMAP) hstepB = 0;
    const size_t kstep = (size_t)(BK * 2);
    const size_t hstep = (size_t)HALF * K * 2;
    const size_t tstep = 2 * hstep;
    const unsigned ldsw = (unsigned)wid * 1024u;
    const int aoff = lds_byte(wr * 64 + fr, fq * 8), boff = lds_byte(wc * 32 + fr, fq * 8);
#define PG8_SA(b, h) (((b) * 2 + (h)) * HTB)
#define PG8_SB(b, h) ((4 + (b) * 2 + (h)) * HTB)
#define PG8_STAGE(bufoff, gbase, voff) do { _Pragma("unroll") for (int _i = 0; _i < 2; ++_i) \
        __builtin_amdgcn_global_load_lds((const unsigned*)((const char*)(gbase) + (voff)[_i]), (PG8_LAS unsigned*)(lds + (bufoff) + ldsw + _i * 8192), 16, 0, 0); } while (0)
#define PG8_LDA(dst, b, h) do { _Pragma("unroll") for (int m = 0; m < 4; ++m) _Pragma("unroll") for (int k = 0; k < 2; ++k) dst[m][k] = *(const PG8_LAS bf16x8*)(lds + PG8_SA(b, h) + aoff + m * 2048 + k * 1024); } while (0)
#define PG8_LDB(dst, b, h) do { _Pragma("unroll") for (int n = 0; n < 2; ++n) _Pragma("unroll") for (int k = 0; k < 2; ++k) dst[n][k] = *(const PG8_LAS bf16x8*)(lds + PG8_SB(b, h) + boff + n * 2048 + k * 1024); } while (0)
#define PG8_MMA(ai, bj, At, Bt) do { __builtin_amdgcn_s_setprio(1); _Pragma("unroll") for (int m = 0; m < 4; ++m) _Pragma("unroll") for (int n = 0; n < 2; ++n) _Pragma("unroll") for (int k = 0; k < 2; ++k) \
        acc[ai][bj][m][n] = __builtin_amdgcn_mfma_f32_16x16x32_bf16(Bt[n][k], At[m][k], acc[ai][bj][m][n], 0, 0, 0); __builtin_amdgcn_s_setprio(0); } while (0)
#define PG8_WAIT_V(n) asm volatile("s_waitcnt vmcnt(" #n ")" ::: "memory")
#define PG8_WAIT_L(n) asm volatile("s_waitcnt lgkmcnt(" #n ")" ::: "memory")
#define PG8_BAR __builtin_amdgcn_s_barrier()
#define PG8_SCHED __builtin_amdgcn_sched_barrier(0)
    Unit cur, nxt; int ui = 0;
    if (!S.next(0, cur)) return;
    f32x4 acc[2][2][4][2];
#pragma unroll
    for (int a = 0; a < 2; ++a)
#pragma unroll
        for (int b = 0; b < 2; ++b)
#pragma unroll
            for (int m = 0; m < 4; ++m)
#pragma unroll
                for (int n = 0; n < 2; ++n) acc[a][b][m][n] = (f32x4){0.f, 0.f, 0.f, 0.f};
    bf16x8 At[4][2], B0[2][2], B1[2][2];
    const char* cA = (const char*)g.A + (size_t)cur.pm * tstep; const char* cB = (const char*)g.Bt + (size_t)cur.pn * tstep;
    S.a_ready(cur);
    if constexpr (SP2) {
        PG8_STAGE(PG8_SB(0, 0), cB, voffB); PG8_STAGE(PG8_SB(0, 1), cB + hstepB, voffB1); PG8_STAGE(PG8_SA(0, 0), cA, voffA); PG8_STAGE(PG8_SA(0, 1), cA + hstep, voffA);
        if (wr == 1) PG8_BAR;
        PG8_WAIT_V(2); PG8_BAR;
        PG8_STAGE(PG8_SB(1, 0), cB + kstep, voffB); PG8_STAGE(PG8_SA(1, 0), cA + kstep, voffA); PG8_STAGE(PG8_SB(1, 1), cB + hstepB + kstep, voffB1);
        PG8_WAIT_V(6); PG8_BAR;
    } else {
        PG8_STAGE(PG8_SB(0, 0), cB, voffB); PG8_STAGE(PG8_SA(0, 0), cA, voffA); PG8_STAGE(PG8_SB(0, 1), cB + hstepB, voffB1); PG8_STAGE(PG8_SA(0, 1), cA + hstep, voffA);
        if (wr == 1) PG8_BAR;
        PG8_WAIT_V(4); PG8_BAR;
        PG8_STAGE(PG8_SB(1, 0), cB + kstep, voffB); PG8_STAGE(PG8_SA(1, 0), cA + kstep, voffA); PG8_STAGE(PG8_SB(1, 1), cB + hstepB + kstep, voffB1);
        PG8_WAIT_V(6); PG8_BAR;
    }
    for (;;) {
        const bool has_next = S.next(ui + 1, nxt);
        const char* nA = has_next ? (const char*)g.A + (size_t)nxt.pm * tstep : cA; const char* nB = has_next ? (const char*)g.Bt + (size_t)nxt.pn * tstep : cB;
        for (int t = 0; t < nt; t += 2) {
            const bool last = (t == nt - 2);
            const char* a1 = cA + (size_t)(t + 1) * kstep;
            const char* a2 = last ? nA : cA + (size_t)(t + 2) * kstep; const char* b2 = last ? nB : cB + (size_t)(t + 2) * kstep;
            const char* a3 = a2 + kstep; const char* b3 = b2 + kstep;
            if (last && has_next) S.a_ready(nxt);
            if constexpr (SP2) {
            PG8_LDB(B0, 0, 0); PG8_LDB(B1, 0, 1); PG8_SCHED; PG8_LDA(At, 0, 0); PG8_STAGE(PG8_SA(1, 1), a1 + hstep, voffA);
            PG8_WAIT_V(8); PG8_WAIT_L(0); PG8_BAR; PG8_MMA(0, 0, At, B0); PG8_MMA(0, 1, At, B1); PG8_BAR; PG8_SCHED;
            PG8_LDA(At, 0, 1); PG8_STAGE(PG8_SB(0, 0), b2, voffB); PG8_STAGE(PG8_SB(0, 1), b2 + hstepB, voffB1); PG8_STAGE(PG8_SA(0, 0), a2, voffA);
            PG8_WAIT_V(8); PG8_WAIT_L(0); PG8_BAR; PG8_MMA(1, 0, At, B0); PG8_MMA(1, 1, At, B1); PG8_BAR; PG8_SCHED;
            PG8_LDB(B0, 1, 0); PG8_LDB(B1, 1, 1); PG8_SCHED; PG8_LDA(At, 1, 0); PG8_STAGE(PG8_SA(0, 1), a2 + hstep, voffA);
            PG8_WAIT_V(8); PG8_WAIT_L(0); PG8_BAR; PG8_MMA(0, 0, At, B0); PG8_MMA(0, 1, At, B1); PG8_BAR; PG8_SCHED;
            PG8_LDA(At, 1, 1); PG8_STAGE(PG8_SB(1, 0), b3, voffB); PG8_STAGE(PG8_SB(1, 1), b3 + hstepB, voffB1); PG8_STAGE(PG8_SA(1, 0), a3, voffA);
            PG8_WAIT_V(8); PG8_WAIT_L(0); PG8_BAR; PG8_MMA(1, 0, At, B0); PG8_MMA(1, 1, At, B1); PG8_BAR; PG8_SCHED;
            } else {
            PG8_LDB(B0, 0, 0); PG8_SCHED; PG8_LDA(At, 0, 0); PG8_STAGE(PG8_SA(1, 1), a1 + hstep, voffA);
            PG8_WAIT_L(8); PG8_BAR; PG8_WAIT_L(0); PG8_MMA(0, 0, At, B0); PG8_BAR; PG8_SCHED;
            PG8_LDB(B1, 0, 1); PG8_STAGE(PG8_SB(0, 0), b2, voffB);
            PG8_BAR; PG8_WAIT_L(0); PG8_MMA(0, 1, At, B1); PG8_BAR;
            PG8_LDA(At, 0, 1); PG8_STAGE(PG8_SA(0, 0), a2, voffA);
            PG8_BAR; PG8_WAIT_L(0); PG8_MMA(1, 0, At, B0); PG8_BAR; PG8_SCHED;
            PG8_STAGE(PG8_SB(0, 1), b2 + hstepB, voffB1);
            PG8_WAIT_V(6); PG8_BAR; PG8_MMA(1, 1, At, B1); PG8_BAR;
            PG8_LDB(B0, 1, 0); PG8_SCHED; PG8_LDA(At, 1, 0); PG8_STAGE(PG8_SA(0, 1), a2 + hstep, voffA);
            PG8_WAIT_L(8); PG8_BAR; PG8_WAIT_L(0); PG8_MMA(0, 0, At, B0); PG8_BAR; PG8_SCHED;
            PG8_LDB(B1, 1, 1); PG8_STAGE(PG8_SB(1, 0), b3, voffB);
            PG8_BAR; PG8_WAIT_L(0); PG8_MMA(0, 1, At, B1); PG8_BAR;
            PG8_LDA(At, 1, 1); PG8_STAGE(PG8_SA(1, 0), a3, voffA);
            PG8_BAR; PG8_WAIT_L(0); PG8_MMA(1, 0, At, B0); PG8_BAR; PG8_SCHED;
            PG8_STAGE(PG8_SB(1, 1), b3 + hstepB, voffB1);
            PG8_WAIT_V(6); PG8_BAR; PG8_MMA(1, 1, At, B1); PG8_BAR;
            }
        }
        if constexpr (ALIGN_EPI) { if (wr == 0) PG8_BAR; }
        if constexpr (!Epi::AFTER_DRAIN) { E(acc, cur, wr, wc, fr, fq); S.done(cur); }
        if (!has_next) break;
#pragma unroll
        for (int a = 0; a < 2; ++a)
#pragma unroll
            for (int b = 0; b < 2; ++b)
#pragma unroll
                for (int m = 0; m < 4; ++m)
#pragma unroll
                    for (int n = 0; n < 2; ++n) acc[a][b][m][n] = (f32x4){0.f, 0.f, 0.f, 0.f};
        cur = nxt; cA = nA; cB = nB; ++ui;
        if constexpr (ALIGN_EPI) { if (wr == 1) PG8_BAR; }
    }
    PG8_WAIT_V(0);
    if constexpr (!ALIGN_EPI) { if (wr == 0) PG8_BAR; }
    PG8_BAR;
    if constexpr (Epi::AFTER_DRAIN) { E.fused(acc, cur, wr, wc, fr, fq, lds, wid, lane); S.done(cur); }
#undef PG8_SA
#undef PG8_SB
#undef PG8_STAGE
#undef PG8_LDA
#undef PG8_LDB
#undef PG8_MMA
#undef PG8_WAIT_V
#undef PG8_WAIT_L
#undef PG8_BAR
#undef PG8_SCHED
}
}
__device__ __forceinline__ size_t gbuf_off(int gate, int rb, int cb, int lane) { return ((((size_t)gate * 256 + rb) * 128 + cb) * 64 + lane) * 8; }

struct EpiG1 {
  static constexpr bool PERM = true, AFTER_DRAIN = false, COLMAP = true;
  bf16_t* proj; bf16_t* gbuf; const float2* rope; const float* qn_g; const float* kn_g; float* xch;
  __device__ __forceinline__ void operator()(const pg8::f32x4 (&acc)[2][2][4][2], const pg8::Unit& u, int wr, int wc, int fr, int fq) const {
    const int colt = u.pn * 256;
    if (colt >= C_QB && colt < C_VB) { qknorm(acc, u, wr, wc, fr, fq); return; }
    const int type = (colt < C_VA) ? 0 : (colt >= C_GA) ? 3 : (((colt >= C_ZA && colt < C_QB) || (colt >= C_ZB && colt < C_GA)) ? 2 : 4);
#pragma unroll
    for (int ai = 0; ai < 2; ++ai)
#pragma unroll
      for (int m = 0; m < 4; ++m) {
        const int row = u.pm * 256 + ai * 128 + wr * 64 + m * 16 + fr;
        float v[2][8];
#pragma unroll
        for (int bj = 0; bj < 2; ++bj)
#pragma unroll
          for (int e = 0; e < 4; ++e) { v[bj][e] = acc[ai][bj][m][0][e]; v[bj][4 + e] = acc[ai][bj][m][1][e]; }
        if (type == 0) {
          const f32x4* tp = (const f32x4*)(rope + (row & (SEQ - 1)) * 32 + 8 * fq);
#pragma unroll
          for (int q = 0; q < 4; ++q) { const f32x4 cs = tp[q];
            { const float x1 = v[0][2 * q], x2 = v[1][2 * q]; v[0][2 * q] = x1 * cs[0] - x2 * cs[1]; v[1][2 * q] = x2 * cs[0] + x1 * cs[1]; }
            { const float x1 = v[0][2 * q + 1], x2 = v[1][2 * q + 1]; v[0][2 * q + 1] = x1 * cs[2] - x2 * cs[3]; v[1][2 * q + 1] = x2 * cs[2] + x1 * cs[3]; } }
        } else if (type == 2) {
#pragma unroll
          for (int bj = 0; bj < 2; ++bj)
#pragma unroll
            for (int e = 0; e < 8; ++e) v[bj][e] = v[bj][e] * sigmoidf_(v[bj][e]);
        } else if (type == 3) {
#pragma unroll
          for (int bj = 0; bj < 2; ++bj)
#pragma unroll
            for (int e = 0; e < 8; ++e) v[bj][e] = sigmoidf_(v[bj][e]);
        }
#pragma unroll
        for (int bj = 0; bj < 2; ++bj) {
          const int col8 = colt + 64 * wc + 32 * bj + 8 * fq;
          u32x4 w; w[0] = cvtpk(v[bj][0], v[bj][1]); w[1] = cvtpk(v[bj][2], v[bj][3]); w[2] = cvtpk(v[bj][4], v[bj][5]); w[3] = cvtpk(v[bj][6], v[bj][7]);
          if (type == 3) {
            const int gate = (col8 >= C_GB) ? 1 : 0, gc = col8 - (gate ? C_GB : C_GA);
            *(u32x4*)(gbuf + gbuf_off(gate, row >> 5, gc >> 4, ((gc >> 3) & 1) * 32 + (row & 31))) = w;
          } else {
            *(u32x4*)(proj + (size_t)row * CT + col8) = w;
          }
        }
        asm volatile("" ::: "memory");
      }
  }
  __device__ __forceinline__ void qknorm(const pg8::f32x4 (&acc)[2][2][4][2], const pg8::Unit& u, int wr, int wc, int fr, int fq) const {
    const int colt = u.pn * 256, wid = wr * 4 + wc;
    const float* g = (colt < C_KB) ? qn_g : kn_g;
#pragma unroll
    for (int ai = 0; ai < 2; ++ai)
#pragma unroll
      for (int m = 0; m < 4; ++m) {
        float ss = 0.f;
#pragma unroll
        for (int bj = 0; bj < 2; ++bj)
#pragma unroll
          for (int n = 0; n < 2; ++n)
#pragma unroll
            for (int e = 0; e < 4; ++e) ss += acc[ai][bj][m][n][e] * acc[ai][bj][m][n][e];
        ss += __shfl_xor(ss, 16); ss += __shfl_xor(ss, 32);
        if (fq == 0) xch[wid * 128 + (ai * 4 + m) * 16 + fr] = ss;
        asm volatile("" ::: "memory");
      }
    asm volatile("s_waitcnt lgkmcnt(0)" ::: "memory");
    __builtin_amdgcn_s_barrier();
    asm volatile("" ::: "memory");
    const int hg = wc & 1;
#pragma unroll
    for (int ai = 0; ai < 2; ++ai)
#pragma unroll
      for (int m = 0; m < 4; ++m) {
        const int row = u.pm * 256 + ai * 128 + wr * 64 + m * 16 + fr;
        const float tot = xch[wid * 128 + (ai * 4 + m) * 16 + fr] + xch[(wid ^ 1) * 128 + (ai * 4 + m) * 16 + fr];
        const float rinv = rsqrtf(tot * (1.0f / 128.0f) + EPS);
        float v[2][8];
#pragma unroll
        for (int bj = 0; bj < 2; ++bj) { const f32x4 g0 = *(const f32x4*)(g + hg * 64 + bj * 32 + 8 * fq), g1 = *(const f32x4*)(g + hg * 64 + bj * 32 + 8 * fq + 4);
#pragma unroll
          for (int e = 0; e < 4; ++e) { v[bj][e] = acc[ai][bj][m][0][e] * rinv * g0[e]; v[bj][4 + e] = acc[ai][bj][m][1][e] * rinv * g1[e]; } }
        const int s_ = row & (SEQ - 1), pos = hg ? (s_ & 63) : (s_ >> 6);
        const f32x4* tp = (const f32x4*)(rope + pos * 32 + 8 * fq);
#pragma unroll
        for (int q = 0; q < 4; ++q) { const f32x4 cs = tp[q];
          { const float x1 = v[0][2 * q], x2 = v[1][2 * q]; v[0][2 * q] = x1 * cs[0] - x2 * cs[1]; v[1][2 * q] = x2 * cs[0] + x1 * cs[1]; }
          { const float x1 = v[0][2 * q + 1], x2 = v[1][2 * q + 1]; v[0][2 * q + 1] = x1 * cs[2] - x2 * cs[3]; v[1][2 * q + 1] = x2 * cs[2] + x1 * cs[3]; } }
#pragma unroll
        for (int bj = 0; bj < 2; ++bj) {
          const int col8 = colt + 64 * wc + 32 * bj + 8 * fq;
          u32x4 w; w[0] = cvtpk(v[bj][0], v[bj][1]); w[1] = cvtpk(v[bj][2], v[bj][3]); w[2] = cvtpk(v[bj][4], v[bj][5]); w[3] = cvtpk(v[bj][6], v[bj][7]);
          *(u32x4*)(proj + (size_t)row * CT + col8) = w;
        }
        asm volatile("" ::: "memory");
      }
  }
};
struct SchedG1 {
  int b;
  __device__ __forceinline__ bool next(int i, pg8::Unit& u) const {
    int id;
    if (b < 160) { if (i >= 5) return false; if (i == 4) { u.pm = b & 31; u.pn = 16 + (b >> 5); return true; } id = b + 160 * i; }
    else { if (i >= 5) return false; id = 640 + (b - 160) + 96 * i; }
    const int ct = id >> 5; u.pm = id & 31; u.pn = (ct < 16) ? ct : (21 + (ct - 16)); return true;
  }
  __device__ __forceinline__ void a_ready(const pg8::Unit&) const {}
  __device__ __forceinline__ void done(const pg8::Unit&) const {}
};

#define XB_TMO      128
#define XB_XCNT(j)  (256  + 64 * (j))
#define XB_XSUB(j)  (1280 + 64 * (j))
#define XB_XGEN(j)  (2304 + 64 * (j))
#define XB_TOP      3328
#define XB_TOPGEN   3392
#define XCD_BAR_WORDS 3456
#define XB_SPIN_CAP (1u << 18)

__device__ __forceinline__ unsigned xb_ld(unsigned* p)              { return __hip_atomic_load(p, __ATOMIC_RELAXED, __HIP_MEMORY_SCOPE_AGENT); }
__device__ __forceinline__ unsigned xb_add(unsigned* p, unsigned v) { return __hip_atomic_fetch_add(p, v, __ATOMIC_RELAXED, __HIP_MEMORY_SCOPE_AGENT); }
__device__ __forceinline__ unsigned xb_xcc_id() { return (unsigned)__builtin_amdgcn_s_getreg((3 << 11) | 20) & 0xFu; }
#define XB_SPIN(cond, bar) do { unsigned _sp = 0; while (cond) { __builtin_amdgcn_s_sleep(1); \
    if ((++_sp & 255u) == 0u) { if (xb_ld(&(bar)[XB_TMO])) break; if (_sp > XB_SPIN_CAP) { atomicAdd(&(bar)[XB_TMO], 1u); break; } } } } while (0)

struct XcdBarrier {
    unsigned* bar; unsigned x;
    volatile LAS unsigned* st;
};

__device__ __forceinline__ XcdBarrier xcd_barrier_post(unsigned* bar, volatile LAS unsigned* st) {
    XcdBarrier b; b.bar = bar; b.x = xb_xcc_id(); b.st = st;
    if (threadIdx.x == 0) (void)xb_add(&bar[XB_XCNT(b.x)], 1u);
    return b;
}
__device__ __forceinline__ void xcd_barrier_complete(unsigned* bar, unsigned x, unsigned& nloc, unsigned& nx) {
    const unsigned G = gridDim.x * gridDim.y * gridDim.z;
    unsigned sum, cnt, mine, sp = 0u;
    for (;;) {
        sum = 0u; cnt = 0u; mine = 0u;
#pragma unroll
        for (unsigned j = 0; j < 16; ++j) { const unsigned c = xb_ld(&bar[XB_XCNT(j)]); sum += c; cnt += (c > 0u) ? 1u : 0u; mine = (j == x) ? c : mine; }
        if (sum == G) break;
        __builtin_amdgcn_s_sleep(1);
        if ((++sp & 255u) == 0u) { if (xb_ld(&bar[XB_TMO])) break; if (sp > XB_SPIN_CAP) { atomicAdd(&bar[XB_TMO], 1u); break; } }
    }
    nloc = mine > 0u ? mine : 1u; nx = cnt > 0u ? cnt : 1u;
}

__device__ __forceinline__ void xcd_barrier(const XcdBarrier& b) {
    asm volatile("s_waitcnt vmcnt(0)" ::: "memory");
    __syncthreads();
    if (threadIdx.x == 0) {
        unsigned* bar = b.bar;
        __builtin_amdgcn_s_waitcnt(0);
        unsigned nloc = b.st[0], nx = b.st[1];
        if (nloc == 0u) { xcd_barrier_complete(bar, b.x, nloc, nx); b.st[0] = nloc; b.st[1] = nx; }
        const unsigned old = xb_add(&bar[XB_XSUB(b.x)], 1u);
        const unsigned gen = old / nloc;
        if (old + 1u == (gen + 1u) * nloc) {
            __builtin_amdgcn_fence(__ATOMIC_RELEASE, "agent");
            asm volatile("s_waitcnt vmcnt(0)" ::: "memory");
            const unsigned og = xb_add(&bar[XB_TOP], 1u);
            const unsigned tg = og / nx;
            if (og + 1u == (tg + 1u) * nx) xb_add(&bar[XB_TOPGEN], 1u);
            else XB_SPIN(xb_ld(&bar[XB_TOPGEN]) == tg, bar);
            __builtin_amdgcn_fence(__ATOMIC_ACQUIRE, "agent");
            xb_add(&bar[XB_XGEN(b.x)], 1u);
            asm volatile("s_waitcnt vmcnt(0)" ::: "memory");
        } else {
            XB_SPIN(xb_ld(&bar[XB_XGEN(b.x)]) == gen, bar);
            __builtin_amdgcn_fence(__ATOMIC_ACQUIRE, "agent");
            asm volatile("s_waitcnt vmcnt(0)" ::: "memory");
        }
    }
    __syncthreads();
}


__device__ __forceinline__ int launder(int x) { asm volatile("" : "+v"(x)); return x; }

__device__ __forceinline__ void rot4(float (&x1)[4], float (&x2)[4], const f32x4 ca, const f32x4 cb) {
  const float c[4] = {ca[0], ca[2], cb[0], cb[2]}, sn[4] = {ca[1], ca[3], cb[1], cb[3]};
#pragma unroll
  for (int e = 0; e < 4; ++e) { const float a = x1[e] * c[e] - x2[e] * sn[e], bb = x2[e] * c[e] + x1[e] * sn[e]; x1[e] = a; x2[e] = bb; }
}
__device__ __forceinline__ u32x4 pack8(const float (&a)[4], const float (&b)[4]) {
  const unsigned a0 = cvtpk(a[0], a[1]), a1 = cvtpk(a[2], a[3]), b0 = cvtpk(b[0], b[1]), b1 = cvtpk(b[2], b[3]);
  auto r0 = __builtin_amdgcn_permlane32_swap(a0, b0, false, false); auto r1 = __builtin_amdgcn_permlane32_swap(a1, b1, false, false);
  u32x4 w = {r0[0], r1[0], r0[1], r1[1]}; return w;
}
template <int TYPE>
__device__ __forceinline__ void epi1_group(const Params& p, const f32x16 (&acc)[2][4], int mi, int gq, int s, int hi, float rinv, const float* g, float (&v)[4][4]) {
  const int i0 = 8 * gq + 4 * hi;
#pragma unroll
  for (int ni = 0; ni < 4; ++ni)
#pragma unroll
    for (int e = 0; e < 4; ++e) v[ni][e] = acc[mi][ni][4 * gq + e];
  if (TYPE == 0) {
    const f32x4* tp = (const f32x4*)(p.rope + s * 32 + i0);
    const f32x4 ca = tp[0], cb = tp[1];
    rot4(v[0], v[1], ca, cb); rot4(v[2], v[3], ca, cb);
  } else if (TYPE == 1) {
#pragma unroll
    for (int ni = 0; ni < 4; ++ni) { const f32x4 gv = *(const f32x4*)(g + ni * 32 + i0);
#pragma unroll
      for (int e = 0; e < 4; ++e) v[ni][e] = v[ni][e] * rinv * gv[e]; }
    const f32x4* t0 = (const f32x4*)(p.rope + (s >> 6) * 32 + i0);
    const f32x4* t1 = (const f32x4*)(p.rope + (s & 63) * 32 + i0);
    const f32x4 a0 = t0[0], b0 = t0[1], a1 = t1[0], b1 = t1[1];
    rot4(v[0], v[1], a0, b0); rot4(v[2], v[3], a1, b1);
  } else if (TYPE == 2) {
#pragma unroll
    for (int ni = 0; ni < 4; ++ni)
#pragma unroll
      for (int e = 0; e < 4; ++e) v[ni][e] = v[ni][e] * sigmoidf_(v[ni][e]);
  } else if (TYPE == 3) {
#pragma unroll
    for (int ni = 0; ni < 4; ++ni)
#pragma unroll
      for (int e = 0; e < 4; ++e) v[ni][e] = sigmoidf_(v[ni][e]);
  }
}
template <int TYPE>
__device__ __forceinline__ void epi1(const Params& p, const f32x16 (&acc)[2][4], int rowb, int col0, int r32, int hi, const float* g) {
#pragma unroll
  for (int mi = 0; mi < 2; ++mi) {
    const int row = rowb + mi * 32 + r32;
    const int s = row & (SEQ - 1);
    float rinv = 1.f;
    if (TYPE == 1) {
      float ss = 0.f;
#pragma unroll
      for (int ni = 0; ni < 4; ++ni)
#pragma unroll
        for (int r = 0; r < 16; ++r) ss += acc[mi][ni][r] * acc[mi][ni][r];
      ss += __shfl_xor(ss, 32);
      rinv = rsqrtf(ss * (1.0f / 128.0f) + EPS);
    }
    bf16_t* dst = p.proj + (size_t)row * CT + col0 + 8 * hi;
#pragma unroll
    for (int j = 0; j < 2; ++j) {
      float va[4][4], vb[4][4];
      epi1_group<TYPE>(p, acc, mi, 2 * j, s, hi, rinv, g, va);
      epi1_group<TYPE>(p, acc, mi, 2 * j + 1, s, hi, rinv, g, vb);
      if (TYPE == 3) {
        const int gate = (col0 >= C_GB) ? 1 : 0, gc = col0 - (gate ? C_GB : C_GA);
        const int rb = (rowb >> 5) + mi, lane_ = hi * 32 + r32;
#pragma unroll
        for (int ni = 0; ni < 4; ++ni) *(u32x4*)(p.gbuf + gbuf_off(gate, rb, (gc >> 4) + ni * 2 + j, lane_)) = pack8(va[ni], vb[ni]);
      } else {
#pragma unroll
        for (int ni = 0; ni < 4; ++ni) *(u32x4*)(dst + ni * 32 + 16 * j) = pack8(va[ni], vb[ni]);
      }
    }
    asm volatile("" ::: "memory");
  }
}

__device__ __forceinline__ void phase_gemm1(const Params& p, char* lds) {
  const int tid = threadIdx.x, wid = tid >> 6, lane = tid & 63, wm = wid >> 1, wn = wid & 1;
  const int b = blockIdx.x;
  const bool has_tail = b < 128;
  {
    pg8::Gemm g{p.h, p.winT, MTOK, CT, DM};
    SchedG1 S{b}; EpiG1 E{p.proj, p.gbuf, p.rope, p.qn_g, p.kn_g, (float*)(lds + 131072 + 64)};
    pg8::gemm_phase<EpiG1, SchedG1, true, true>((LAS unsigned char*)lds, g, S, E);
  }
  const int nmine = 0;
#define MINE_ID(i_) (b)
#define MINE_PN(id_) (16 + ((id_) >> 5))
  if (nmine > 0) { const int id0 = MINE_ID(0); gemm_prefetch<4>(p.h + (size_t)(id0 & 31) * 256 * DM, DM, p.winT + (size_t)MINE_PN(id0) * 256 * DM, DM, lds); }
  for (int i = 0; i < nmine; ++i) {
    const int id = MINE_ID(i);
    const int pm = id & 31, pn = MINE_PN(id);
    f32x16 acc[2][4];
#pragma unroll
    for (int mi = 0; mi < 2; ++mi)
#pragma unroll
      for (int ni = 0; ni < 4; ++ni) acc[mi][ni] = f32x16{};
    gemm_mainloop<4, true>(p.h + (size_t)pm * 256 * DM, DM, p.winT + (size_t)pn * 256 * DM, DM, DM, acc, lds);
    if (i + 1 < nmine) { const int idn = MINE_ID(i + 1); gemm_prefetch<4>(p.h + (size_t)(idn & 31) * 256 * DM, DM, p.winT + (size_t)MINE_PN(idn) * 256 * DM, DM, lds); }
    else if (has_tail) gemm_prefetch<2>(p.h + (size_t)(b & 31) * 256 * DM, DM, p.winT + (size_t)(40 * 256 + (b >> 5) * 128) * DM, DM, lds);
    const int l2 = launder(lane), r32 = l2 & 31, hi = l2 >> 5;
    const int col0 = pn * 256 + wn * 128;
    const int rowb = pm * 256 + wm * 64;
    if (col0 < C_KB) epi1<1>(p, acc, rowb, col0, r32, hi, p.qn_g);
    else epi1<1>(p, acc, rowb, col0, r32, hi, p.kn_g);
  }
  if (nmine == 0 && has_tail) gemm_prefetch<2>(p.h + (size_t)(b & 31) * 256 * DM, DM, p.winT + (size_t)(40 * 256 + (b >> 5) * 128) * DM, DM, lds);
#undef MINE_ID
#undef MINE_PN
  if (!has_tail) transpose_late_weights(p, lds, (int)blockIdx.x - 128, (int)gridDim.x - 128);
  if (has_tail) {
    const int u = blockIdx.x;
    const int pm = u & 31, cbase = 40 * 256 + (u >> 5) * 128;
    f32x16 acc[2][2];
#pragma unroll
    for (int mi = 0; mi < 2; ++mi)
#pragma unroll
      for (int ni = 0; ni < 2; ++ni) acc[mi][ni] = f32x16{};
    gemm_mainloop<2, true>(p.h + (size_t)pm * 256 * DM, DM, p.winT + (size_t)cbase * DM, DM, DM, acc, lds);
    const int l2 = launder(lane), r32 = l2 & 31, hi = l2 >> 5;
    const int col0 = cbase + wn * 64;
    const int rowb = pm * 256 + wm * 64;
#pragma unroll
    for (int mi = 0; mi < 2; ++mi) {
      const int rb = (rowb >> 5) + mi, cb0 = (col0 - C_GB) >> 4;
#pragma unroll
      for (int ni = 0; ni < 2; ++ni) {
        float o[4][4];
#pragma unroll
        for (int gq = 0; gq < 4; ++gq)
#pragma unroll
          for (int e = 0; e < 4; ++e) o[gq][e] = sigmoidf_(acc[mi][ni][4 * gq + e]);
        *(u32x4*)(p.gbuf + gbuf_off(1, rb, cb0 + ni * 2, l2)) = pack8(o[0], o[1]);
        *(u32x4*)(p.gbuf + gbuf_off(1, rb, cb0 + ni * 2 + 1, l2)) = pack8(o[2], o[3]);
      }
    }
  }
}

struct EpiG2 {
  static constexpr bool PERM = true, AFTER_DRAIN = false, COLMAP = false;
  const bf16_t* gbuf; bf16_t* merged;
  __device__ __forceinline__ void operator()(const pg8::f32x4 (&acc)[2][2][4][2], const pg8::Unit& u, int wr, int wc, int fr, int fq) const {
    const int pass = u.pm >> 5, pm = u.pm & 31, pn = u.pn & 7;
#pragma unroll
    for (int ai = 0; ai < 2; ++ai)
#pragma unroll
      for (int m = 0; m < 4; ++m) {
        const int row = pm * 256 + ai * 128 + wr * 64 + m * 16 + fr;
#pragma unroll
        for (int bj = 0; bj < 2; ++bj) {
          const int col8 = pn * 256 + bj * 128 + wc * 32 + 8 * fq;
          const u32x4 gw = __builtin_nontemporal_load((const u32x4*)(gbuf + gbuf_off(pass, row >> 5, col8 >> 4, ((col8 >> 3) & 1) * 32 + (row & 31))));
          bf16_t* mp = merged + (size_t)row * DM + col8;
          float sg[8], o[8];
#pragma unroll
          for (int i = 0; i < 4; ++i) { sg[2 * i] = __uint_as_float(gw[i] << 16); sg[2 * i + 1] = __uint_as_float(gw[i] & 0xffff0000u); }
#pragma unroll
          for (int e = 0; e < 4; ++e) { o[e] = sg[e] * acc[ai][bj][m][0][e]; o[4 + e] = sg[4 + e] * acc[ai][bj][m][1][e]; }
          if (pass) {
            const u32x4 tw = *(const u32x4*)mp;
#pragma unroll
            for (int i = 0; i < 4; ++i) { o[2 * i] += __uint_as_float(tw[i] << 16); o[2 * i + 1] += __uint_as_float(tw[i] & 0xffff0000u); }
          }
          u32x4 w; w[0] = cvtpk(o[0], o[1]); w[1] = cvtpk(o[2], o[3]); w[2] = cvtpk(o[4], o[5]); w[3] = cvtpk(o[6], o[7]);
          *(u32x4*)mp = w;
        }
        asm volatile("" ::: "memory");
      }
  }
};
struct SchedG2 {
  int b;
  __device__ __forceinline__ bool next(int i, pg8::Unit& u) const { if (i >= 2) return false; u.pm = (b & 31) + 32 * i; u.pn = (b >> 5) + 8 * i; return true; }
  __device__ __forceinline__ void a_ready(const pg8::Unit&) const {}
  __device__ __forceinline__ void done(const pg8::Unit&) const {}
};
__device__ __forceinline__ void phase_gemm2(const Params& p, char* lds) {
  pg8::Gemm g{p.U, p.waT, 2 * MTOK, 2 * DM, BW};
  SchedG2 S{(int)blockIdx.x}; EpiG2 E{p.gbuf, p.merged};
  pg8::gemm_phase<EpiG2, SchedG2, true, true>((LAS unsigned char*)lds, g, S, E);
}

struct EpiG3 {
  static constexpr bool PERM = true, AFTER_DRAIN = true, COLMAP = false;
  const float* x; float* out; float* ssq; const float* fg; const XcdBarrier* xb;
  __device__ __forceinline__ void fused(pg8::f32x4 (&acc)[2][2][4][2], const pg8::Unit& u, int wr, int wc, int fr, int fq, LAS unsigned char*, int, int) const {
    const int colw = u.pn * 256 + wc * 32 + 8 * fq;
#pragma unroll
    for (int ai = 0; ai < 2; ++ai)
#pragma unroll
      for (int m = 0; m < 4; ++m) {
        const int row = u.pm * 256 + ai * 128 + wr * 64 + m * 16 + fr;
        float ss = 0.f;
#pragma unroll
        for (int bj = 0; bj < 2; ++bj) {
          const float* xp = x + (size_t)row * DM + colw + bj * 128;
          const f32x4 xa = __builtin_nontemporal_load((const f32x4*)xp), xc = __builtin_nontemporal_load((const f32x4*)(xp + 4));
#pragma unroll
          for (int e = 0; e < 4; ++e) { const float y0 = acc[ai][bj][m][0][e] + xa[e], y1 = acc[ai][bj][m][1][e] + xc[e]; acc[ai][bj][m][0][e] = y0; acc[ai][bj][m][1][e] = y1; ss += y0 * y0 + y1 * y1; }
        }
        ss += __shfl_xor(ss, 16); ss += __shfl_xor(ss, 32);
        if (fq == 0) ssq[row * 32 + u.pn * 4 + wc] = ss;
        asm volatile("" ::: "memory");
      }
    xcd_barrier(*xb);
#pragma unroll
    for (int ai = 0; ai < 2; ++ai)
#pragma unroll
      for (int m = 0; m < 4; ++m) {
        const int row = u.pm * 256 + ai * 128 + wr * 64 + m * 16 + fr;
        const f32x4* sp = (const f32x4*)(ssq + row * 32);
        float tot = 0.f;
#pragma unroll
        for (int q = 0; q < 8; ++q) { const f32x4 t = sp[q]; tot += (t[0] + t[1]) + (t[2] + t[3]); }
        const float rinv = rsqrtf(tot * (1.0f / DM) + EPS);
#pragma unroll
        for (int bj = 0; bj < 2; ++bj) {
          const int col = colw + bj * 128;
          const f32x4 g0 = *(const f32x4*)(fg + col), g1 = *(const f32x4*)(fg + col + 4);
          f32x4 o0, o1;
#pragma unroll
          for (int e = 0; e < 4; ++e) { o0[e] = acc[ai][bj][m][0][e] * rinv * g0[e]; o1[e] = acc[ai][bj][m][1][e] * rinv * g1[e]; }
          float* op = out + (size_t)row * DM + col;
          __builtin_nontemporal_store(o0, (f32x4*)op); __builtin_nontemporal_store(o1, (f32x4*)(op + 4));
        }
        asm volatile("" ::: "memory");
      }
  }
};
struct SchedOne {
  int b;
  __device__ __forceinline__ bool next(int i, pg8::Unit& u) const { if (i >= 1) return false; u.pm = b & 31; u.pn = b >> 5; return true; }
  __device__ __forceinline__ void a_ready(const pg8::Unit&) const {}
  __device__ __forceinline__ void done(const pg8::Unit&) const {}
};
__device__ __forceinline__ void phase_gemm3_final(const Params& p, char* lds, const XcdBarrier& xb) {
  pg8::Gemm g{p.merged, p.woT, MTOK, DM, DM};
  SchedOne S{(int)blockIdx.x}; EpiG3 E{p.x, p.out, p.ssq, p.final_g, &xb};
  pg8::gemm_phase<EpiG3, SchedOne, false, false>((LAS unsigned char*)lds, g, S, E);
}

constexpr int KVBLK = 64;
constexpr size_t SHM_V = KVBLK * 128 * 2, SHM_K = KVBLK * 128 * 2;
constexpr int ATT_TILE = 32768, ATT_WS = 131072 + 64;
constexpr float THR = 8.f;
#define KSWZ(row, colB) ((row) * 256 + ((colB) ^ (((row) & 7) << 4)))

template <int DQK> struct AttnC { static constexpr float SCALE = (DQK == 64) ? 0.125f : 0.088388347648318440f; };

template <int DQK>
__device__ __forceinline__ void partialSM(f32x16& p0, f32x16& p1, float& m_reg, float& mn, float& alpha) {
  constexpr float SCALE = AttnC<DQK>::SCALE;
  constexpr float C = SCALE * 1.4426950408889634f;
  float pmax = p0[0];
#pragma unroll
  for (int r = 1; r < 16; ++r) pmax = fmaxf(pmax, p0[r]);
#pragma unroll
  for (int r = 0; r < 16; ++r) pmax = fmaxf(pmax, p1[r]);
  { auto rr = __builtin_amdgcn_permlane32_swap(__float_as_uint(pmax), __float_as_uint(pmax), false, false);
    pmax = fmaxf(__uint_as_float(rr[0]), __uint_as_float(rr[1])); }
  if (__builtin_expect(__all(pmax - m_reg <= THR / SCALE), 1)) { mn = m_reg; alpha = 1.f; }
  else { mn = fmaxf(m_reg, pmax); alpha = __builtin_amdgcn_exp2f((m_reg - mn) * C); m_reg = mn; }
  const float mnC = -mn * C;
#pragma unroll
  for (int r = 0; r < 16; ++r) p0[r] = fmaf(p0[r], C, mnC);
#pragma unroll
  for (int r = 0; r < 16; ++r) p1[r] = fmaf(p1[r], C, mnC);
#pragma unroll
  for (int r = 0; r < 16; ++r) p0[r] = __builtin_amdgcn_exp2f(p0[r]);
}
__device__ __forceinline__ void finishSM(f32x16& p0, f32x16& p1, float alpha, float& l_reg, bf16x8& pa0, bf16x8& pa1, bf16x8& pa2, bf16x8& pa3) {
#pragma unroll
  for (int r = 0; r < 16; ++r) p1[r] = __builtin_amdgcn_exp2f(p1[r]);
  float ps = 0;
#pragma unroll
  for (int r = 0; r < 16; ++r) ps += p0[r];
#pragma unroll
  for (int r = 0; r < 16; ++r) ps += p1[r];
  { auto rr = __builtin_amdgcn_permlane32_swap(__float_as_uint(ps), __float_as_uint(ps), false, false);
    ps = __uint_as_float(rr[0]) + __uint_as_float(rr[1]); }
  l_reg = l_reg * alpha + ps;
#define PK4(P, BASE, OUT) do { unsigned a0 = cvtpk(P[BASE + 0], P[BASE + 1]), a1 = cvtpk(P[BASE + 2], P[BASE + 3]);   \
    unsigned b0 = cvtpk(P[BASE + 4], P[BASE + 5]), b1 = cvtpk(P[BASE + 6], P[BASE + 7]);                              \
    auto r0 = __builtin_amdgcn_permlane32_swap(a0, b0, false, false); auto r1 = __builtin_amdgcn_permlane32_swap(a1, b1, false, false); \
    u32x4 w = {r0[0], r1[0], r0[1], r1[1]}; OUT = *reinterpret_cast<bf16x8*>(&w); } while (0)
  PK4(p0, 0, pa0); PK4(p0, 8, pa1); PK4(p1, 0, pa2); PK4(p1, 8, pa3);
#undef PK4
}
template <int DQK>
__device__ __forceinline__ void qkt(f32x16& p0, f32x16& p1, const LAS char* Ks, const bf16x8* qr, int r32, int hi) {
  constexpr int PITCH = DQK * 2;
  const int sw = (DQK == 128) ? (r32 & 7) : ((r32 >> 1) & 7);
  p0 = f32x16{}; p1 = f32x16{};
#pragma unroll
  for (int d0 = 0; d0 < DQK / 16; ++d0) { const int co = ((d0 * 2 + hi) ^ sw) << 4;
    bf16x8 b0 = *reinterpret_cast<const LAS bf16x8*>(Ks + r32 * PITCH + co);
    bf16x8 b1 = *reinterpret_cast<const LAS bf16x8*>(Ks + (32 + r32) * PITCH + co);
    p0 = __builtin_amdgcn_mfma_f32_32x32x16_bf16(b0, qr[d0], p0, 0, 0, 0);
    p1 = __builtin_amdgcn_mfma_f32_32x32x16_bf16(b1, qr[d0], p1, 0, 0, 0); }
}
__device__ __forceinline__ int v_st(int k, int c) { const int kk = (k & ~0xC) | ((k & 4) << 1) | ((k & 8) >> 1); return ((kk >> 3) * 4 + (c >> 5)) * 512 + ((kk & 7) * 32 + (c & 31)) * 2; }
__device__ __forceinline__ int v_rd_base(int lane) { return ((lane & 3) << 3) | (((lane >> 2) & 3) << 6) | (((lane >> 4) & 1) << 5) | (((lane >> 5) & 1) << 8); }
constexpr int v_rd_off(int d0, int ks, int half) { return d0 * 512 + ks * 4096 + half * 2048; }
template <int OFF> __device__ __forceinline__ s16x4 tr_read(int vb) {
  s16x4 r; asm volatile("ds_read_b64_tr_b16 %0, %1 offset:%2" : "=&v"(r) : "v"(vb), "i"(OFF) : "memory"); return r;
}
template <int D0> __device__ __forceinline__ void pv_one(f32x16& od, int vb, bf16x8 pa0, bf16x8 pa1, bf16x8 pa2, bf16x8 pa3) {
  const s16x4 l0 = tr_read<v_rd_off(D0, 0, 0)>(vb), h0 = tr_read<v_rd_off(D0, 0, 1)>(vb), l1 = tr_read<v_rd_off(D0, 1, 0)>(vb), h1 = tr_read<v_rd_off(D0, 1, 1)>(vb);
  const s16x4 l2 = tr_read<v_rd_off(D0, 2, 0)>(vb), h2 = tr_read<v_rd_off(D0, 2, 1)>(vb), l3 = tr_read<v_rd_off(D0, 3, 0)>(vb), h3 = tr_read<v_rd_off(D0, 3, 1)>(vb);
  asm volatile("s_waitcnt lgkmcnt(0)" ::: "memory"); SBAR();
#define PK(L, H) (bf16x8){L[0], L[1], L[2], L[3], H[0], H[1], H[2], H[3]}
  od = __builtin_amdgcn_mfma_f32_32x32x16_bf16(pa0, PK(l0, h0), od, 0, 0, 0);
  od = __builtin_amdgcn_mfma_f32_32x32x16_bf16(pa1, PK(l1, h1), od, 0, 0, 0);
  od = __builtin_amdgcn_mfma_f32_32x32x16_bf16(pa2, PK(l2, h2), od, 0, 0, 0);
  od = __builtin_amdgcn_mfma_f32_32x32x16_bf16(pa3, PK(l3, h3), od, 0, 0, 0);
#undef PK
}
template <int DQK, class ISS>
__device__ __forceinline__ void pv_sm(f32x16 (&o)[4], int vb, bf16x8 pa0, bf16x8 pa1, bf16x8 pa2, bf16x8 pa3,
                                      f32x16& p0, f32x16& p1, float& m_reg, float& mn, float& alpha, const ISS& iss) {
  constexpr float SCALE = AttnC<DQK>::SCALE;
  constexpr float C = SCALE * 1.4426950408889634f;
#define PK(L, H) (bf16x8){L[0], L[1], L[2], L[3], H[0], H[1], H[2], H[3]}
#define PV_READS(D0) const s16x4 l0 = tr_read<v_rd_off(D0, 0, 0)>(vb), h0 = tr_read<v_rd_off(D0, 0, 1)>(vb), l1 = tr_read<v_rd_off(D0, 1, 0)>(vb), h1 = tr_read<v_rd_off(D0, 1, 1)>(vb); \
    const s16x4 l2 = tr_read<v_rd_off(D0, 2, 0)>(vb), h2 = tr_read<v_rd_off(D0, 2, 1)>(vb), l3 = tr_read<v_rd_off(D0, 3, 0)>(vb), h3 = tr_read<v_rd_off(D0, 3, 1)>(vb); \
    asm volatile("s_waitcnt lgkmcnt(0)" ::: "memory"); SBAR();
#define PV_MMA(D0) o[D0] = __builtin_amdgcn_mfma_f32_32x32x16_bf16(pa0, PK(l0, h0), o[D0], 0, 0, 0); o[D0] = __builtin_amdgcn_mfma_f32_32x32x16_bf16(pa1, PK(l1, h1), o[D0], 0, 0, 0); \
    o[D0] = __builtin_amdgcn_mfma_f32_32x32x16_bf16(pa2, PK(l2, h2), o[D0], 0, 0, 0); o[D0] = __builtin_amdgcn_mfma_f32_32x32x16_bf16(pa3, PK(l3, h3), o[D0], 0, 0, 0);
  float pmax, mnC;
  { PV_READS(0)
    iss(0);
    pmax = p0[0];
#pragma unroll
    for (int r = 1; r < 16; ++r) pmax = fmaxf(pmax, p0[r]);
    PV_MMA(0) }
  { PV_READS(1)
    iss(1);
#pragma unroll
    for (int r = 0; r < 16; ++r) pmax = fmaxf(pmax, p1[r]);
    { auto rr = __builtin_amdgcn_permlane32_swap(__float_as_uint(pmax), __float_as_uint(pmax), false, false);
      pmax = fmaxf(__uint_as_float(rr[0]), __uint_as_float(rr[1])); }
    const bool keep = __all(pmax - m_reg <= THR / SCALE);
    mn = keep ? m_reg : fmaxf(m_reg, pmax);
    alpha = __builtin_amdgcn_exp2f((m_reg - mn) * C);
    m_reg = mn; mnC = -mn * C;
    PV_MMA(1) }
  { PV_READS(2)
    iss(2);
#pragma unroll
    for (int r = 0; r < 16; ++r) p0[r] = fmaf(p0[r], C, mnC);
#pragma unroll
    for (int r = 0; r < 16; ++r) p1[r] = fmaf(p1[r], C, mnC);
    PV_MMA(2) }
  { PV_READS(3)
    iss(3);
#pragma unroll
    for (int r = 0; r < 16; ++r) p0[r] = __builtin_amdgcn_exp2f(p0[r]);
    PV_MMA(3) }
#undef PK
#undef PV_READS
#undef PV_MMA
}
__device__ __forceinline__ void pv_d0(f32x16 (&o)[4], int vb, bf16x8 pa0, bf16x8 pa1, bf16x8 pa2, bf16x8 pa3) {
  pv_one<0>(o[0], vb, pa0, pa1, pa2, pa3); pv_one<1>(o[1], vb, pa0, pa1, pa2, pa3); pv_one<2>(o[2], vb, pa0, pa1, pa2, pa3); pv_one<3>(o[3], vb, pa0, pa1, pa2, pa3);
}

template <int DQK>
__device__ __forceinline__ void attn_body(const bf16_t* __restrict__ Qb, const bf16_t* __restrict__ Kh, const bf16_t* __restrict__ Vh,
                                          char* lds, f32x16 (&o)[4], float& l_out) {
  constexpr int LD = CT;
  constexpr int NQ = DQK / 16, PK = DQK / 64, P = 2 + PK;
  const int tid = threadIdx.x, wid = __builtin_amdgcn_readfirstlane(tid >> 6), lane = tid & 63, r32 = lane & 31, hi = lane >> 5;
  LAS char* ldsl = (LAS char*)lds;
  float* ws = (float*)(lds + ATT_WS) + wid * 64; float* al_l = ws + 32;
  float m_reg = -1e30f, l_reg = 0;
#pragma unroll
  for (int d = 0; d < 4; ++d) o[d] = f32x16{};
  bf16x8 qr[NQ];
  const bf16_t* Qw = Qb + (size_t)(wid * 32 + r32) * LD + hi * 8;
#pragma unroll
  for (int d0 = 0; d0 < NQ; ++d0) qr[d0] = __builtin_nontemporal_load((const bf16x8*)(Qw + d0 * 16));
  unsigned vgo[2], kgo[2];
#pragma unroll
  for (int i = 0; i < 2; ++i) {
    const int kk = (i * 4 + (tid >> 7)) * 8 + ((tid & 31) >> 2), c = ((tid >> 5) & 3) * 32 + (tid & 3) * 8;
    const int k = (kk & ~0xC) | ((kk & 4) << 1) | ((kk & 8) >> 1);
    vgo[i] = (unsigned)(k * LD + c) * 2u;
    if (DQK == 128) { const int row = i * 32 + (tid >> 4), lc = (tid & 15) ^ (row & 7); kgo[i] = (unsigned)(row * LD + lc * 8) * 2u; }
    else { const int row = tid >> 3, lc = (tid & 7) ^ ((row >> 1) & 7); kgo[i] = (unsigned)(row * LD + lc * 8) * 2u; }
  }
  const char* Vb = (const char*)Vh; const char* Kb = (const char*)Kh;
#define A_ISSUE(t_) do { const size_t ko_ = (size_t)(t_) * (KVBLK * LD * 2); LAS char* bb_ = ldsl + ((t_) & 3) * ATT_TILE + wid * 1024; \
    __builtin_amdgcn_global_load_lds((const unsigned*)(Vb + ko_ + vgo[0]), (LAS unsigned*)(bb_), 16, 0, 0); \
    __builtin_amdgcn_global_load_lds((const unsigned*)(Vb + ko_ + vgo[1]), (LAS unsigned*)(bb_ + 8192), 16, 0, 0); \
    __builtin_amdgcn_global_load_lds((const unsigned*)(Kb + ko_ + kgo[0]), (LAS unsigned*)(bb_ + 16384), 16, 0, 0); \
    if constexpr (DQK == 128) __builtin_amdgcn_global_load_lds((const unsigned*)(Kb + ko_ + kgo[1]), (LAS unsigned*)(bb_ + 16384 + 8192), 16, 0, 0); } while (0)
  auto a_piece = [&](int t_, int j_) {
    const size_t ko_ = (size_t)t_ * (KVBLK * LD * 2); LAS char* bb_ = ldsl + (t_ & 3) * ATT_TILE + wid * 1024;
    if (j_ == 0) __builtin_amdgcn_global_load_lds((const unsigned*)(Vb + ko_ + vgo[0]), (LAS unsigned*)(bb_), 16, 0, 0);
    else if (j_ == 1) __builtin_amdgcn_global_load_lds((const unsigned*)(Vb + ko_ + vgo[1]), (LAS unsigned*)(bb_ + 8192), 16, 0, 0);
    else if (j_ == 2) __builtin_amdgcn_global_load_lds((const unsigned*)(Kb + ko_ + kgo[0]), (LAS unsigned*)(bb_ + 16384), 16, 0, 0);
    else if (DQK == 128) __builtin_amdgcn_global_load_lds((const unsigned*)(Kb + ko_ + kgo[1]), (LAS unsigned*)(bb_ + 16384 + 8192), 16, 0, 0);
  };
#define A_WAITBAR(N) do { asm volatile("s_waitcnt vmcnt(%0)" :: "n"(N) : "memory"); __builtin_amdgcn_s_barrier(); asm volatile("" ::: "memory"); } while (0)
#define KBUF(t_) ((const LAS char*)(ldsl + ((t_) & 3) * ATT_TILE + 16384))
#define VBUF(t_) ((int)(uintptr_t)(ldsl + ((t_) & 3) * ATT_TILE) + vrb)
#define RESC(a) do { if (__any((a) < 1.f)) { if (hi == 0) al_l[r32] = (a); asm volatile("s_waitcnt lgkmcnt(0)" ::: "memory"); \
    _Pragma("unroll") for (int d = 0; d < 4; ++d) _Pragma("unroll") for (int r = 0; r < 16; ++r) o[d][r] *= al_l[crow(r, hi)]; } } while (0)
  const int vrb = v_rd_base(lane);
  f32x16 pA0, pA1, pB0, pB1; float mnA, mnB, alA, alB; bf16x8 pa0, pa1, pa2, pa3; constexpr int NT = SEQ / KVBLK;
  A_ISSUE(0); A_ISSUE(1);
  A_WAITBAR(P);
  qkt<DQK>(pA0, pA1, KBUF(0), qr, r32, hi); partialSM<DQK>(pA0, pA1, m_reg, mnA, alA);
  A_ISSUE(2);
  A_WAITBAR(P);
  for (int n = 1; n + 1 < NT; n += 2) {
    SBAR(); qkt<DQK>(pB0, pB1, KBUF(n), qr, r32, hi);
    finishSM(pA0, pA1, alA, l_reg, pa0, pa1, pa2, pa3); SBAR();
    pv_sm<DQK>(o, VBUF(n - 1), pa0, pa1, pa2, pa3, pB0, pB1, m_reg, mnB, alB, [&](int j_) { a_piece(n + 2, j_); });
    A_WAITBAR(P);
    RESC(alB);
    SBAR(); qkt<DQK>(pA0, pA1, KBUF(n + 1), qr, r32, hi);
    finishSM(pB0, pB1, alB, l_reg, pa0, pa1, pa2, pa3); SBAR();
    { const bool more_ = (n + 3 < NT); pv_sm<DQK>(o, VBUF(n), pa0, pa1, pa2, pa3, pA0, pA1, m_reg, mnA, alA, [&](int j_) { if (more_) a_piece(n + 3, j_); }); }
    if (n + 3 < NT) A_WAITBAR(P); else A_WAITBAR(0);
    RESC(alA);
  }
  SBAR(); qkt<DQK>(pB0, pB1, KBUF(NT - 1), qr, r32, hi);
  finishSM(pA0, pA1, alA, l_reg, pa0, pa1, pa2, pa3); SBAR();
  pv_sm<DQK>(o, VBUF(NT - 2), pa0, pa1, pa2, pa3, pB0, pB1, m_reg, mnB, alB, [](int) {});
  RESC(alB);
  finishSM(pB0, pB1, alB, l_reg, pa0, pa1, pa2, pa3); SBAR();
  pv_d0(o, VBUF(NT - 1), pa0, pa1, pa2, pa3);
  l_out = l_reg;
#undef A_ISSUE
#undef A_WAITBAR
#undef KBUF
#undef VBUF
#undef RESC
}

__device__ __forceinline__ void attn_rli(float l_reg, char* lds, float (&rli)[16]) {
  const int tid = threadIdx.x, wid = tid >> 6, lane = tid & 63, r32 = lane & 31, hi = lane >> 5;
  float* li_l = (float*)(lds + ATT_WS) + wid * 64;
  if (hi == 0) li_l[r32] = l_reg;
  asm volatile("s_waitcnt lgkmcnt(0)" ::: "memory");
#pragma unroll
  for (int r = 0; r < 16; ++r) rli[r] = __builtin_amdgcn_rcpf(li_l[crow(r, hi)]);
  asm volatile("s_waitcnt lgkmcnt(0)" ::: "memory");
}

constexpr int EPI_RS = 68, EPI_WAVE_BYTES = 32 * EPI_RS * 4;
__device__ __forceinline__ void epi_put_half(const f32x16 (&o)[4], const float (&rli)[16], float* sc, int half, int r32, int hi) {
#pragma unroll
  for (int d0h = 0; d0h < 2; ++d0h)
#pragma unroll
    for (int r = 0; r < 16; ++r) sc[crow(r, hi) * EPI_RS + d0h * 32 + r32] = o[half * 2 + d0h][r] * rli[r];
}
__device__ __forceinline__ void epi_get(const float* sc, int q, int lane, float (&v)[8]) {
  const f32x4* sp = (const f32x4*)(sc + (q * 8 + (lane >> 3)) * EPI_RS + (lane & 7) * 8);
  const f32x4 a = sp[0], bq = sp[1];
  v[0] = a[0]; v[1] = a[1]; v[2] = a[2]; v[3] = a[3]; v[4] = bq[0]; v[5] = bq[1]; v[6] = bq[2]; v[7] = bq[3];
}
__device__ __forceinline__ void unpack8(const u32x4 w, float (&z)[8]) {
#pragma unroll
  for (int i = 0; i < 4; ++i) { z[2 * i] = __uint_as_float(w[i] << 16); z[2 * i + 1] = __uint_as_float(w[i] & 0xffff0000u); }
}

__device__ __forceinline__ void phase_attn(const Params& p, char* lds) {
  const int tid = threadIdx.x, wid = tid >> 6, lane = tid & 63;
  float* sc = (float*)(lds + wid * EPI_WAVE_BYTES);
  for (int it = blockIdx.x; it < 512; it += gridDim.x) {
    const int j = it & 255, xcd = j & 7, slot = j >> 3;
    const int bh = xcd * 2 + (slot >> 4), qblk = slot & 15;
    const int b = bh >> 3, h = bh & 7;
    const size_t tok0 = (size_t)b * SEQ;
    const size_t rowq = tok0 + qblk * 256;
    const int rowbase = (int)rowq + wid * 32;
    f32x16 o[4]; float l_reg; float rli[16];
    if (it < 256) {
      const int kvh = h >> 2;
      attn_body<128>(p.proj + rowq * CT + C_QB + h * 128, p.proj + tok0 * CT + C_KB + kvh * 128, p.proj + tok0 * CT + C_VB + kvh * 128, lds, o, l_reg);
      attn_rli(l_reg, lds, rli);
      __syncthreads();
      const int l2 = launder(lane), r32 = l2 & 31, hi = l2 >> 5;
#pragma unroll
      for (int half = 0; half < 2; ++half) {
        epi_put_half(o, rli, sc, half, r32, hi);
#pragma unroll
        for (int q = 0; q < 4; ++q) {
          float v[8], z[8]; epi_get(sc, q, l2, v);
          const size_t row = (size_t)(rowbase + q * 8 + (l2 >> 3)); const int col = h * 128 + half * 64 + (l2 & 7) * 8;
          unpack8(__builtin_nontemporal_load((const u32x4*)(p.proj + row * CT + C_ZB + col)), z);
          u32x4 w; w[0] = cvtpk(v[0] * z[0], v[1] * z[1]); w[1] = cvtpk(v[2] * z[2], v[3] * z[3]); w[2] = cvtpk(v[4] * z[4], v[5] * z[5]); w[3] = cvtpk(v[6] * z[6], v[7] * z[7]);
          *(u32x4*)(p.U + (size_t)MTOK * BW + row * BW + (col - h * 128) + h * 128) = w;
        }
      }
    } else {
      const bf16_t* Vp = p.proj + tok0 * CT + C_VA + h * 128;
      attn_body<64>(p.proj + rowq * CT + C_QA + h * 128, p.proj + tok0 * CT + C_KA + h * 128, Vp, lds, o, l_reg);
      attn_rli(l_reg, lds, rli);
      __syncthreads();
      {
        const int l2 = launder(lane), r32 = l2 & 31, hi = l2 >> 5;
#pragma unroll
        for (int half = 0; half < 2; ++half) {
          epi_put_half(o, rli, sc, half, r32, hi);
#pragma unroll
          for (int q = 0; q < 4; ++q) {
            float v[8]; epi_get(sc, q, l2, v);
            float* op = p.o1 + (size_t)(rowbase + q * 8 + (l2 >> 3)) * BW + h * 128 + half * 64 + (l2 & 7) * 8;
            f32x4 a = {v[0], v[1], v[2], v[3]}, c = {v[4], v[5], v[6], v[7]};
            *(f32x4*)op = a; *(f32x4*)(op + 4) = c;
          }
        }
      }
      __syncthreads();
      attn_body<64>(p.proj + rowq * CT + C_QA + h * 128 + 64, p.proj + tok0 * CT + C_KA + h * 128 + 64, Vp, lds, o, l_reg);
      attn_rli(l_reg, lds, rli);
      __syncthreads();
      const int l2 = launder(lane), r32 = l2 & 31, hi = l2 >> 5;
      float d1 = 0.f, d2 = 0.f;
      for (int i = 0; i < 64; ++i) { d1 += p.lq1[i] * p.lk1[i]; d2 += p.lq2[i] * p.lk2[i]; }
      const float lam = __expf(d1) - __expf(d2) + 0.2f;
      float t[2][4][8]; float ss[4] = {0.f, 0.f, 0.f, 0.f};
#pragma unroll
      for (int half = 0; half < 2; ++half) {
        epi_put_half(o, rli, sc, half, r32, hi);
#pragma unroll
        for (int q = 0; q < 4; ++q) {
          float v[8]; epi_get(sc, q, l2, v);
          const float* op = p.o1 + (size_t)(rowbase + q * 8 + (l2 >> 3)) * BW + h * 128 + half * 64 + (l2 & 7) * 8;
          const f32x4 a = *(const f32x4*)op, c = *(const f32x4*)(op + 4);
          const float o1v[8] = {a[0], a[1], a[2], a[3], c[0], c[1], c[2], c[3]};
#pragma unroll
          for (int e = 0; e < 8; ++e) { const float tv = o1v[e] - lam * v[e]; t[half][q][e] = tv; ss[q] += tv * tv; }
        }
      }
      float rinv[4];
#pragma unroll
      for (int q = 0; q < 4; ++q) { float x = ss[q]; x += __shfl_xor(x, 1); x += __shfl_xor(x, 2); x += __shfl_xor(x, 4); rinv[q] = rsqrtf(x * (1.0f / 128.0f) + EPS) * 0.8f; }
#pragma unroll
      for (int half = 0; half < 2; ++half) {
        const int colh = half * 64 + (l2 & 7) * 8;
        const f32x4 g0 = *(const f32x4*)(p.subln_g + colh), g1 = *(const f32x4*)(p.subln_g + colh + 4);
        const float sg[8] = {g0[0], g0[1], g0[2], g0[3], g1[0], g1[1], g1[2], g1[3]};
#pragma unroll
        for (int q = 0; q < 4; ++q) {
          const size_t row = (size_t)(rowbase + q * 8 + (l2 >> 3)); const int col = h * 128 + colh;
          float z[8]; unpack8(__builtin_nontemporal_load((const u32x4*)(p.proj + row * CT + C_ZA + col)), z);
          float ov[8];
#pragma unroll
          for (int e = 0; e < 8; ++e) ov[e] = t[half][q][e] * rinv[q] * sg[e] * z[e];
          u32x4 w; w[0] = cvtpk(ov[0], ov[1]); w[1] = cvtpk(ov[2], ov[3]); w[2] = cvtpk(ov[4], ov[5]); w[3] = cvtpk(ov[6], ov[7]);
          *(u32x4*)(p.U + row * BW + col) = w;
        }
      }
    }
    __syncthreads();
  }
}

__global__ void __launch_bounds__(512) mega(Params p) {
  extern __shared__ __attribute__((aligned(16))) char lds[];
  cg::grid_group grid = cg::this_grid();
  if (p.phase_lo < 0) grid.sync();
  volatile LAS unsigned* xst = (volatile LAS unsigned*)((LAS char*)lds + 131072);
  if (threadIdx.x < 4) xst[threadIdx.x] = 0u;
  __syncthreads();
  XcdBarrier xb = xcd_barrier_post(p.bar, xst);
  const int hi = p.phase_hi;
  if (hi >= 0) phase_prologue(p, lds);
  xcd_barrier(xb);
  if (hi >= 1) phase_gemm1(p, lds);
  xcd_barrier(xb);
  if (hi >= 2) phase_attn(p, lds);
  xcd_barrier(xb);
  if (hi >= 3) phase_gemm2(p, lds);
  xcd_barrier(xb);
  if (hi >= 4) phase_gemm3_final(p, lds, xb);
}

extern "C" void kernel_launch(void* const* d_in, const int* in_sizes, int n_in, void* d_out, int out_size, void* d_ws, size_t ws_size, hipStream_t stream) {
  static int grid_blocks = 0;
  if (!grid_blocks) {
    hipFuncSetAttribute((const void*)mega, hipFuncAttributeMaxDynamicSharedMemorySize, LDS_BYTES);
    int dev = 0, cus = 0, per_cu = 0;
    hipGetDevice(&dev);
    hipDeviceGetAttribute(&cus, hipDeviceAttributeMultiprocessorCount, dev);
    hipOccupancyMaxActiveBlocksPerMultiprocessor(&per_cu, mega, 512, LDS_BYTES);
    if (per_cu < 1) { fprintf(stderr, "occupancy query returned %d\n", per_cu); per_cu = 1; }
    grid_blocks = cus * per_cu;
    if (grid_blocks > 256) grid_blocks = 256;
    if (grid_blocks != 256) fprintf(stderr, "unexpected grid %d (need 256)\n", grid_blocks);
  }
  Params p{};
  p.x = (const float*)d_in[0]; p.norm_g = (const float*)d_in[1]; p.w_in = (const float*)d_in[2];
  p.lq1 = (const float*)d_in[3]; p.lk1 = (const float*)d_in[4]; p.lq2 = (const float*)d_in[5]; p.lk2 = (const float*)d_in[6];
  p.subln_g = (const float*)d_in[7]; p.qn_g = (const float*)d_in[8]; p.kn_g = (const float*)d_in[9];
  p.w_out_a = (const float*)d_in[10]; p.w_out_b = (const float*)d_in[11]; p.w_o = (const float*)d_in[12]; p.final_g = (const float*)d_in[13];
  p.out = (float*)d_out;
  char* w = (char*)d_ws; size_t off = 0;
  auto take = [&](size_t bytes) { char* r = w + off; off += (bytes + 255) & ~(size_t)255; return r; };
  p.h      = (bf16_t*)take((size_t)MTOK * DM * 2);
  p.o1     = (float*)p.h;
  p.merged = (bf16_t*)p.h;
  p.winT   = (bf16_t*)take((size_t)CT * DM * 2);
  p.waT    = (bf16_t*)take((size_t)DM * BW * 2);
  p.wbT    = (bf16_t*)take((size_t)DM * BW * 2);
  p.woT    = (bf16_t*)take((size_t)DM * DM * 2);
  p.proj   = (bf16_t*)take((size_t)MTOK * CT * 2);
  p.U      = (bf16_t*)d_out;
  p.gbuf   = (bf16_t*)take((size_t)2 * MTOK * DM * 2);
  p.rope   = (float2*)take((size_t)SEQ * 32 * 8);
  p.ssq    = (float*)take((size_t)MTOK * 32 * 4);
  p.bar    = (unsigned*)take(XCD_BAR_WORDS * 4);
  if (off > ws_size) { fprintf(stderr, "workspace too small: need %zu have %zu\n", off, ws_size); return; }
  if (grid_blocks != 256) return;
  p.phase_lo = 0; p.phase_hi = 5;
  hipMemsetAsync(p.bar, 0, XCD_BAR_WORDS * 4, stream);
  void* args[] = {&p};
  hipError_t e = hipLaunchCooperativeKernel((void*)mega, dim3(grid_blocks), dim3(512), args, LDS_BYTES, stream);
  if (e != hipSuccess) fprintf(stderr, "cooperative launch failed: %s (grid %d)\n", hipGetErrorString(e), grid_blocks);
}
```

```cpp
#include <hip/hip_runtime.h>
#include <hip/hip_cooperative_groups.h>
#include <cstdio>
#include <cstdint>
namespace cg = cooperative_groups;

#ifndef MK_LAUNCHES
#define MK_LAUNCHES 1
#endif

typedef unsigned short bf16_t;
using bf16x8 = __attribute__((ext_vector_type(8))) short;
using s16x4  = __attribute__((ext_vector_type(4))) short;
using f32x16 = __attribute__((ext_vector_type(16))) float;
using f32x4  = __attribute__((ext_vector_type(4))) float;
using u32x4  = __attribute__((ext_vector_type(4))) unsigned;
using u32x2  = __attribute__((ext_vector_type(2))) unsigned;

constexpr int MTOK = 8192, SEQ = 4096, DM = 2048, CT = 10752, BW = 1024;
constexpr int C_QA = 0, C_KA = 1024, C_VA = 2048, C_ZA = 3072, C_QB = 4096, C_KB = 5120, C_VB = 5376, C_ZB = 5632, C_GA = 6656, C_GB = 8704;
constexpr float EPS = 1e-6f;
constexpr int LDS_BYTES = 131072 + 64 + 4096;

struct Params {
  const float *x, *norm_g, *w_in, *lq1, *lk1, *lq2, *lk2, *subln_g, *qn_g, *kn_g, *w_out_a, *w_out_b, *w_o, *final_g;
  float* out;
  bf16_t *h, *winT, *waT, *wbT, *woT, *proj, *U, *merged;
  float* o1;
  float2* rope;
  float* ssq;
  unsigned* bar;
  bf16_t* gbuf;
  void* pad0;
  int phase_lo, phase_hi;
};

#define SBAR() __builtin_amdgcn_sched_barrier(0)
#define LAS __attribute__((address_space(3)))
__device__ __forceinline__ int crow(int r, int hi) { return (r & 3) + 8 * (r >> 2) + 4 * hi; }
__device__ __forceinline__ unsigned cvtpk(float lo, float hi) {
  unsigned r; asm volatile("v_cvt_pk_bf16_f32 %0, %1, %2" : "=v"(r) : "v"(lo), "v"(hi)); return r;
}
__device__ __forceinline__ float bf2f(bf16_t v) { return __uint_as_float(((unsigned)v) << 16); }
__device__ __forceinline__ bf16_t f2bf(float f) { return (bf16_t)(cvtpk(f, f) & 0xffffu); }
__device__ __forceinline__ float sigmoidf_(float v) { return 1.f / (1.f + __expf(-v)); }

__device__ __forceinline__ void transpose_cvt_strip(const float* __restrict__ W, bf16_t* __restrict__ Wt, int K, int N, int strip, float* tl) {
  const int tid = threadIdx.x;
  const int nsn = N >> 7;
  const int n0 = (strip % nsn) * 128, k0 = (strip / nsn) * 64;
  const int r = tid >> 5, c4 = (tid & 31) * 4;
  f32x4 v[4];
#pragma unroll
  for (int j = 0; j < 4; ++j) v[j] = __builtin_nontemporal_load((const f32x4*)(W + (size_t)(k0 + r + 16 * j) * N + n0 + c4));
#pragma unroll
  for (int j = 0; j < 4; ++j) { float* d = tl + (r + 16 * j) * 129 + c4; d[0] = v[j][0]; d[1] = v[j][1]; d[2] = v[j][2]; d[3] = v[j][3]; }
  __syncthreads();
#pragma unroll
  for (int i = 0; i < 2; ++i) {
    const int id = tid + 512 * i, n = id >> 3, kc = (id & 7) * 8;
    u32x4 w;
    w[0] = cvtpk(tl[(kc + 0) * 129 + n], tl[(kc + 1) * 129 + n]);
    w[1] = cvtpk(tl[(kc + 2) * 129 + n], tl[(kc + 3) * 129 + n]);
    w[2] = cvtpk(tl[(kc + 4) * 129 + n], tl[(kc + 5) * 129 + n]);
    w[3] = cvtpk(tl[(kc + 6) * 129 + n], tl[(kc + 7) * 129 + n]);
    *(u32x4*)(Wt + (size_t)(n0 + n) * K + k0 + kc) = w;
  }
  __syncthreads();
}
__device__ __forceinline__ void transpose_late_weights(const Params& p, char* lds, int worker, int nworkers) {
  float* tl = (float*)lds;
  constexpr int S_OA = (BW / 64) * (DM / 128), S_WO = (DM / 64) * (DM / 128);
  for (int t = worker; t < 2 * S_OA + S_WO; t += nworkers) {
    if (t < S_OA) transpose_cvt_strip(p.w_out_a, p.waT, BW, DM, t, tl);
    else if (t < 2 * S_OA) transpose_cvt_strip(p.w_out_b, p.wbT, BW, DM, t - S_OA, tl);
    else transpose_cvt_strip(p.w_o, p.woT, DM, DM, t - 2 * S_OA, tl);
  }
}

__device__ __forceinline__ void phase_prologue(const Params& p, char* lds) {
  const int tid = threadIdx.x, wid = tid >> 6, lane = tid & 63;
  for (int i = blockIdx.x * 512 + tid; i < SEQ * 32; i += gridDim.x * 512) {
    const int pos = i >> 5, f = i & 31;
    const float inv = 1.0f / exp2f((float)f * (13.287712379549449f / 32.0f));
    const float ang = (float)pos * inv;
    const double rev = (double)ang * 0.15915494309189535;
    const float fr = (float)(rev - rint(rev));
    float2 cs; cs.x = __builtin_amdgcn_cosf(fr); cs.y = __builtin_amdgcn_sinf(fr);
    p.rope[i] = cs;
  }
  for (int row = blockIdx.x * 8 + wid; row < MTOK; row += gridDim.x * 8) {
    const float* xr = p.x + (size_t)row * DM;
    f32x4 v[8]; float ss = 0.f;
#pragma unroll
    for (int j = 0; j < 8; ++j) { v[j] = __builtin_nontemporal_load((const f32x4*)(xr + j * 256 + lane * 4)); ss += v[j][0] * v[j][0] + v[j][1] * v[j][1] + v[j][2] * v[j][2] + v[j][3] * v[j][3]; }
#pragma unroll
    for (int m = 1; m < 64; m <<= 1) ss += __shfl_xor(ss, m);
    const float rinv = rsqrtf(ss * (1.0f / DM) + EPS);
    bf16_t* hr = p.h + (size_t)row * DM;
#pragma unroll
    for (int j = 0; j < 8; ++j) {
      const f32x4 g = *(const f32x4*)(p.norm_g + j * 256 + lane * 4);
      u32x2 w; w[0] = cvtpk(v[j][0] * rinv * g[0], v[j][1] * rinv * g[1]); w[1] = cvtpk(v[j][2] * rinv * g[2], v[j][3] * rinv * g[3]);
      *(u32x2*)(hr + j * 256 + lane * 4) = w;
    }
  }
  float* tl = (float*)lds;
  constexpr int S_IN = (DM / 64) * (CT / 128);
  for (int t = blockIdx.x; t < S_IN; t += gridDim.x) transpose_cvt_strip(p.w_in, p.winT, DM, CT, t, tl);
}

template <int NI>
__device__ __forceinline__ void gemm_prefetch(const bf16_t* __restrict__ A, int lda, const bf16_t* __restrict__ Bt, int ldb, char* lds_) {
  constexpr int BN = NI * 64, NPB = BN / 128;
  constexpr int SA = 256 * 64, SB = BN * 64, STG = SA + SB;
  LAS char* lds = (LAS char*)lds_;
  const int tid = threadIdx.x, wid = __builtin_amdgcn_readfirstlane(tid >> 6);
  const int rowq = tid >> 2, lc = (tid & 3) ^ ((tid >> 4) & 3);
  const unsigned goA = (unsigned)(rowq * lda + lc * 8) * 2u, goB = (unsigned)(rowq * ldb + lc * 8) * 2u;
  const char* Ab0 = (const char*)A; const char* Bb0 = (const char*)Bt;
#pragma unroll
  for (int kt = 0; kt < 2; ++kt) {
    LAS char* sb_ = lds + kt * STG + wid * 1024;
#pragma unroll
    for (int i_ = 0; i_ < 2; ++i_) __builtin_amdgcn_global_load_lds((const unsigned*)(Ab0 + (size_t)kt * 64 + (size_t)(128 * i_) * lda * 2 + goA), (LAS unsigned*)(sb_ + i_ * 8192), 16, 0, 0);
#pragma unroll
    for (int i_ = 0; i_ < NPB; ++i_) __builtin_amdgcn_global_load_lds((const unsigned*)(Bb0 + (size_t)kt * 64 + (size_t)(128 * i_) * ldb * 2 + goB), (LAS unsigned*)(sb_ + SA + i_ * 8192), 16, 0, 0);
  }
}
template <int NI, bool PRE = false>
__device__ __forceinline__ void gemm_mainloop(const bf16_t* __restrict__ A, int lda, const bf16_t* __restrict__ Bt, int ldb, int K,
                                              f32x16 (&acc)[2][NI], char* lds_) {
  constexpr int BN = NI * 64, NPB = BN / 128;
  constexpr int SA = 256 * 64, SB = BN * 64, STG = SA + SB;
  constexpr int P = 2 + NPB;
  LAS char* lds = (LAS char*)lds_;
  const int tid = threadIdx.x, wid = __builtin_amdgcn_readfirstlane(tid >> 6), lane = tid & 63, r32 = lane & 31, hi = lane >> 5, wm = wid >> 1, wn = wid & 1;
  const int rowq = tid >> 2, lc = (tid & 3) ^ ((tid >> 4) & 3);
  const unsigned goA = (unsigned)(rowq * lda + lc * 8) * 2u, goB = (unsigned)(rowq * ldb + lc * 8) * 2u;
  const char* Ab0 = (const char*)A; const char* Bb0 = (const char*)Bt;
  const int nt = K >> 5;
#define G_ISSUE(kt_) do { const int st_ = (kt_) & 3; const char* An_ = Ab0 + (size_t)(kt_) * 64; const char* Bn_ = Bb0 + (size_t)(kt_) * 64; \
    LAS char* sb_ = lds + st_ * STG + wid * 1024; \
    _Pragma("unroll") for (int i_ = 0; i_ < 2; ++i_) __builtin_amdgcn_global_load_lds((const unsigned*)(An_ + (size_t)(128 * i_) * lda * 2 + goA), (LAS unsigned*)(sb_ + i_ * 8192), 16, 0, 0); \
    _Pragma("unroll") for (int i_ = 0; i_ < NPB; ++i_) __builtin_amdgcn_global_load_lds((const unsigned*)(Bn_ + (size_t)(128 * i_) * ldb * 2 + goB), (LAS unsigned*)(sb_ + SA + i_ * 8192), 16, 0, 0); } while (0)
#define G_PIECE(kt_, j_) do { const int st_ = (kt_) & 3; LAS char* sb_ = lds + st_ * STG + wid * 1024; \
    if ((j_) < 2) __builtin_amdgcn_global_load_lds((const unsigned*)(Ab0 + (size_t)(kt_) * 64 + (size_t)(128 * (j_)) * lda * 2 + goA), (LAS unsigned*)(sb_ + (j_) * 8192), 16, 0, 0); \
    else __builtin_amdgcn_global_load_lds((const unsigned*)(Bb0 + (size_t)(kt_) * 64 + (size_t)(128 * ((j_) - 2)) * ldb * 2 + goB), (LAS unsigned*)(sb_ + SA + ((j_) - 2) * 8192), 16, 0, 0); } while (0)
  if (!PRE) { asm volatile("s_waitcnt vmcnt(0)" ::: "memory"); G_ISSUE(0); G_ISSUE(1); }
  const int sw = (r32 >> 2) & 3;
  const int co0 = (hi ^ sw) << 4;
  const int aoff = (wm * 64 + r32) * 64, boff = SA + (wn * (BN / 2) + r32) * 64;
  constexpr int STEP = (2 * NI) / P;
#define DSR(dst, addr, OFF) asm volatile("ds_read_b128 %0, %1 offset:%2" : "=&v"(dst) : "v"(addr), "i"(OFF) : "memory")
#define DSR_SET(F, pa, pb) do { DSR(F.a[0], pa, 0); DSR(F.a[1], pa, 2048); _Pragma("unroll") for (int ni_ = 0; ni_ < NI; ++ni_) DSR(F.b[ni_], pb, ni_ * 2048); } while (0)
#define MMA_SET(F, KT_ISSUE) do { _Pragma("unroll") for (int mi_ = 0; mi_ < 2; ++mi_) _Pragma("unroll") for (int ni_ = 0; ni_ < NI; ++ni_) { \
      acc[mi_][ni_] = __builtin_amdgcn_mfma_f32_32x32x16_bf16(F.b[ni_], F.a[mi_], acc[mi_][ni_], 0, 0, 0); \
      const int idx_ = mi_ * NI + ni_; \
      if ((KT_ISSUE) >= 0 && (idx_ + 1) % STEP == 0 && (idx_ + 1) / STEP - 1 < P) { SBAR(); if (issue) G_PIECE((KT_ISSUE), (idx_ + 1) / STEP - 1); SBAR(); } } } while (0)
#define LWAIT(N) do { SBAR(); asm volatile("s_waitcnt lgkmcnt(%0)" :: "n"(N) : "memory"); SBAR(); } while (0)
  struct Frag { bf16x8 a[2]; bf16x8 b[NI]; };
  for (int kt = 0; kt < nt; kt += 2) {
    asm volatile("s_waitcnt vmcnt(0)" ::: "memory");
    __builtin_amdgcn_s_barrier();
    asm volatile("" ::: "memory");
    const bool issue = (kt + 2 < nt);
    const int sa_ = (int)(uintptr_t)(lds + (kt & 3) * STG), sb2_ = (int)(uintptr_t)(lds + ((kt + 1) & 3) * STG);
    Frag F0, F1;
    DSR_SET(F0, sa_ + aoff + co0, sa_ + boff + co0);
    DSR_SET(F1, sa_ + aoff + (co0 ^ 32), sa_ + boff + (co0 ^ 32));
    LWAIT(2 + NI);
    MMA_SET(F0, kt + 2);
    SBAR(); DSR_SET(F0, sb2_ + aoff + co0, sb2_ + boff + co0); SBAR();
    LWAIT(2 + NI);
    MMA_SET(F1, kt + 3);
    SBAR(); DSR_SET(F1, sb2_ + aoff + (co0 ^ 32), sb2_ + boff + (co0 ^ 32)); SBAR();
    LWAIT(2 + NI);
    MMA_SET(F0, -1);
    LWAIT(0);
    MMA_SET(F1, -1);
  }
#undef DSR
#undef DSR_SET
#undef MMA_SET
#undef LWAIT
  asm volatile("" ::: "memory");
  __builtin_amdgcn_s_barrier();
  asm volatile("" ::: "memory");
#undef G_ISSUE
#undef G_PIECE
}

namespace pg8 {
#define PG8_LAS __attribute__((address_space(3)))
typedef unsigned short bf16_t;
typedef short bf16x8 __attribute__((ext_vector_type(8)));
typedef float f32x4 __attribute__((ext_vector_type(4)));
typedef unsigned u32x4 __attribute__((ext_vector_type(4)));
constexpr int BM = 256, BK = 64, HALF = 128, HTB = HALF * BK * 2  , STAGE_BYTES = 8 * HTB, NXCD = 8, WGM = 8;

__host__ __device__ __forceinline__ int lds_byte(int r, int c) { const int st = (r >> 4) * 2 + (c >> 5), rr = r & 15, cc = c & 31, ob = rr * 64 + cc * 2; return st * 1024 + (ob ^ (((ob >> 9) & 1) << 5)); }
__host__ __device__ __forceinline__ void stage_rc(int b, int& R, int& C) { const int st = b / 1024, sb = b % 1024, swz = sb ^ (((sb >> 9) & 1) << 5); R = (st >> 1) * 16 + swz / 64; C = (st & 1) * 32 + (swz % 64) / 2; }
__host__ __device__ __forceinline__ int perm32(int rho) { const int n = rho >> 4, i = rho & 15; return 8 * (i >> 2) + 4 * n + (i & 3); }

struct Unit { int pm, pn; };
struct Gemm { const bf16_t* A; const bf16_t* Bt; int M, N, K; };

__device__ __forceinline__ unsigned cvt_pk_bf16(float lo, float hi) { unsigned r; asm volatile("v_cvt_pk_bf16_f32 %0, %1, %2" : "=v"(r) : "v"(lo), "v"(hi)); return r; }
template <class Epi, class Sched, bool ALIGN_EPI = false, bool SP2 = false>
__device__ __forceinline__ void gemm_phase(PG8_LAS unsigned char* lds, const Gemm g, const Sched& S, const Epi& E) {
    const int tid = threadIdx.x, wid = __builtin_amdgcn_readfirstlane(tid >> 6), lane = tid & 63, wr = wid >> 2, wc = wid & 3, fr = lane & 15, fq = lane >> 4;
    const int K = g.K, nt = K / BK;
    unsigned voffA[2], voffB[2];
#pragma unroll
    for (int i = 0; i < 2; ++i) { int R, C; stage_rc(tid * 16 + i * 8192, R, C); const int Rb = Epi::PERM ? ((R & ~31) + perm32(R & 31)) : R;
        voffA[i] = (unsigned)(R * K + C) * 2u; voffB[i] = (unsigned)(Rb * K + C) * 2u; }
    unsigned voffB1[2]; size_t hstepB = (size_t)HALF * K * 2;
#pragma unroll
    for (int i = 0; i < 2; ++i) { voffB1[i] = voffB[i];
        if constexpr (Epi::COLMAP) { int R, C; stage_rc(tid * 16 + i * 8192, R, C); const int c0 = 64 * (R >> 5) + perm32(R & 31);
            voffB[i] = (unsigned)(c0 * K + C) * 2u; voffB1[i] = (unsigned)((c0 + 32) * K + C) * 2u; } }
    if constexpr (Epi::COLMAP) hstepB = 0;
    const size_t kstep = (size_t)(BK * 2);
    const size_t hstep = (size_t)HALF * K * 2;
    const size_t tstep = 2 * hstep;
    const unsigned ldsw = (unsigned)wid * 1024u;
    const int aoff = lds_byte(wr * 64 + fr, fq * 8), boff = lds_byte(wc * 32 + fr, fq * 8);
#define PG8_SA(b, h) (((b) * 2 + (h)) * HTB)
#define PG8_SB(b, h) ((4 + (b) * 2 + (h)) * HTB)
#define PG8_STAGE(bufoff, gbase, voff) do { _Pragma("unroll") for (int _i = 0; _i < 2; ++_i) \
        __builtin_amdgcn_global_load_lds((const unsigned*)((const char*)(gbase) + (voff)[_i]), (PG8_LAS unsigned*)(lds + (bufoff) + ldsw + _i * 8192), 16, 0, 0); } while (0)
#define PG8_LDA(dst, b, h) do { _Pragma("unroll") for (int m = 0; m < 4; ++m) _Pragma("unroll") for (int k = 0; k < 2; ++k) dst[m][k] = *(const PG8_LAS bf16x8*)(lds + PG8_SA(b, h) + aoff + m * 2048 + k * 1024); } while (0)
#define PG8_LDB(dst, b, h) do { _Pragma("unroll") for (int n = 0; n < 2; ++n) _Pragma("unroll") for (int k = 0; k < 2; ++k) dst[n][k] = *(const PG8_LAS bf16x8*)(lds + PG8_SB(b, h) + boff + n * 2048 + k * 1024); } while (0)
#define PG8_MMA(ai, bj, At, Bt) do { __builtin_amdgcn_s_setprio(1); _Pragma("unroll") for (int m = 0; m < 4; ++m) _Pragma("unroll") for (int n = 0; n < 2; ++n) _Pragma("unroll") for (int k = 0; k < 2; ++k) \
        acc[ai][bj][m][n] = __builtin_amdgcn_mfma_f32_16x16x32_bf16(Bt[n][k], At[m][k], acc[ai][bj][m][n], 0, 0, 0); __builtin_amdgcn_s_setprio(0); } while (0)
#define PG8_WAIT_V(n) asm volatile("s_waitcnt vmcnt(" #n ")" ::: "memory")
#define PG8_WAIT_L(n) asm volatile("s_waitcnt lgkmcnt(" #n ")" ::: "memory")
#define PG8_BAR __builtin_amdgcn_s_barrier()
#define PG8_SCHED __builtin_amdgcn_sched_barrier(0)
    Unit cur, nxt; int ui = 0;
    if (!S.next(0, cur)) return;
    f32x4 acc[2][2][4][2];
#pragma unroll
    for (int a = 0; a < 2; ++a)
#pragma unroll
        for (int b = 0; b < 2; ++b)
#pragma unroll
            for (int m = 0; m < 4; ++m)
#pragma unroll
                for (int n = 0; n < 2; ++n) acc[a][b][m][n] = (f32x4){0.f, 0.f, 0.f, 0.f};
    bf16x8 At[4][2], B0[2][2], B1[2][2];
    const char* cA = (const char*)g.A + (size_t)cur.pm * tstep; const char* cB = (const char*)g.Bt + (size_t)cur.pn * tstep;
    S.a_ready(cur);
    if constexpr (SP2) {
        PG8_STAGE(PG8_SB(0, 0), cB, voffB); PG8_STAGE(PG8_SB(0, 1), cB + hstepB, voffB1); PG8_STAGE(PG8_SA(0, 0), cA, voffA); PG8_STAGE(PG8_SA(0, 1), cA + hstep, voffA);
        if (wr == 1) PG8_BAR;
        PG8_WAIT_V(2); PG8_BAR;
        PG8_STAGE(PG8_SB(1, 0), cB + kstep, voffB); PG8_STAGE(PG8_SA(1, 0), cA + kstep, voffA); PG8_STAGE(PG8_SB(1, 1), cB + hstepB + kstep, voffB1);
        PG8_WAIT_V(6); PG8_BAR;
    } else {
        PG8_STAGE(PG8_SB(0, 0), cB, voffB); PG8_STAGE(PG8_SA(0, 0), cA, voffA); PG8_STAGE(PG8_SB(0, 1), cB + hstepB, voffB1); PG8_STAGE(PG8_SA(0, 1), cA + hstep, voffA);
        if (wr == 1) PG8_BAR;
        PG8_WAIT_V(4); PG8_BAR;
        PG8_STAGE(PG8_SB(1, 0), cB + kstep, voffB); PG8_STAGE(PG8_SA(1, 0), cA + kstep, voffA); PG8_STAGE(PG8_SB(1, 1), cB + hstepB + kstep, voffB1);
        PG8_WAIT_V(6); PG8_BAR;
    }
    for (;;) {
        const bool has_next = S.next(ui + 1, nxt);
        const char* nA = has_next ? (const char*)g.A + (size_t)nxt.pm * tstep : cA; const char* nB = has_next ? (const char*)g.Bt + (size_t)nxt.pn * tstep : cB;
        for (int t = 0; t < nt; t += 2) {
            const bool last = (t == nt - 2);
            const char* a1 = cA + (size_t)(t + 1) * kstep;
            const char* a2 = last ? nA : cA + (size_t)(t + 2) * kstep; const char* b2 = last ? nB : cB + (size_t)(t + 2) * kstep;
            const char* a3 = a2 + kstep; const char* b3 = b2 + kstep;
            if (last && has_next) S.a_ready(nxt);
            if constexpr (SP2) {
            PG8_LDB(B0, 0, 0); PG8_LDB(B1, 0, 1); PG8_SCHED; PG8_LDA(At, 0, 0); PG8_STAGE(PG8_SA(1, 1), a1 + hstep, voffA);
            PG8_WAIT_V(8); PG8_WAIT_L(0); PG8_BAR; PG8_MMA(0, 0, At, B0); PG8_MMA(0, 1, At, B1); PG8_BAR; PG8_SCHED;
            PG8_LDA(At, 0, 1); PG8_STAGE(PG8_SB(0, 0), b2, voffB); PG8_STAGE(PG8_SB(0, 1), b2 + hstepB, voffB1); PG8_STAGE(PG8_SA(0, 0), a2, voffA);
            PG8_WAIT_V(8); PG8_WAIT_L(0); PG8_BAR; PG8_MMA(1, 0, At, B0); PG8_MMA(1, 1, At, B1); PG8_BAR; PG8_SCHED;
            PG8_LDB(B0, 1, 0); PG8_LDB(B1, 1, 1); PG8_SCHED; PG8_LDA(At, 1, 0); PG8_STAGE(PG8_SA(0, 1), a2 + hstep, voffA);
            PG8_WAIT_V(8); PG8_WAIT_L(0); PG8_BAR; PG8_MMA(0, 0, At, B0); PG8_MMA(0, 1, At, B1); PG8_BAR; PG8_SCHED;
            PG8_LDA(At, 1, 1); PG8_STAGE(PG8_SB(1, 0), b3, voffB); PG8_STAGE(PG8_SB(1, 1), b3 + hstepB, voffB1); PG8_STAGE(PG8_SA(1, 0), a3, voffA);
            PG8_WAIT_V(8); PG8_WAIT_L(0); PG8_BAR; PG8_MMA(1, 0, At, B0); PG8_MMA(1, 1, At, B1); PG8_BAR; PG8_SCHED;
            } else {
            PG8_LDB(B0, 0, 0); PG8_SCHED; PG8_LDA(At, 0, 0); PG8_STAGE(PG8_SA(1, 1), a1 + hstep, voffA);
            PG8_WAIT_L(8); PG8_BAR; PG8_WAIT_L(0); PG8_MMA(0, 0, At, B0); PG8_BAR; PG8_SCHED;
            PG8_LDB(B1, 0, 1); PG8_STAGE(PG8_SB(0, 0), b2, voffB);
            PG8_BAR; PG8_WAIT_L(0); PG8_MMA(0, 1, At, B1); PG8_BAR;
            PG8_LDA(At, 0, 1); PG8_STAGE(PG8_SA(0, 0), a2, voffA);
            PG8_BAR; PG8_WAIT_L(0); PG8_MMA(1, 0, At, B0); PG8_BAR; PG8_SCHED;
            PG8_STAGE(PG8_SB(0, 1), b2 + hstepB, voffB1);
            PG8_WAIT_V(6); PG8_BAR; PG8_MMA(1, 1, At, B1); PG8_BAR;
            PG8_LDB(B0, 1, 0); PG8_SCHED; PG8_LDA(At, 1, 0); PG8_STAGE(PG8_SA(0, 1), a2 + hstep, voffA);
            PG8_WAIT_L(8); PG8_BAR; PG8_WAIT_L(0); PG8_MMA(0, 0, At, B0); PG8_BAR; PG8_SCHED;
            PG8_LDB(B1, 1, 1); PG8_STAGE(PG8_SB(1, 0), b3, voffB);
            PG8_BAR; PG8_WAIT_L(0); PG8_MMA(0, 1, At, B1); PG8_BAR;
            PG8_LDA(At, 1, 1); PG8_STAGE(PG8_SA(1, 0), a3, voffA);
            PG8_BAR; PG8_WAIT_L(0); PG8_MMA(1, 0, At, B0); PG8_BAR; PG8_SCHED;
            PG8_STAGE(PG8_SB(1, 1), b3 + hstepB, voffB1);
            PG8_WAIT_V(6); PG8_BAR; PG8_MMA(1, 1, At, B1); PG8_BAR;
            }
        }
        if constexpr (ALIGN_EPI) { if (wr == 0) PG8_BAR; }
        if constexpr (!Epi::AFTER_DRAIN) { E(acc, cur, wr, wc, fr, fq); S.done(cur); }
        if (!has_next) break;
#pragma unroll
        for (int a = 0; a < 2; ++a)
#pragma unroll
            for (int b = 0; b < 2; ++b)
#pragma unroll
                for (int m = 0; m < 4; ++m)
#pragma unroll
                    for (int n = 0; n < 2; ++n) acc[a][b][m][n] = (f32x4){0.f, 0.f, 0.f, 0.f};
        cur = nxt; cA = nA; cB = nB; ++ui;
        if constexpr (ALIGN_EPI) { if (wr == 1) PG8_BAR; }
    }
    PG8_WAIT_V(0);
    if constexpr (!ALIGN_EPI) { if (wr == 0) PG8_BAR; }
    PG8_BAR;
    if constexpr (Epi::AFTER_DRAIN) { E.fused(acc, cur, wr, wc, fr, fq, lds, wid, lane); S.done(cur); }
#undef PG8_SA
#undef PG8_SB
#undef PG8_STAGE
#undef PG8_LDA
#undef PG8_LDB
#undef PG8_MMA
#undef PG8_WAIT_V
#undef PG8_WAIT_L
#undef PG8_BAR
#undef PG8_SCHED
}
}
__device__ __forceinline__ size_t gbuf_off(int gate, int rb, int cb, int lane) { return ((((size_t)gate * 256 + rb) * 128 + cb) * 64 + lane) * 8; }

struct EpiG1 {
  static constexpr bool PERM = true, AFTER_DRAIN = false, COLMAP = true;
  bf16_t* proj; bf16_t* gbuf; const float2* rope; const float* qn_g; const float* kn_g; float* xch;
  __device__ __forceinline__ void operator()(const pg8::f32x4 (&acc)[2][2][4][2], const pg8::Unit& u, int wr, int wc, int fr, int fq) const {
    const int colt = u.pn * 256;
    if (colt >= C_QB && colt < C_VB) { qknorm(acc, u, wr, wc, fr, fq); return; }
    const int type = (colt < C_VA) ? 0 : (colt >= C_GA) ? 3 : (((colt >= C_ZA && colt < C_QB) || (colt >= C_ZB && colt < C_GA)) ? 2 : 4);
#pragma unroll
    for (int ai = 0; ai < 2; ++ai)
#pragma unroll
      for (int m = 0; m < 4; ++m) {
        const int row = u.pm * 256 + ai * 128 + wr * 64 + m * 16 + fr;
        float v[2][8];
#pragma unroll
        for (int bj = 0; bj < 2; ++bj)
#pragma unroll
          for (int e = 0; e < 4; ++e) { v[bj][e] = acc[ai][bj][m][0][e]; v[bj][4 + e] = acc[ai][bj][m][1][e]; }
        if (type == 0) {
          const f32x4* tp = (const f32x4*)(rope + (row & (SEQ - 1)) * 32 + 8 * fq);
#pragma unroll
          for (int q = 0; q < 4; ++q) { const f32x4 cs = tp[q];
            { const float x1 = v[0][2 * q], x2 = v[1][2 * q]; v[0][2 * q] = x1 * cs[0] - x2 * cs[1]; v[1][2 * q] = x2 * cs[0] + x1 * cs[1]; }
            { const float x1 = v[0][2 * q + 1], x2 = v[1][2 * q + 1]; v[0][2 * q + 1] = x1 * cs[2] - x2 * cs[3]; v[1][2 * q + 1] = x2 * cs[2] + x1 * cs[3]; } }
        } else if (type == 2) {
#pragma unroll
          for (int bj = 0; bj < 2; ++bj)
#pragma unroll
            for (int e = 0; e < 8; ++e) v[bj][e] = v[bj][e] * sigmoidf_(v[bj][e]);
        } else if (type == 3) {
#pragma unroll
          for (int bj = 0; bj < 2; ++bj)
#pragma unroll
            for (int e = 0; e < 8; ++e) v[bj][e] = sigmoidf_(v[bj][e]);
        }
#pragma unroll
        for (int bj = 0; bj < 2; ++bj) {
          const int col8 = colt + 64 * wc + 32 * bj + 8 * fq;
          u32x4 w; w[0] = cvtpk(v[bj][0], v[bj][1]); w[1] = cvtpk(v[bj][2], v[bj][3]); w[2] = cvtpk(v[bj][4], v[bj][5]); w[3] = cvtpk(v[bj][6], v[bj][7]);
          if (type == 3) {
            const int gate = (col8 >= C_GB) ? 1 : 0, gc = col8 - (gate ? C_GB : C_GA);
            *(u32x4*)(gbuf + gbuf_off(gate, row >> 5, gc >> 4, ((gc >> 3) & 1) * 32 + (row & 31))) = w;
          } else {
            *(u32x4*)(proj + (size_t)row * CT + col8) = w;
          }
        }
        asm volatile("" ::: "memory");
      }
  }
  __device__ __forceinline__ void qknorm(const pg8::f32x4 (&acc)[2][2][4][2], const pg8::Unit& u, int wr, int wc, int fr, int fq) const {
    const int colt = u.pn * 256, wid = wr * 4 + wc;
    const float* g = (colt < C_KB) ? qn_g : kn_g;
#pragma unroll
    for (int ai = 0; ai < 2; ++ai)
#pragma unroll
      for (int m = 0; m < 4; ++m) {
        float ss = 0.f;
#pragma unroll
        for (int bj = 0; bj < 2; ++bj)
#pragma unroll
          for (int n = 0; n < 2; ++n)
#pragma unroll
            for (int e = 0; e < 4; ++e) ss += acc[ai][bj][m][n][e] * acc[ai][bj][m][n][e];
        ss += __shfl_xor(ss, 16); ss += __shfl_xor(ss, 32);
        if (fq == 0) xch[wid * 128 + (ai * 4 + m) * 16 + fr] = ss;
        asm volatile("" ::: "memory");
      }
    asm volatile("s_waitcnt lgkmcnt(0)" ::: "memory");
    __builtin_amdgcn_s_barrier();
    asm volatile("" ::: "memory");
    const int hg = wc & 1;
#pragma unroll
    for (int ai = 0; ai < 2; ++ai)
#pragma unroll
      for (int m = 0; m < 4; ++m) {
        const int row = u.pm * 256 + ai * 128 + wr * 64 + m * 16 + fr;
        const float tot = xch[wid * 128 + (ai * 4 + m) * 16 + fr] + xch[(wid ^ 1) * 128 + (ai * 4 + m) * 16 + fr];
        const float rinv = rsqrtf(tot * (1.0f / 128.0f) + EPS);
        float v[2][8];
#pragma unroll
        for (int bj = 0; bj < 2; ++bj) { const f32x4 g0 = *(const f32x4*)(g + hg * 64 + bj * 32 + 8 * fq), g1 = *(const f32x4*)(g + hg * 64 + bj * 32 + 8 * fq + 4);
#pragma unroll
          for (int e = 0; e < 4; ++e) { v[bj][e] = acc[ai][bj][m][0][e] * rinv * g0[e]; v[bj][4 + e] = acc[ai][bj][m][1][e] * rinv * g1[e]; } }
        const int s_ = row & (SEQ - 1), pos = hg ? (s_ & 63) : (s_ >> 6);
        const f32x4* tp = (const f32x4*)(rope + pos * 32 + 8 * fq);
#pragma unroll
        for (int q = 0; q < 4; ++q) { const f32x4 cs = tp[q];
          { const float x1 = v[0][2 * q], x2 = v[1][2 * q]; v[0][2 * q] = x1 * cs[0] - x2 * cs[1]; v[1][2 * q] = x2 * cs[0] + x1 * cs[1]; }
          { const float x1 = v[0][2 * q + 1], x2 = v[1][2 * q + 1]; v[0][2 * q + 1] = x1 * cs[2] - x2 * cs[3]; v[1][2 * q + 1] = x2 * cs[2] + x1 * cs[3]; } }
#pragma unroll
        for (int bj = 0; bj < 2; ++bj) {
          const int col8 = colt + 64 * wc + 32 * bj + 8 * fq;
          u32x4 w; w[0] = cvtpk(v[bj][0], v[bj][1]); w[1] = cvtpk(v[bj][2], v[bj][3]); w[2] = cvtpk(v[bj][4], v[bj][5]); w[3] = cvtpk(v[bj][6], v[bj][7]);
          *(u32x4*)(proj + (size_t)row * CT + col8) = w;
        }
        asm volatile("" ::: "memory");
      }
  }
};
struct SchedG1 {
  int b;
  __device__ __forceinline__ bool next(int i, pg8::Unit& u) const {
    int id;
    if (b < 160) { if (i >= 5) return false; if (i == 4) { u.pm = b & 31; u.pn = 16 + (b >> 5); return true; } id = b + 160 * i; }
    else { if (i >= 5) return false; id = 640 + (b - 160) + 96 * i; }
    const int ct = id >> 5; u.pm = id & 31; u.pn = (ct < 16) ? ct : (21 + (ct - 16)); return true;
  }
  __device__ __forceinline__ void a_ready(const pg8::Unit&) const {}
  __device__ __forceinline__ void done(const pg8::Unit&) const {}
};

#define XB_TMO      128
#define XB_XCNT(j)  (256  + 64 * (j))
#define XB_XSUB(j)  (1280 + 64 * (j))
#define XB_XGEN(j)  (2304 + 64 * (j))
#define XB_TOP      3328
#define XB_TOPGEN   3392
#define XCD_BAR_WORDS 3456
#define XB_SPIN_CAP (1u << 18)

__device__ __forceinline__ unsigned xb_ld(unsigned* p)              { return __hip_atomic_load(p, __ATOMIC_RELAXED, __HIP_MEMORY_SCOPE_AGENT); }
__device__ __forceinline__ unsigned xb_add(unsigned* p, unsigned v) { return __hip_atomic_fetch_add(p, v, __ATOMIC_RELAXED, __HIP_MEMORY_SCOPE_AGENT); }
__device__ __forceinline__ unsigned xb_xcc_id() { return (unsigned)__builtin_amdgcn_s_getreg((3 << 11) | 20) & 0xFu; }
#define XB_SPIN(cond, bar) do { unsigned _sp = 0; while (cond) { __builtin_amdgcn_s_sleep(1); \
    if ((++_sp & 255u) == 0u) { if (xb_ld(&(bar)[XB_TMO])) break; if (_sp > XB_SPIN_CAP) { atomicAdd(&(bar)[XB_TMO], 1u); break; } } } } while (0)

struct XcdBarrier {
    unsigned* bar; unsigned x;
    volatile LAS unsigned* st;
};

__device__ __forceinline__ XcdBarrier xcd_barrier_post(unsigned* bar, volatile LAS unsigned* st) {
    XcdBarrier b; b.bar = bar; b.x = xb_xcc_id(); b.st = st;
    if (threadIdx.x == 0) (void)xb_add(&bar[XB_XCNT(b.x)], 1u);
    return b;
}
__device__ __forceinline__ void xcd_barrier_complete(unsigned* bar, unsigned x, unsigned& nloc, unsigned& nx) {
    const unsigned G = gridDim.x * gridDim.y * gridDim.z;
    unsigned sum, cnt, mine, sp = 0u;
    for (;;) {
        sum = 0u; cnt = 0u; mine = 0u;
#pragma unroll
        for (unsigned j = 0; j < 16; ++j) { const unsigned c = xb_ld(&bar[XB_XCNT(j)]); sum += c; cnt += (c > 0u) ? 1u : 0u; mine = (j == x) ? c : mine; }
        if (sum == G) break;
        __builtin_amdgcn_s_sleep(1);
        if ((++sp & 255u) == 0u) { if (xb_ld(&bar[XB_TMO])) break; if (sp > XB_SPIN_CAP) { atomicAdd(&bar[XB_TMO], 1u); break; } }
    }
    nloc = mine > 0u ? mine : 1u; nx = cnt > 0u ? cnt : 1u;
}

__device__ __forceinline__ void xcd_barrier(const XcdBarrier& b) {
    asm volatile("s_waitcnt vmcnt(0)" ::: "memory");
    __syncthreads();
    if (threadIdx.x == 0) {
        unsigned* bar = b.bar;
        __builtin_amdgcn_s_waitcnt(0);
        unsigned nloc = b.st[0], nx = b.st[1];
        if (nloc == 0u) { xcd_barrier_complete(bar, b.x, nloc, nx); b.st[0] = nloc; b.st[1] = nx; }
        const unsigned old = xb_add(&bar[XB_XSUB(b.x)], 1u);
        const unsigned gen = old / nloc;
        if (old + 1u == (gen + 1u) * nloc) {
            __builtin_amdgcn_fence(__ATOMIC_RELEASE, "agent");
            asm volatile("s_waitcnt vmcnt(0)" ::: "memory");
            const unsigned og = xb_add(&bar[XB_TOP], 1u);
            const unsigned tg = og / nx;
            if (og + 1u == (tg + 1u) * nx) xb_add(&bar[XB_TOPGEN], 1u);
            else XB_SPIN(xb_ld(&bar[XB_TOPGEN]) == tg, bar);
            __builtin_amdgcn_fence(__ATOMIC_ACQUIRE, "agent");
            xb_add(&bar[XB_XGEN(b.x)], 1u);
            asm volatile("s_waitcnt vmcnt(0)" ::: "memory");
        } else {
            XB_SPIN(xb_ld(&bar[XB_XGEN(b.x)]) == gen, bar);
            __builtin_amdgcn_fence(__ATOMIC_ACQUIRE, "agent");
            asm volatile("s_waitcnt vmcnt(0)" ::: "memory");
        }
    }
    __syncthreads();
}


__device__ __forceinline__ int launder(int x) { asm volatile("" : "+v"(x)); return x; }

__device__ __forceinline__ void rot4(float (&x1)[4], float (&x2)[4], const f32x4 ca, const f32x4 cb) {
  const float c[4] = {ca[0], ca[2], cb[0], cb[2]}, sn[4] = {ca[1], ca[3], cb[1], cb[3]};
#pragma unroll
  for (int e = 0; e < 4; ++e) { const float a = x1[e] * c[e] - x2[e] * sn[e], bb = x2[e] * c[e] + x1[e] * sn[e]; x1[e] = a; x2[e] = bb; }
}
__device__ __forceinline__ u32x4 pack8(const float (&a)[4], const float (&b)[4]) {
  const unsigned a0 = cvtpk(a[0], a[1]), a1 = cvtpk(a[2], a[3]), b0 = cvtpk(b[0], b[1]), b1 = cvtpk(b[2], b[3]);
  auto r0 = __builtin_amdgcn_permlane32_swap(a0, b0, false, false); auto r1 = __builtin_amdgcn_permlane32_swap(a1, b1, false, false);
  u32x4 w = {r0[0], r1[0], r0[1], r1[1]}; return w;
}
template <int TYPE>
__device__ __forceinline__ void epi1_group(const Params& p, const f32x16 (&acc)[2][4], int mi, int gq, int s, int hi, float rinv, const float* g, float (&v)[4][4]) {
  const int i0 = 8 * gq + 4 * hi;
#pragma unroll
  for (int ni = 0; ni < 4; ++ni)
#pragma unroll
    for (int e = 0; e < 4; ++e) v[ni][e] = acc[mi][ni][4 * gq + e];
  if (TYPE == 0) {
    const f32x4* tp = (const f32x4*)(p.rope + s * 32 + i0);
    const f32x4 ca = tp[0], cb = tp[1];
    rot4(v[0], v[1], ca, cb); rot4(v[2], v[3], ca, cb);
  } else if (TYPE == 1) {
#pragma unroll
    for (int ni = 0; ni < 4; ++ni) { const f32x4 gv = *(const f32x4*)(g + ni * 32 + i0);
#pragma unroll
      for (int e = 0; e < 4; ++e) v[ni][e] = v[ni][e] * rinv * gv[e]; }
    const f32x4* t0 = (const f32x4*)(p.rope + (s >> 6) * 32 + i0);
    const f32x4* t1 = (const f32x4*)(p.rope + (s & 63) * 32 + i0);
    const f32x4 a0 = t0[0], b0 = t0[1], a1 = t1[0], b1 = t1[1];
    rot4(v[0], v[1], a0, b0); rot4(v[2], v[3], a1, b1);
  } else if (TYPE == 2) {
#pragma unroll
    for (int ni = 0; ni < 4; ++ni)
#pragma unroll
      for (int e = 0; e < 4; ++e) v[ni][e] = v[ni][e] * sigmoidf_(v[ni][e]);
  } else if (TYPE == 3) {
#pragma unroll
    for (int ni = 0; ni < 4; ++ni)
#pragma unroll
      for (int e = 0; e < 4; ++e) v[ni][e] = sigmoidf_(v[ni][e]);
  }
}
template <int TYPE>
__device__ __forceinline__ void epi1(const Params& p, const f32x16 (&acc)[2][4], int rowb, int col0, int r32, int hi, const float* g) {
#pragma unroll
  for (int mi = 0; mi < 2; ++mi) {
    const int row = rowb + mi * 32 + r32;
    const int s = row & (SEQ - 1);
    float rinv = 1.f;
    if (TYPE == 1) {
      float ss = 0.f;
#pragma unroll
      for (int ni = 0; ni < 4; ++ni)
#pragma unroll
        for (int r = 0; r < 16; ++r) ss += acc[mi][ni][r] * acc[mi][ni][r];
      ss += __shfl_xor(ss, 32);
      rinv = rsqrtf(ss * (1.0f / 128.0f) + EPS);
    }
    bf16_t* dst = p.proj + (size_t)row * CT + col0 + 8 * hi;
#pragma unroll
    for (int j = 0; j < 2; ++j) {
      float va[4][4], vb[4][4];
      epi1_group<TYPE>(p, acc, mi, 2 * j, s, hi, rinv, g, va);
      epi1_group<TYPE>(p, acc, mi, 2 * j + 1, s, hi, rinv, g, vb);
      if (TYPE == 3) {
        const int gate = (col0 >= C_GB) ? 1 : 0, gc = col0 - (gate ? C_GB : C_GA);
        const int rb = (rowb >> 5) + mi, lane_ = hi * 32 + r32;
#pragma unroll
        for (int ni = 0; ni < 4; ++ni) *(u32x4*)(p.gbuf + gbuf_off(gate, rb, (gc >> 4) + ni * 2 + j, lane_)) = pack8(va[ni], vb[ni]);
      } else {
#pragma unroll
        for (int ni = 0; ni < 4; ++ni) *(u32x4*)(dst + ni * 32 + 16 * j) = pack8(va[ni], vb[ni]);
      }
    }
    asm volatile("" ::: "memory");
  }
}

__device__ __forceinline__ void phase_gemm1(const Params& p, char* lds) {
  const int tid = threadIdx.x, wid = tid >> 6, lane = tid & 63, wm = wid >> 1, wn = wid & 1;
  const int b = blockIdx.x;
  const bool has_tail = b < 128;
  {
    pg8::Gemm g{p.h, p.winT, MTOK, CT, DM};
    SchedG1 S{b}; EpiG1 E{p.proj, p.gbuf, p.rope, p.qn_g, p.kn_g, (float*)(lds + 131072 + 64)};
    pg8::gemm_phase<EpiG1, SchedG1, true, true>((LAS unsigned char*)lds, g, S, E);
  }
  const int nmine = 0;
#define MINE_ID(i_) (b)
#define MINE_PN(id_) (16 + ((id_) >> 5))
  if (nmine > 0) { const int id0 = MINE_ID(0); gemm_prefetch<4>(p.h + (size_t)(id0 & 31) * 256 * DM, DM, p.winT + (size_t)MINE_PN(id0) * 256 * DM, DM, lds); }
  for (int i = 0; i < nmine; ++i) {
    const int id = MINE_ID(i);
    const int pm = id & 31, pn = MINE_PN(id);
    f32x16 acc[2][4];
#pragma unroll
    for (int mi = 0; mi < 2; ++mi)
#pragma unroll
      for (int ni = 0; ni < 4; ++ni) acc[mi][ni] = f32x16{};
    gemm_mainloop<4, true>(p.h + (size_t)pm * 256 * DM, DM, p.winT + (size_t)pn * 256 * DM, DM, DM, acc, lds);
    if (i + 1 < nmine) { const int idn = MINE_ID(i + 1); gemm_prefetch<4>(p.h + (size_t)(idn & 31) * 256 * DM, DM, p.winT + (size_t)MINE_PN(idn) * 256 * DM, DM, lds); }
    else if (has_tail) gemm_prefetch<2>(p.h + (size_t)(b & 31) * 256 * DM, DM, p.winT + (size_t)(40 * 256 + (b >> 5) * 128) * DM, DM, lds);
    const int l2 = launder(lane), r32 = l2 & 31, hi = l2 >> 5;
    const int col0 = pn * 256 + wn * 128;
    const int rowb = pm * 256 + wm * 64;
    if (col0 < C_KB) epi1<1>(p, acc, rowb, col0, r32, hi, p.qn_g);
    else epi1<1>(p, acc, rowb, col0, r32, hi, p.kn_g);
  }
  if (nmine == 0 && has_tail) gemm_prefetch<2>(p.h + (size_t)(b & 31) * 256 * DM, DM, p.winT + (size_t)(40 * 256 + (b >> 5) * 128) * DM, DM, lds);
#undef MINE_ID
#undef MINE_PN
  if (!has_tail) transpose_late_weights(p, lds, (int)blockIdx.x - 128, (int)gridDim.x - 128);
  if (has_tail) {
    const int u = blockIdx.x;
    const int pm = u & 31, cbase = 40 * 256 + (u >> 5) * 128;
    f32x16 acc[2][2];
#pragma unroll
    for (int mi = 0; mi < 2; ++mi)
#pragma unroll
      for (int ni = 0; ni < 2; ++ni) acc[mi][ni] = f32x16{};
    gemm_mainloop<2, true>(p.h + (size_t)pm * 256 * DM, DM, p.winT + (size_t)cbase * DM, DM, DM, acc, lds);
    const int l2 = launder(lane), r32 = l2 & 31, hi = l2 >> 5;
    const int col0 = cbase + wn * 64;
    const int rowb = pm * 256 + wm * 64;
#pragma unroll
    for (int mi = 0; mi < 2; ++mi) {
      const int rb = (rowb >> 5) + mi, cb0 = (col0 - C_GB) >> 4;
#pragma unroll
      for (int ni = 0; ni < 2; ++ni) {
        float o[4][4];
#pragma unroll
        for (int gq = 0; gq < 4; ++gq)
#pragma unroll
          for (int e = 0; e < 4; ++e) o[gq][e] = sigmoidf_(acc[mi][ni][4 * gq + e]);
        *(u32x4*)(p.gbuf + gbuf_off(1, rb, cb0 + ni * 2, l2)) = pack8(o[0], o[1]);
        *(u32x4*)(p.gbuf + gbuf_off(1, rb, cb0 + ni * 2 + 1, l2)) = pack8(o[2], o[3]);
      }
    }
  }
}

struct EpiG2 {
  static constexpr bool PERM = true, AFTER_DRAIN = false, COLMAP = false;
  const bf16_t* gbuf; bf16_t* merged;
  __device__ __forceinline__ void operator()(const pg8::f32x4 (&acc)[2][2][4][2], const pg8::Unit& u, int wr, int wc, int fr, int fq) const {
    const int pass = u.pm >> 5, pm = u.pm & 31, pn = u.pn & 7;
#pragma unroll
    for (int ai = 0; ai < 2; ++ai)
#pragma unroll
      for (int m = 0; m < 4; ++m) {
        const int row = pm * 256 + ai * 128 + wr * 64 + m * 16 + fr;
#pragma unroll
        for (int bj = 0; bj < 2; ++bj) {
          const int col8 = pn * 256 + bj * 128 + wc * 32 + 8 * fq;
          const u32x4 gw = __builtin_nontemporal_load((const u32x4*)(gbuf + gbuf_off(pass, row >> 5, col8 >> 4, ((col8 >> 3) & 1) * 32 + (row & 31))));
          bf16_t* mp = merged + (size_t)row * DM + col8;
          float sg[8], o[8];
#pragma unroll
          for (int i = 0; i < 4; ++i) { sg[2 * i] = __uint_as_float(gw[i] << 16); sg[2 * i + 1] = __uint_as_float(gw[i] & 0xffff0000u); }
#pragma unroll
          for (int e = 0; e < 4; ++e) { o[e] = sg[e] * acc[ai][bj][m][0][e]; o[4 + e] = sg[4 + e] * acc[ai][bj][m][1][e]; }
          if (pass) {
            const u32x4 tw = *(const u32x4*)mp;
#pragma unroll
            for (int i = 0; i < 4; ++i) { o[2 * i] += __uint_as_float(tw[i] << 16); o[2 * i + 1] += __uint_as_float(tw[i] & 0xffff0000u); }
          }
          u32x4 w; w[0] = cvtpk(o[0], o[1]); w[1] = cvtpk(o[2], o[3]); w[2] = cvtpk(o[4], o[5]); w[3] = cvtpk(o[6], o[7]);
          *(u32x4*)mp = w;
        }
        asm volatile("" ::: "memory");
      }
  }
};
struct SchedG2 {
  int b;
  __device__ __forceinline__ bool next(int i, pg8::Unit& u) const { if (i >= 2) return false; u.pm = (b & 31) + 32 * i; u.pn = (b >> 5) + 8 * i; return true; }
  __device__ __forceinline__ void a_ready(const pg8::Unit&) const {}
  __device__ __forceinline__ void done(const pg8::Unit&) const {}
};
__device__ __forceinline__ void phase_gemm2(const Params& p, char* lds) {
  pg8::Gemm g{p.U, p.waT, 2 * MTOK, 2 * DM, BW};
  SchedG2 S{(int)blockIdx.x}; EpiG2 E{p.gbuf, p.merged};
  pg8::gemm_phase<EpiG2, SchedG2, true, true>((LAS unsigned char*)lds, g, S, E);
}

struct EpiG3 {
  static constexpr bool PERM = true, AFTER_DRAIN = true, COLMAP = false;
  const float* x; float* out; float* ssq; const float* fg; const XcdBarrier* xb;
  __device__ __forceinline__ void fused(pg8::f32x4 (&acc)[2][2][4][2], const pg8::Unit& u, int wr, int wc, int fr, int fq, LAS unsigned char*, int, int) const {
    const int colw = u.pn * 256 + wc * 32 + 8 * fq;
#pragma unroll
    for (int ai = 0; ai < 2; ++ai)
#pragma unroll
      for (int m = 0; m < 4; ++m) {
        const int row = u.pm * 256 + ai * 128 + wr * 64 + m * 16 + fr;
        float ss = 0.f;
#pragma unroll
        for (int bj = 0; bj < 2; ++bj) {
          const float* xp = x + (size_t)row * DM + colw + bj * 128;
          const f32x4 xa = __builtin_nontemporal_load((const f32x4*)xp), xc = __builtin_nontemporal_load((const f32x4*)(xp + 4));
#pragma unroll
          for (int e = 0; e < 4; ++e) { const float y0 = acc[ai][bj][m][0][e] + xa[e], y1 = acc[ai][bj][m][1][e] + xc[e]; acc[ai][bj][m][0][e] = y0; acc[ai][bj][m][1][e] = y1; ss += y0 * y0 + y1 * y1; }
        }
        ss += __shfl_xor(ss, 16); ss += __shfl_xor(ss, 32);
        if (fq == 0) ssq[row * 32 + u.pn * 4 + wc] = ss;
        asm volatile("" ::: "memory");
      }
    xcd_barrier(*xb);
#pragma unroll
    for (int ai = 0; ai < 2; ++ai)
#pragma unroll
      for (int m = 0; m < 4; ++m) {
        const int row = u.pm * 256 + ai * 128 + wr * 64 + m * 16 + fr;
        const f32x4* sp = (const f32x4*)(ssq + row * 32);
        float tot = 0.f;
#pragma unroll
        for (int q = 0; q < 8; ++q) { const f32x4 t = sp[q]; tot += (t[0] + t[1]) + (t[2] + t[3]); }
        const float rinv = rsqrtf(tot * (1.0f / DM) + EPS);
#pragma unroll
        for (int bj = 0; bj < 2; ++bj) {
          const int col = colw + bj * 128;
          const f32x4 g0 = *(const f32x4*)(fg + col), g1 = *(const f32x4*)(fg + col + 4);
          f32x4 o0, o1;
#pragma unroll
          for (int e = 0; e < 4; ++e) { o0[e] = acc[ai][bj][m][0][e] * rinv * g0[e]; o1[e] = acc[ai][bj][m][1][e] * rinv * g1[e]; }
          float* op = out + (size_t)row * DM + col;
          __builtin_nontemporal_store(o0, (f32x4*)op); __builtin_nontemporal_store(o1, (f32x4*)(op + 4));
        }
        asm volatile("" ::: "memory");
      }
  }
};
struct SchedOne {
  int b;
  __device__ __forceinline__ bool next(int i, pg8::Unit& u) const { if (i >= 1) return false; u.pm = b & 31; u.pn = b >> 5; return true; }
  __device__ __forceinline__ void a_ready(const pg8::Unit&) const {}
  __device__ __forceinline__ void done(const pg8::Unit&) const {}
};
__device__ __forceinline__ void phase_gemm3_final(const Params& p, char* lds, const XcdBarrier& xb) {
  pg8::Gemm g{p.merged, p.woT, MTOK, DM, DM};
  SchedOne S{(int)blockIdx.x}; EpiG3 E{p.x, p.out, p.ssq, p.final_g, &xb};
  pg8::gemm_phase<EpiG3, SchedOne, false, true>((LAS unsigned char*)lds, g, S, E);
}

constexpr int KVBLK = 64;
constexpr size_t SHM_V = KVBLK * 128 * 2, SHM_K = KVBLK * 128 * 2;
constexpr int ATT_TILE = 32768, ATT_WS = 131072 + 64;
constexpr float THR = 8.f;
#define KSWZ(row, colB) ((row) * 256 + ((colB) ^ (((row) & 7) << 4)))

template <int DQK> struct AttnC { static constexpr float SCALE = (DQK == 64) ? 0.125f : 0.088388347648318440f; };

template <int DQK>
__device__ __forceinline__ void partialSM(f32x16& p0, f32x16& p1, float& m_reg, float& mn, float& alpha) {
  constexpr float SCALE = AttnC<DQK>::SCALE;
  constexpr float C = SCALE * 1.4426950408889634f;
  float pmax = p0[0];
#pragma unroll
  for (int r = 1; r < 16; ++r) pmax = fmaxf(pmax, p0[r]);
#pragma unroll
  for (int r = 0; r < 16; ++r) pmax = fmaxf(pmax, p1[r]);
  { auto rr = __builtin_amdgcn_permlane32_swap(__float_as_uint(pmax), __float_as_uint(pmax), false, false);
    pmax = fmaxf(__uint_as_float(rr[0]), __uint_as_float(rr[1])); }
  if (__builtin_expect(__all(pmax - m_reg <= THR / SCALE), 1)) { mn = m_reg; alpha = 1.f; }
  else { mn = fmaxf(m_reg, pmax); alpha = __builtin_amdgcn_exp2f((m_reg - mn) * C); m_reg = mn; }
  const float mnC = -mn * C;
#pragma unroll
  for (int r = 0; r < 16; ++r) p0[r] = fmaf(p0[r], C, mnC);
#pragma unroll
  for (int r = 0; r < 16; ++r) p1[r] = fmaf(p1[r], C, mnC);
#pragma unroll
  for (int r = 0; r < 16; ++r) p0[r] = __builtin_amdgcn_exp2f(p0[r]);
}
__device__ __forceinline__ void finishSM(f32x16& p0, f32x16& p1, float alpha, float& l_reg, bf16x8& pa0, bf16x8& pa1, bf16x8& pa2, bf16x8& pa3) {
#pragma unroll
  for (int r = 0; r < 16; ++r) p1[r] = __builtin_amdgcn_exp2f(p1[r]);
  float ps = 0;
#pragma unroll
  for (int r = 0; r < 16; ++r) ps += p0[r];
#pragma unroll
  for (int r = 0; r < 16; ++r) ps += p1[r];
  { auto rr = __builtin_amdgcn_permlane32_swap(__float_as_uint(ps), __float_as_uint(ps), false, false);
    ps = __uint_as_float(rr[0]) + __uint_as_float(rr[1]); }
  l_reg = l_reg * alpha + ps;
#define PK4(P, BASE, OUT) do { unsigned a0 = cvtpk(P[BASE + 0], P[BASE + 1]), a1 = cvtpk(P[BASE + 2], P[BASE + 3]);   \
    unsigned b0 = cvtpk(P[BASE + 4], P[BASE + 5]), b1 = cvtpk(P[BASE + 6], P[BASE + 7]);                              \
    auto r0 = __builtin_amdgcn_permlane32_swap(a0, b0, false, false); auto r1 = __builtin_amdgcn_permlane32_swap(a1, b1, false, false); \
    u32x4 w = {r0[0], r1[0], r0[1], r1[1]}; OUT = *reinterpret_cast<bf16x8*>(&w); } while (0)
  PK4(p0, 0, pa0); PK4(p0, 8, pa1); PK4(p1, 0, pa2); PK4(p1, 8, pa3);
#undef PK4
}
template <int DQK>
__device__ __forceinline__ void qkt(f32x16& p0, f32x16& p1, const LAS char* Ks, const bf16x8* qr, int r32, int hi) {
  constexpr int PITCH = DQK * 2;
  const int sw = (DQK == 128) ? (r32 & 7) : ((r32 >> 1) & 7);
  p0 = f32x16{}; p1 = f32x16{};
#pragma unroll
  for (int d0 = 0; d0 < DQK / 16; ++d0) { const int co = ((d0 * 2 + hi) ^ sw) << 4;
    bf16x8 b0 = *reinterpret_cast<const LAS bf16x8*>(Ks + r32 * PITCH + co);
    bf16x8 b1 = *reinterpret_cast<const LAS bf16x8*>(Ks + (32 + r32) * PITCH + co);
    p0 = __builtin_amdgcn_mfma_f32_32x32x16_bf16(b0, qr[d0], p0, 0, 0, 0);
    p1 = __builtin_amdgcn_mfma_f32_32x32x16_bf16(b1, qr[d0], p1, 0, 0, 0); }
}
__device__ __forceinline__ int v_st(int k, int c) { const int kk = (k & ~0xC) | ((k & 4) << 1) | ((k & 8) >> 1); return ((kk >> 3) * 4 + (c >> 5)) * 512 + ((kk & 7) * 32 + (c & 31)) * 2; }
__device__ __forceinline__ int v_rd_base(int lane) { return ((lane & 3) << 3) | (((lane >> 2) & 3) << 6) | (((lane >> 4) & 1) << 5) | (((lane >> 5) & 1) << 8); }
constexpr int v_rd_off(int d0, int ks, int half) { return d0 * 512 + ks * 4096 + half * 2048; }
template <int OFF> __device__ __forceinline__ s16x4 tr_read(int vb) {
  s16x4 r; asm volatile("ds_read_b64_tr_b16 %0, %1 offset:%2" : "=&v"(r) : "v"(vb), "i"(OFF) : "memory"); return r;
}
template <int D0> __device__ __forceinline__ void pv_one(f32x16& od, int vb, bf16x8 pa0, bf16x8 pa1, bf16x8 pa2, bf16x8 pa3) {
  const s16x4 l0 = tr_read<v_rd_off(D0, 0, 0)>(vb), h0 = tr_read<v_rd_off(D0, 0, 1)>(vb), l1 = tr_read<v_rd_off(D0, 1, 0)>(vb), h1 = tr_read<v_rd_off(D0, 1, 1)>(vb);
  const s16x4 l2 = tr_read<v_rd_off(D0, 2, 0)>(vb), h2 = tr_read<v_rd_off(D0, 2, 1)>(vb), l3 = tr_read<v_rd_off(D0, 3, 0)>(vb), h3 = tr_read<v_rd_off(D0, 3, 1)>(vb);
  asm volatile("s_waitcnt lgkmcnt(0)" ::: "memory"); SBAR();
#define PK(L, H) (bf16x8){L[0], L[1], L[2], L[3], H[0], H[1], H[2], H[3]}
  od = __builtin_amdgcn_mfma_f32_32x32x16_bf16(pa0, PK(l0, h0), od, 0, 0, 0);
  od = __builtin_amdgcn_mfma_f32_32x32x16_bf16(pa1, PK(l1, h1), od, 0, 0, 0);
  od = __builtin_amdgcn_mfma_f32_32x32x16_bf16(pa2, PK(l2, h2), od, 0, 0, 0);
  od = __builtin_amdgcn_mfma_f32_32x32x16_bf16(pa3, PK(l3, h3), od, 0, 0, 0);
#undef PK
}
template <int DQK, class ISS>
__device__ __forceinline__ void pv_sm(f32x16 (&o)[4], int vb, bf16x8 pa0, bf16x8 pa1, bf16x8 pa2, bf16x8 pa3,
                                      f32x16& p0, f32x16& p1, float& m_reg, float& mn, float& alpha, const ISS& iss) {
  constexpr float SCALE = AttnC<DQK>::SCALE;
  constexpr float C = SCALE * 1.4426950408889634f;
#define PK(L, H) (bf16x8){L[0], L[1], L[2], L[3], H[0], H[1], H[2], H[3]}
#define PV_READS(D0) const s16x4 l0 = tr_read<v_rd_off(D0, 0, 0)>(vb), h0 = tr_read<v_rd_off(D0, 0, 1)>(vb), l1 = tr_read<v_rd_off(D0, 1, 0)>(vb), h1 = tr_read<v_rd_off(D0, 1, 1)>(vb); \
    const s16x4 l2 = tr_read<v_rd_off(D0, 2, 0)>(vb), h2 = tr_read<v_rd_off(D0, 2, 1)>(vb), l3 = tr_read<v_rd_off(D0, 3, 0)>(vb), h3 = tr_read<v_rd_off(D0, 3, 1)>(vb); \
    asm volatile("s_waitcnt lgkmcnt(0)" ::: "memory"); SBAR();
#define PV_MMA(D0) o[D0] = __builtin_amdgcn_mfma_f32_32x32x16_bf16(pa0, PK(l0, h0), o[D0], 0, 0, 0); o[D0] = __builtin_amdgcn_mfma_f32_32x32x16_bf16(pa1, PK(l1, h1), o[D0], 0, 0, 0); \
    o[D0] = __builtin_amdgcn_mfma_f32_32x32x16_bf16(pa2, PK(l2, h2), o[D0], 0, 0, 0); o[D0] = __builtin_amdgcn_mfma_f32_32x32x16_bf16(pa3, PK(l3, h3), o[D0], 0, 0, 0);
  float pmax, mnC;
  { PV_READS(0)
    iss(0);
    pmax = p0[0];
#pragma unroll
    for (int r = 1; r < 16; ++r) pmax = fmaxf(pmax, p0[r]);
    PV_MMA(0) }
  { PV_READS(1)
    iss(1);
#pragma unroll
    for (int r = 0; r < 16; ++r) pmax = fmaxf(pmax, p1[r]);
    { auto rr = __builtin_amdgcn_permlane32_swap(__float_as_uint(pmax), __float_as_uint(pmax), false, false);
      pmax = fmaxf(__uint_as_float(rr[0]), __uint_as_float(rr[1])); }
    const bool keep = __all(pmax - m_reg <= THR / SCALE);
    mn = keep ? m_reg : fmaxf(m_reg, pmax);
    alpha = __builtin_amdgcn_exp2f((m_reg - mn) * C);
    m_reg = mn; mnC = -mn * C;
    PV_MMA(1) }
  { PV_READS(2)
    iss(2);
#pragma unroll
    for (int r = 0; r < 16; ++r) p0[r] = fmaf(p0[r], C, mnC);
#pragma unroll
    for (int r = 0; r < 16; ++r) p1[r] = fmaf(p1[r], C, mnC);
    PV_MMA(2) }
  { PV_READS(3)
    iss(3);
#pragma unroll
    for (int r = 0; r < 16; ++r) p0[r] = __builtin_amdgcn_exp2f(p0[r]);
    PV_MMA(3) }
#undef PK
#undef PV_READS
#undef PV_MMA
}
__device__ __forceinline__ void pv_d0(f32x16 (&o)[4], int vb, bf16x8 pa0, bf16x8 pa1, bf16x8 pa2, bf16x8 pa3) {
  pv_one<0>(o[0], vb, pa0, pa1, pa2, pa3); pv_one<1>(o[1], vb, pa0, pa1, pa2, pa3); pv_one<2>(o[2], vb, pa0, pa1, pa2, pa3); pv_one<3>(o[3], vb, pa0, pa1, pa2, pa3);
}

template <int DQK>
__device__ __forceinline__ void attn_body(const bf16_t* __restrict__ Qb, const bf16_t* __restrict__ Kh, const bf16_t* __restrict__ Vh,
                                          char* lds, f32x16 (&o)[4], float& l_out) {
  constexpr int LD = CT;
  constexpr int NQ = DQK / 16, PK = DQK / 64, P = 2 + PK;
  const int tid = threadIdx.x, wid = __builtin_amdgcn_readfirstlane(tid >> 6), lane = tid & 63, r32 = lane & 31, hi = lane >> 5;
  LAS char* ldsl = (LAS char*)lds;
  float* ws = (float*)(lds + ATT_WS) + wid * 64; float* al_l = ws + 32;
  float m_reg = -1e30f, l_reg = 0;
#pragma unroll
  for (int d = 0; d < 4; ++d) o[d] = f32x16{};
  bf16x8 qr[NQ];
  const bf16_t* Qw = Qb + (size_t)(wid * 32 + r32) * LD + hi * 8;
#pragma unroll
  for (int d0 = 0; d0 < NQ; ++d0) qr[d0] = __builtin_nontemporal_load((const bf16x8*)(Qw + d0 * 16));
  unsigned vgo[2], kgo[2];
#pragma unroll
  for (int i = 0; i < 2; ++i) {
    const int kk = (i * 4 + (tid >> 7)) * 8 + ((tid & 31) >> 2), c = ((tid >> 5) & 3) * 32 + (tid & 3) * 8;
    const int k = (kk & ~0xC) | ((kk & 4) << 1) | ((kk & 8) >> 1);
    vgo[i] = (unsigned)(k * LD + c) * 2u;
    if (DQK == 128) { const int row = i * 32 + (tid >> 4), lc = (tid & 15) ^ (row & 7); kgo[i] = (unsigned)(row * LD + lc * 8) * 2u; }
    else { const int row = tid >> 3, lc = (tid & 7) ^ ((row >> 1) & 7); kgo[i] = (unsigned)(row * LD + lc * 8) * 2u; }
  }
  const char* Vb = (const char*)Vh; const char* Kb = (const char*)Kh;
#define A_ISSUE(t_) do { const size_t ko_ = (size_t)(t_) * (KVBLK * LD * 2); LAS char* bb_ = ldsl + ((t_) & 3) * ATT_TILE + wid * 1024; \
    __builtin_amdgcn_global_load_lds((const unsigned*)(Vb + ko_ + vgo[0]), (LAS unsigned*)(bb_), 16, 0, 0); \
    __builtin_amdgcn_global_load_lds((const unsigned*)(Vb + ko_ + vgo[1]), (LAS unsigned*)(bb_ + 8192), 16, 0, 0); \
    __builtin_amdgcn_global_load_lds((const unsigned*)(Kb + ko_ + kgo[0]), (LAS unsigned*)(bb_ + 16384), 16, 0, 0); \
    if constexpr (DQK == 128) __builtin_amdgcn_global_load_lds((const unsigned*)(Kb + ko_ + kgo[1]), (LAS unsigned*)(bb_ + 16384 + 8192), 16, 0, 0); } while (0)
  auto a_piece = [&](int t_, int j_) {
    const size_t ko_ = (size_t)t_ * (KVBLK * LD * 2); LAS char* bb_ = ldsl + (t_ & 3) * ATT_TILE + wid * 1024;
    if (j_ == 0) __builtin_amdgcn_global_load_lds((const unsigned*)(Vb + ko_ + vgo[0]), (LAS unsigned*)(bb_), 16, 0, 0);
    else if (j_ == 1) __builtin_amdgcn_global_load_lds((const unsigned*)(Vb + ko_ + vgo[1]), (LAS unsigned*)(bb_ + 8192), 16, 0, 0);
    else if (j_ == 2) __builtin_amdgcn_global_load_lds((const unsigned*)(Kb + ko_ + kgo[0]), (LAS unsigned*)(bb_ + 16384), 16, 0, 0);
    else if (DQK == 128) __builtin_amdgcn_global_load_lds((const unsigned*)(Kb + ko_ + kgo[1]), (LAS unsigned*)(bb_ + 16384 + 8192), 16, 0, 0);
  };
#define A_WAITBAR(N) do { asm volatile("s_waitcnt vmcnt(%0)" :: "n"(N) : "memory"); __builtin_amdgcn_s_barrier(); asm volatile("" ::: "memory"); } while (0)
#define KBUF(t_) ((const LAS char*)(ldsl + ((t_) & 3) * ATT_TILE + 16384))
#define VBUF(t_) ((int)(uintptr_t)(ldsl + ((t_) & 3) * ATT_TILE) + vrb)
#define RESC(a) do { if (__any((a) < 1.f)) { if (hi == 0) al_l[r32] = (a); asm volatile("s_waitcnt lgkmcnt(0)" ::: "memory"); \
    _Pragma("unroll") for (int d = 0; d < 4; ++d) _Pragma("unroll") for (int r = 0; r < 16; ++r) o[d][r] *= al_l[crow(r, hi)]; } } while (0)
  const int vrb = v_rd_base(lane);
  f32x16 pA0, pA1, pB0, pB1; float mnA, mnB, alA, alB; bf16x8 pa0, pa1, pa2, pa3; constexpr int NT = SEQ / KVBLK;
  A_ISSUE(0); A_ISSUE(1);
  A_WAITBAR(P);
  qkt<DQK>(pA0, pA1, KBUF(0), qr, r32, hi); partialSM<DQK>(pA0, pA1, m_reg, mnA, alA);
  A_ISSUE(2);
  A_WAITBAR(P);
  for (int n = 1; n + 1 < NT; n += 2) {
    SBAR(); qkt<DQK>(pB0, pB1, KBUF(n), qr, r32, hi);
    finishSM(pA0, pA1, alA, l_reg, pa0, pa1, pa2, pa3); SBAR();
    pv_sm<DQK>(o, VBUF(n - 1), pa0, pa1, pa2, pa3, pB0, pB1, m_reg, mnB, alB, [&](int j_) { a_piece(n + 2, j_); });
    A_WAITBAR(P);
    RESC(alB);
    SBAR(); qkt<DQK>(pA0, pA1, KBUF(n + 1), qr, r32, hi);
    finishSM(pB0, pB1, alB, l_reg, pa0, pa1, pa2, pa3); SBAR();
    { const bool more_ = (n + 3 < NT); pv_sm<DQK>(o, VBUF(n), pa0, pa1, pa2, pa3, pA0, pA1, m_reg, mnA, alA, [&](int j_) { if (more_) a_piece(n + 3, j_); }); }
    if (n + 3 < NT) A_WAITBAR(P); else A_WAITBAR(0);
    RESC(alA);
  }
  SBAR(); qkt<DQK>(pB0, pB1, KBUF(NT - 1), qr, r32, hi);
  finishSM(pA0, pA1, alA, l_reg, pa0, pa1, pa2, pa3); SBAR();
  pv_sm<DQK>(o, VBUF(NT - 2), pa0, pa1, pa2, pa3, pB0, pB1, m_reg, mnB, alB, [](int) {});
  RESC(alB);
  finishSM(pB0, pB1, alB, l_reg, pa0, pa1, pa2, pa3); SBAR();
  pv_d0(o, VBUF(NT - 1), pa0, pa1, pa2, pa3);
  l_out = l_reg;
#undef A_ISSUE
#undef A_WAITBAR
#undef KBUF
#undef VBUF
#undef RESC
}

__device__ __forceinline__ void attn_rli(float l_reg, char* lds, float (&rli)[16]) {
  const int tid = threadIdx.x, wid = tid >> 6, lane = tid & 63, r32 = lane & 31, hi = lane >> 5;
  float* li_l = (float*)(lds + ATT_WS) + wid * 64;
  if (hi == 0) li_l[r32] = l_reg;
  asm volatile("s_waitcnt lgkmcnt(0)" ::: "memory");
#pragma unroll
  for (int r = 0; r < 16; ++r) rli[r] = __builtin_amdgcn_rcpf(li_l[crow(r, hi)]);
  asm volatile("s_waitcnt lgkmcnt(0)" ::: "memory");
}

constexpr int EPI_RS = 68, EPI_WAVE_BYTES = 32 * EPI_RS * 4;
__device__ __forceinline__ void epi_put_half(const f32x16 (&o)[4], const float (&rli)[16], float* sc, int half, int r32, int hi) {
#pragma unroll
  for (int d0h = 0; d0h < 2; ++d0h)
#pragma unroll
    for (int r = 0; r < 16; ++r) sc[crow(r, hi) * EPI_RS + d0h * 32 + r32] = o[half * 2 + d0h][r] * rli[r];
}
__device__ __forceinline__ void epi_get(const float* sc, int q, int lane, float (&v)[8]) {
  const f32x4* sp = (const f32x4*)(sc + (q * 8 + (lane >> 3)) * EPI_RS + (lane & 7) * 8);
  const f32x4 a = sp[0], bq = sp[1];
  v[0] = a[0]; v[1] = a[1]; v[2] = a[2]; v[3] = a[3]; v[4] = bq[0]; v[5] = bq[1]; v[6] = bq[2]; v[7] = bq[3];
}
__device__ __forceinline__ void unpack8(const u32x4 w, float (&z)[8]) {
#pragma unroll
  for (int i = 0; i < 4; ++i) { z[2 * i] = __uint_as_float(w[i] << 16); z[2 * i + 1] = __uint_as_float(w[i] & 0xffff0000u); }
}

__device__ __forceinline__ void phase_attn(const Params& p, char* lds) {
  const int tid = threadIdx.x, wid = tid >> 6, lane = tid & 63;
  float* sc = (float*)(lds + wid * EPI_WAVE_BYTES);
  for (int k_ = 0; k_ < 2; ++k_) {
    const int it = ((blockIdx.x & 1) ^ k_) ? (int)blockIdx.x + 256 : (int)blockIdx.x;
    const int j = it & 255, xcd = j & 7, slot = j >> 3;
    const int bh = xcd * 2 + (slot >> 4), qblk = slot & 15;
    const int b = bh >> 3, h = bh & 7;
    const size_t tok0 = (size_t)b * SEQ;
    const size_t rowq = tok0 + qblk * 256;
    const int rowbase = (int)rowq + wid * 32;
    f32x16 o[4]; float l_reg; float rli[16];
    if (it < 256) {
      const int kvh = h >> 2;
      attn_body<128>(p.proj + rowq * CT + C_QB + h * 128, p.proj + tok0 * CT + C_KB + kvh * 128, p.proj + tok0 * CT + C_VB + kvh * 128, lds, o, l_reg);
      attn_rli(l_reg, lds, rli);
      __syncthreads();
      const int l2 = launder(lane), r32 = l2 & 31, hi = l2 >> 5;
#pragma unroll
      for (int half = 0; half < 2; ++half) {
        epi_put_half(o, rli, sc, half, r32, hi);
#pragma unroll
        for (int q = 0; q < 4; ++q) {
          float v[8], z[8]; epi_get(sc, q, l2, v);
          const size_t row = (size_t)(rowbase + q * 8 + (l2 >> 3)); const int col = h * 128 + half * 64 + (l2 & 7) * 8;
          unpack8(__builtin_nontemporal_load((const u32x4*)(p.proj + row * CT + C_ZB + col)), z);
          u32x4 w; w[0] = cvtpk(v[0] * z[0], v[1] * z[1]); w[1] = cvtpk(v[2] * z[2], v[3] * z[3]); w[2] = cvtpk(v[4] * z[4], v[5] * z[5]); w[3] = cvtpk(v[6] * z[6], v[7] * z[7]);
          *(u32x4*)(p.U + (size_t)MTOK * BW + row * BW + (col - h * 128) + h * 128) = w;
        }
      }
    } else {
      const bf16_t* Vp = p.proj + tok0 * CT + C_VA + h * 128;
      attn_body<64>(p.proj + rowq * CT + C_QA + h * 128, p.proj + tok0 * CT + C_KA + h * 128, Vp, lds, o, l_reg);
      attn_rli(l_reg, lds, rli);
      __syncthreads();
      {
        const int l2 = launder(lane), r32 = l2 & 31, hi = l2 >> 5;
#pragma unroll
        for (int half = 0; half < 2; ++half) {
          epi_put_half(o, rli, sc, half, r32, hi);
#pragma unroll
          for (int q = 0; q < 4; ++q) {
            float v[8]; epi_get(sc, q, l2, v);
            float* op = p.o1 + (size_t)(rowbase + q * 8 + (l2 >> 3)) * BW + h * 128 + half * 64 + (l2 & 7) * 8;
            f32x4 a = {v[0], v[1], v[2], v[3]}, c = {v[4], v[5], v[6], v[7]};
            *(f32x4*)op = a; *(f32x4*)(op + 4) = c;
          }
        }
      }
      __syncthreads();
      attn_body<64>(p.proj + rowq * CT + C_QA + h * 128 + 64, p.proj + tok0 * CT + C_KA + h * 128 + 64, Vp, lds, o, l_reg);
      attn_rli(l_reg, lds, rli);
      __syncthreads();
      const int l2 = launder(lane), r32 = l2 & 31, hi = l2 >> 5;
      float d1 = 0.f, d2 = 0.f;
      for (int i = 0; i < 64; ++i) { d1 += p.lq1[i] * p.lk1[i]; d2 += p.lq2[i] * p.lk2[i]; }
      const float lam = __expf(d1) - __expf(d2) + 0.2f;
      float t[2][4][8]; float ss[4] = {0.f, 0.f, 0.f, 0.f};
#pragma unroll
      for (int half = 0; half < 2; ++half) {
        epi_put_half(o, rli, sc, half, r32, hi);
#pragma unroll
        for (int q = 0; q < 4; ++q) {
          float v[8]; epi_get(sc, q, l2, v);
          const float* op = p.o1 + (size_t)(rowbase + q * 8 + (l2 >> 3)) * BW + h * 128 + half * 64 + (l2 & 7) * 8;
          const f32x4 a = *(const f32x4*)op, c = *(const f32x4*)(op + 4);
          const float o1v[8] = {a[0], a[1], a[2], a[3], c[0], c[1], c[2], c[3]};
#pragma unroll
          for (int e = 0; e < 8; ++e) { const float tv = o1v[e] - lam * v[e]; t[half][q][e] = tv; ss[q] += tv * tv; }
        }
      }
      float rinv[4];
#pragma unroll
      for (int q = 0; q < 4; ++q) { float x = ss[q]; x += __shfl_xor(x, 1); x += __shfl_xor(x, 2); x += __shfl_xor(x, 4); rinv[q] = rsqrtf(x * (1.0f / 128.0f) + EPS) * 0.8f; }
#pragma unroll
      for (int half = 0; half < 2; ++half) {
        const int colh = half * 64 + (l2 & 7) * 8;
        const f32x4 g0 = *(const f32x4*)(p.subln_g + colh), g1 = *(const f32x4*)(p.subln_g + colh + 4);
        const float sg[8] = {g0[0], g0[1], g0[2], g0[3], g1[0], g1[1], g1[2], g1[3]};
#pragma unroll
        for (int q = 0; q < 4; ++q) {
          const size_t row = (size_t)(rowbase + q * 8 + (l2 >> 3)); const int col = h * 128 + colh;
          float z[8]; unpack8(__builtin_nontemporal_load((const u32x4*)(p.proj + row * CT + C_ZA + col)), z);
          float ov[8];
#pragma unroll
          for (int e = 0; e < 8; ++e) ov[e] = t[half][q][e] * rinv[q] * sg[e] * z[e];
          u32x4 w; w[0] = cvtpk(ov[0], ov[1]); w[1] = cvtpk(ov[2], ov[3]); w[2] = cvtpk(ov[4], ov[5]); w[3] = cvtpk(ov[6], ov[7]);
          *(u32x4*)(p.U + row * BW + col) = w;
        }
      }
    }
    __syncthreads();
  }
}

__global__ void __launch_bounds__(512) mega(Params p) {
  extern __shared__ __attribute__((aligned(16))) char lds[];
  cg::grid_group grid = cg::this_grid();
  if (p.phase_lo < 0) grid.sync();
  volatile LAS unsigned* xst = (volatile LAS unsigned*)((LAS char*)lds + 131072);
  if (threadIdx.x < 4) xst[threadIdx.x] = 0u;
  __syncthreads();
  XcdBarrier xb = xcd_barrier_post(p.bar, xst);
  const int hi = p.phase_hi;
  if (hi >= 0) phase_prologue(p, lds);
  xcd_barrier(xb);
  if (hi >= 1) phase_gemm1(p, lds);
  xcd_barrier(xb);
  if (hi >= 2) phase_attn(p, lds);
  xcd_barrier(xb);
  if (hi >= 3) phase_gemm2(p, lds);
  xcd_barrier(xb);
  if (hi >= 4) phase_gemm3_final(p, lds, xb);
}

extern "C" void kernel_launch(void* const* d_in, const int* in_sizes, int n_in, void* d_out, int out_size, void* d_ws, size_t ws_size, hipStream_t stream) {
  static int grid_blocks = 0;
  if (!grid_blocks) {
    hipFuncSetAttribute((const void*)mega, hipFuncAttributeMaxDynamicSharedMemorySize, LDS_BYTES);
    int dev = 0, cus = 0, per_cu = 0;
    hipGetDevice(&dev);
    hipDeviceGetAttribute(&cus, hipDeviceAttributeMultiprocessorCount, dev);
    hipOccupancyMaxActiveBlocksPerMultiprocessor(&per_cu, mega, 512, LDS_BYTES);
    if (per_cu < 1) { fprintf(stderr, "occupancy query returned %d\n", per_cu); per_cu = 1; }
    grid_blocks = cus * per_cu;
    if (grid_blocks > 256) grid_blocks = 256;
    if (grid_blocks != 256) fprintf(stderr, "unexpected grid %d (need 256)\n", grid_blocks);
  }
  Params p{};
  p.x = (const float*)d_in[0]; p.norm_g = (const float*)d_in[1]; p.w_in = (const float*)d_in[2];
  p.lq1 = (const float*)d_in[3]; p.lk1 = (const float*)d_in[4]; p.lq2 = (const float*)d_in[5]; p.lk2 = (const float*)d_in[6];
  p.subln_g = (const float*)d_in[7]; p.qn_g = (const float*)d_in[8]; p.kn_g = (const float*)d_in[9];
  p.w_out_a = (const float*)d_in[10]; p.w_out_b = (const float*)d_in[11]; p.w_o = (const float*)d_in[12]; p.final_g = (const float*)d_in[13];
  p.out = (float*)d_out;
  char* w = (char*)d_ws; size_t off = 0;
  auto take = [&](size_t bytes) { char* r = w + off; off += (bytes + 255) & ~(size_t)255; return r; };
  p.h      = (bf16_t*)take((size_t)MTOK * DM * 2);
  p.o1     = (float*)p.h;
  p.merged = (bf16_t*)p.h;
  p.winT   = (bf16_t*)take((size_t)CT * DM * 2);
  p.waT    = (bf16_t*)take((size_t)DM * BW * 2);
  p.wbT    = (bf16_t*)take((size_t)DM * BW * 2);
  p.woT    = (bf16_t*)take((size_t)DM * DM * 2);
  p.proj   = (bf16_t*)take((size_t)MTOK * CT * 2);
  p.U      = (bf16_t*)d_out;
  p.gbuf   = (bf16_t*)take((size_t)2 * MTOK * DM * 2);
  p.rope   = (float2*)take((size_t)SEQ * 32 * 8);
  p.ssq    = (float*)take((size_t)MTOK * 32 * 4);
  p.bar    = (unsigned*)take(XCD_BAR_WORDS * 4);
  if (off > ws_size) { fprintf(stderr, "workspace too small: need %zu have %zu\n", off, ws_size); return; }
  if (grid_blocks != 256) return;
  p.phase_lo = 0; p.phase_hi = 5;
  hipMemsetAsync(p.bar, 0, XCD_BAR_WORDS * 4, stream);
  void* args[] = {&p};
  hipError_t e = hipLaunchCooperativeKernel((void*)mega, dim3(grid_blocks), dim3(512), args, LDS_BYTES, stream);
  if (e != hipSuccess) fprintf(stderr, "cooperative launch failed: %s (grid %d)\n", hipGetErrorString(e), grid_blocks);
}
```

```cpp
#include <hip/hip_runtime.h>
#include <hip/hip_cooperative_groups.h>
#include <cstdio>
#include <cstdint>
namespace cg = cooperative_groups;

#ifndef MK_LAUNCHES
#define MK_LAUNCHES 1
#endif

typedef unsigned short bf16_t;
using bf16x8 = __attribute__((ext_vector_type(8))) short;
using s16x4  = __attribute__((ext_vector_type(4))) short;
using f32x16 = __attribute__((ext_vector_type(16))) float;
using f32x4  = __attribute__((ext_vector_type(4))) float;
using u32x4  = __attribute__((ext_vector_type(4))) unsigned;
using u32x2  = __attribute__((ext_vector_type(2))) unsigned;

constexpr int MTOK = 8192, SEQ = 4096, DM = 2048, CT = 10752, BW = 1024;
constexpr int C_QA = 0, C_KA = 1024, C_VA = 2048, C_ZA = 3072, C_QB = 4096, C_KB = 5120, C_VB = 5376, C_ZB = 5632, C_GA = 6656, C_GB = 8704;
constexpr float EPS = 1e-6f;
constexpr int LDS_BYTES = 131072 + 64 + 4096;

struct Params {
  const float *x, *norm_g, *w_in, *lq1, *lk1, *lq2, *lk2, *subln_g, *qn_g, *kn_g, *w_out_a, *w_out_b, *w_o, *final_g;
  float* out;
  bf16_t *h, *winT, *waT, *wbT, *woT, *proj, *U, *merged;
  float* o1;
  float2* rope;
  float* ssq;
  unsigned* bar;
  bf16_t* gbuf;
  void* pad0;
  int phase_lo, phase_hi;
};

#define SBAR() __builtin_amdgcn_sched_barrier(0)
#define LAS __attribute__((address_space(3)))
__device__ __forceinline__ int crow(int r, int hi) { return (r & 3) + 8 * (r >> 2) + 4 * hi; }
__device__ __forceinline__ unsigned cvtpk(float lo, float hi) {
  unsigned r; asm volatile("s_nop 0\n\tv_cvt_pk_bf16_f32 %0, %1, %2" : "=v"(r) : "v"(lo), "v"(hi)); return r;
}
__device__ __forceinline__ float bf2f(bf16_t v) { return __uint_as_float(((unsigned)v) << 16); }
__device__ __forceinline__ bf16_t f2bf(float f) { return (bf16_t)(cvtpk(f, f) & 0xffffu); }
__device__ __forceinline__ float sigmoidf_(float v) { return __builtin_amdgcn_rcpf(1.f + __expf(-v)); }

__device__ __forceinline__ void transpose_cvt_strip(const float* __restrict__ W, bf16_t* __restrict__ Wt, int K, int N, int strip, float* tl) {
  const int tid = threadIdx.x;
  const int nsn = N >> 7;
  const int n0 = (strip % nsn) * 128, k0 = (strip / nsn) * 64;
  const int r = tid >> 5, c4 = (tid & 31) * 4;
  f32x4 v[4];
#pragma unroll
  for (int j = 0; j < 4; ++j) v[j] = __builtin_nontemporal_load((const f32x4*)(W + (size_t)(k0 + r + 16 * j) * N + n0 + c4));
#pragma unroll
  for (int j = 0; j < 4; ++j) { float* d = tl + (r + 16 * j) * 129 + c4; d[0] = v[j][0]; d[1] = v[j][1]; d[2] = v[j][2]; d[3] = v[j][3]; }
  __syncthreads();
#pragma unroll
  for (int i = 0; i < 2; ++i) {
    const int id = tid + 512 * i, n = id >> 3, kc = (id & 7) * 8;
    u32x4 w;
    w[0] = cvtpk(tl[(kc + 0) * 129 + n], tl[(kc + 1) * 129 + n]);
    w[1] = cvtpk(tl[(kc + 2) * 129 + n], tl[(kc + 3) * 129 + n]);
    w[2] = cvtpk(tl[(kc + 4) * 129 + n], tl[(kc + 5) * 129 + n]);
    w[3] = cvtpk(tl[(kc + 6) * 129 + n], tl[(kc + 7) * 129 + n]);
    *(u32x4*)(Wt + (size_t)(n0 + n) * K + k0 + kc) = w;
  }
  __syncthreads();
}
__device__ __forceinline__ void transpose_late_weights(const Params& p, char* lds, int worker, int nworkers) {
  float* tl = (float*)lds;
  constexpr int S_OA = (BW / 64) * (DM / 128), S_WO = (DM / 64) * (DM / 128);
  for (int t = worker; t < 2 * S_OA + S_WO; t += nworkers) {
    if (t < S_OA) transpose_cvt_strip(p.w_out_a, p.waT, BW, DM, t, tl);
    else if (t < 2 * S_OA) transpose_cvt_strip(p.w_out_b, p.wbT, BW, DM, t - S_OA, tl);
    else transpose_cvt_strip(p.w_o, p.woT, DM, DM, t - 2 * S_OA, tl);
  }
}

__device__ __forceinline__ void phase_prologue(const Params& p, char* lds) {
  const int tid = threadIdx.x, wid = tid >> 6, lane = tid & 63;
  for (int i = blockIdx.x * 512 + tid; i < SEQ * 32; i += gridDim.x * 512) {
    const int pos = i >> 5, f = i & 31;
    const float inv = 1.0f / exp2f((float)f * (13.287712379549449f / 32.0f));
    const float ang = (float)pos * inv;
    const double rev = (double)ang * 0.15915494309189535;
    const float fr = (float)(rev - rint(rev));
    float2 cs; cs.x = __builtin_amdgcn_cosf(fr); cs.y = __builtin_amdgcn_sinf(fr);
    p.rope[i] = cs;
  }
  for (int row = blockIdx.x * 8 + wid; row < MTOK; row += gridDim.x * 8) {
    const float* xr = p.x + (size_t)row * DM;
    f32x4 v[8]; float ss = 0.f;
#pragma unroll
    for (int j = 0; j < 8; ++j) { v[j] = __builtin_nontemporal_load((const f32x4*)(xr + j * 256 + lane * 4)); ss += v[j][0] * v[j][0] + v[j][1] * v[j][1] + v[j][2] * v[j][2] + v[j][3] * v[j][3]; }
#pragma unroll
    for (int m = 1; m < 64; m <<= 1) ss += __shfl_xor(ss, m);
    const float rinv = rsqrtf(ss * (1.0f / DM) + EPS);
    bf16_t* hr = p.h + (size_t)row * DM;
#pragma unroll
    for (int j = 0; j < 8; ++j) {
      const f32x4 g = *(const f32x4*)(p.norm_g + j * 256 + lane * 4);
      u32x2 w; w[0] = cvtpk(v[j][0] * rinv * g[0], v[j][1] * rinv * g[1]); w[1] = cvtpk(v[j][2] * rinv * g[2], v[j][3] * rinv * g[3]);
      *(u32x2*)(hr + j * 256 + lane * 4) = w;
    }
  }
  float* tl = (float*)lds;
  constexpr int S_IN = (DM / 64) * (CT / 128);
  for (int t = blockIdx.x; t < S_IN; t += gridDim.x) transpose_cvt_strip(p.w_in, p.winT, DM, CT, t, tl);
}

template <int NI>
__device__ __forceinline__ void gemm_prefetch(const bf16_t* __restrict__ A, int lda, const bf16_t* __restrict__ Bt, int ldb, char* lds_) {
  constexpr int BN = NI * 64, NPB = BN / 128;
  constexpr int SA = 256 * 64, SB = BN * 64, STG = SA + SB;
  LAS char* lds = (LAS char*)lds_;
  const int tid = threadIdx.x, wid = __builtin_amdgcn_readfirstlane(tid >> 6);
  const int rowq = tid >> 2, lc = (tid & 3) ^ ((tid >> 4) & 3);
  const unsigned goA = (unsigned)(rowq * lda + lc * 8) * 2u, goB = (unsigned)(rowq * ldb + lc * 8) * 2u;
  const char* Ab0 = (const char*)A; const char* Bb0 = (const char*)Bt;
#pragma unroll
  for (int kt = 0; kt < 2; ++kt) {
    LAS char* sb_ = lds + kt * STG + wid * 1024;
#pragma unroll
    for (int i_ = 0; i_ < 2; ++i_) __builtin_amdgcn_global_load_lds((const unsigned*)(Ab0 + (size_t)kt * 64 + (size_t)(128 * i_) * lda * 2 + goA), (LAS unsigned*)(sb_ + i_ * 8192), 16, 0, 0);
#pragma unroll
    for (int i_ = 0; i_ < NPB; ++i_) __builtin_amdgcn_global_load_lds((const unsigned*)(Bb0 + (size_t)kt * 64 + (size_t)(128 * i_) * ldb * 2 + goB), (LAS unsigned*)(sb_ + SA + i_ * 8192), 16, 0, 0);
  }
}
template <int NI, bool PRE = false>
__device__ __forceinline__ void gemm_mainloop(const bf16_t* __restrict__ A, int lda, const bf16_t* __restrict__ Bt, int ldb, int K,
                                              f32x16 (&acc)[2][NI], char* lds_) {
  constexpr int BN = NI * 64, NPB = BN / 128;
  constexpr int SA = 256 * 64, SB = BN * 64, STG = SA + SB;
  constexpr int P = 2 + NPB;
  LAS char* lds = (LAS char*)lds_;
  const int tid = threadIdx.x, wid = __builtin_amdgcn_readfirstlane(tid >> 6), lane = tid & 63, r32 = lane & 31, hi = lane >> 5, wm = wid >> 1, wn = wid & 1;
  const int rowq = tid >> 2, lc = (tid & 3) ^ ((tid >> 4) & 3);
  const unsigned goA = (unsigned)(rowq * lda + lc * 8) * 2u, goB = (unsigned)(rowq * ldb + lc * 8) * 2u;
  const char* Ab0 = (const char*)A; const char* Bb0 = (const char*)Bt;
  const int nt = K >> 5;
#define G_ISSUE(kt_) do { const int st_ = (kt_) & 3; const char* An_ = Ab0 + (size_t)(kt_) * 64; const char* Bn_ = Bb0 + (size_t)(kt_) * 64; \
    LAS char* sb_ = lds + st_ * STG + wid * 1024; \
    _Pragma("unroll") for (int i_ = 0; i_ < 2; ++i_) __builtin_amdgcn_global_load_lds((const unsigned*)(An_ + (size_t)(128 * i_) * lda * 2 + goA), (LAS unsigned*)(sb_ + i_ * 8192), 16, 0, 0); \
    _Pragma("unroll") for (int i_ = 0; i_ < NPB; ++i_) __builtin_amdgcn_global_load_lds((const unsigned*)(Bn_ + (size_t)(128 * i_) * ldb * 2 + goB), (LAS unsigned*)(sb_ + SA + i_ * 8192), 16, 0, 0); } while (0)
#define G_PIECE(kt_, j_) do { const int st_ = (kt_) & 3; LAS char* sb_ = lds + st_ * STG + wid * 1024; \
    if ((j_) < 2) __builtin_amdgcn_global_load_lds((const unsigned*)(Ab0 + (size_t)(kt_) * 64 + (size_t)(128 * (j_)) * lda * 2 + goA), (LAS unsigned*)(sb_ + (j_) * 8192), 16, 0, 0); \
    else __builtin_amdgcn_global_load_lds((const unsigned*)(Bb0 + (size_t)(kt_) * 64 + (size_t)(128 * ((j_) - 2)) * ldb * 2 + goB), (LAS unsigned*)(sb_ + SA + ((j_) - 2) * 8192), 16, 0, 0); } while (0)
  if (!PRE) { asm volatile("s_waitcnt vmcnt(0)" ::: "memory"); G_ISSUE(0); G_ISSUE(1); }
  const int sw = (r32 >> 2) & 3;
  const int co0 = (hi ^ sw) << 4;
  const int aoff = (wm * 64 + r32) * 64, boff = SA + (wn * (BN / 2) + r32) * 64;
  constexpr int STEP = (2 * NI) / P;
#define DSR(dst, addr, OFF) asm volatile("ds_read_b128 %0, %1 offset:%2" : "=&v"(dst) : "v"(addr), "i"(OFF) : "memory")
#define DSR_SET(F, pa, pb) do { DSR(F.a[0], pa, 0); DSR(F.a[1], pa, 2048); _Pragma("unroll") for (int ni_ = 0; ni_ < NI; ++ni_) DSR(F.b[ni_], pb, ni_ * 2048); } while (0)
#define MMA_SET(F, KT_ISSUE) do { _Pragma("unroll") for (int mi_ = 0; mi_ < 2; ++mi_) _Pragma("unroll") for (int ni_ = 0; ni_ < NI; ++ni_) { \
      acc[mi_][ni_] = __builtin_amdgcn_mfma_f32_32x32x16_bf16(F.b[ni_], F.a[mi_], acc[mi_][ni_], 0, 0, 0); \
      const int idx_ = mi_ * NI + ni_; \
      if ((KT_ISSUE) >= 0 && (idx_ + 1) % STEP == 0 && (idx_ + 1) / STEP - 1 < P) { SBAR(); if (issue) G_PIECE((KT_ISSUE), (idx_ + 1) / STEP - 1); SBAR(); } } } while (0)
#define LWAIT(N) do { SBAR(); asm volatile("s_waitcnt lgkmcnt(%0)" :: "n"(N) : "memory"); SBAR(); } while (0)
  struct Frag { bf16x8 a[2]; bf16x8 b[NI]; };
  for (int kt = 0; kt < nt; kt += 2) {
    asm volatile("s_waitcnt vmcnt(0)" ::: "memory");
    __builtin_amdgcn_s_barrier();
    asm volatile("" ::: "memory");
    const bool issue = (kt + 2 < nt);
    const int sa_ = (int)(uintptr_t)(lds + (kt & 3) * STG), sb2_ = (int)(uintptr_t)(lds + ((kt + 1) & 3) * STG);
    Frag F0, F1;
    DSR_SET(F0, sa_ + aoff + co0, sa_ + boff + co0);
    DSR_SET(F1, sa_ + aoff + (co0 ^ 32), sa_ + boff + (co0 ^ 32));
    LWAIT(2 + NI);
    MMA_SET(F0, kt + 2);
    SBAR(); DSR_SET(F0, sb2_ + aoff + co0, sb2_ + boff + co0); SBAR();
    LWAIT(2 + NI);
    MMA_SET(F1, kt + 3);
    SBAR(); DSR_SET(F1, sb2_ + aoff + (co0 ^ 32), sb2_ + boff + (co0 ^ 32)); SBAR();
    LWAIT(2 + NI);
    MMA_SET(F0, -1);
    LWAIT(0);
    MMA_SET(F1, -1);
  }
#undef DSR
#undef DSR_SET
#undef MMA_SET
#undef LWAIT
  asm volatile("" ::: "memory");
  __builtin_amdgcn_s_barrier();
  asm volatile("" ::: "memory");
#undef G_ISSUE
#undef G_PIECE
}

namespace pg8 {
#define PG8_LAS __attribute__((address_space(3)))
typedef unsigned short bf16_t;
typedef short bf16x8 __attribute__((ext_vector_type(8)));
typedef float f32x4 __attribute__((ext_vector_type(4)));
typedef unsigned u32x4 __attribute__((ext_vector_type(4)));
constexpr int BM = 256, BK = 64, HALF = 128, HTB = HALF * BK * 2  , STAGE_BYTES = 8 * HTB, NXCD = 8, WGM = 8;

__host__ __device__ __forceinline__ int lds_byte(int r, int c) { const int st = (r >> 4) * 2 + (c >> 5), rr = r & 15, cc = c & 31, ob = rr * 64 + cc * 2; return st * 1024 + (ob ^ (((ob >> 9) & 1) << 5)); }
__host__ __device__ __forceinline__ void stage_rc(int b, int& R, int& C) { const int st = b / 1024, sb = b % 1024, swz = sb ^ (((sb >> 9) & 1) << 5); R = (st >> 1) * 16 + swz / 64; C = (st & 1) * 32 + (swz % 64) / 2; }
__host__ __device__ __forceinline__ int perm32(int rho) { const int n = rho >> 4, i = rho & 15; return 8 * (i >> 2) + 4 * n + (i & 3); }

struct Unit { int pm, pn; };
struct Gemm { const bf16_t* A; const bf16_t* Bt; int M, N, K; };

__device__ __forceinline__ unsigned cvt_pk_bf16(float lo, float hi) { unsigned r; asm volatile("v_cvt_pk_bf16_f32 %0, %1, %2" : "=v"(r) : "v"(lo), "v"(hi)); return r; }
template <class Epi, class Sched, bool ALIGN_EPI = false, bool SP2 = false>
__device__ __forceinline__ void gemm_phase(PG8_LAS unsigned char* lds, const Gemm g, const Sched& S, const Epi& E) {
    const int tid = threadIdx.x, wid = __builtin_amdgcn_readfirstlane(tid >> 6), lane = tid & 63, wr = wid >> 2, wc = wid & 3, fr = lane & 15, fq = lane >> 4;
    const int K = g.K, nt = K / BK;
    unsigned voffA[2], voffB[2];
#pragma unroll
    for (int i = 0; i < 2; ++i) { int R, C; stage_rc(tid * 16 + i * 8192, R, C); const int Rb = Epi::PERM ? ((R & ~31) + perm32(R & 31)) : R;
        voffA[i] = (unsigned)(R * K + C) * 2u; voffB[i] = (unsigned)(Rb * K + C) * 2u; }
    unsigned voffB1[2]; size_t hstepB = (size_t)HALF * K * 2;
#pragma unroll
    for (int i = 0; i < 2; ++i) { voffB1[i] = voffB[i];
        if constexpr (Epi::COLMAP) { int R, C; stage_rc(tid * 16 + i * 8192, R, C); const int c0 = 64 * (R >> 5) + perm32(R & 31);
            voffB[i] = (unsigned)(c0 * K + C) * 2u; voffB1[i] = (unsigned)((c0 + 32) * K + C) * 2u; } }
    if constexpr (Epi::COLMAP) hstepB = 0;
    const size_t kstep = (size_t)(BK * 2);
    const size_t hstep = (size_t)HALF * K * 2;
    const size_t tstep = 2 * hstep;
    const unsigned ldsw = (unsigned)wid * 1024u;
    const int aoff = lds_byte(wr * 64 + fr, fq * 8), boff = lds_byte(wc * 32 + fr, fq * 8);
#define PG8_SA(b, h) (((b) * 2 + (h)) * HTB)
#define PG8_SB(b, h) ((4 + (b) * 2 + (h)) * HTB)
#define PG8_STAGE(bufoff, gbase, voff) do { _Pragma("unroll") for (int _i = 0; _i < 2; ++_i) \
        __builtin_amdgcn_global_load_lds((const unsigned*)((const char*)(gbase) + (voff)[_i]), (PG8_LAS unsigned*)(lds + (bufoff) + ldsw + _i * 8192), 16, 0, 0); } while (0)
#define PG8_LDA(dst, b, h) do { _Pragma("unroll") for (int m = 0; m < 4; ++m) _Pragma("unroll") for (int k = 0; k < 2; ++k) dst[m][k] = *(const PG8_LAS bf16x8*)(lds + PG8_SA(b, h) + aoff + m * 2048 + k * 1024); } while (0)
#define PG8_LDB(dst, b, h) do { _Pragma("unroll") for (int n = 0; n < 2; ++n) _Pragma("unroll") for (int k = 0; k < 2; ++k) dst[n][k] = *(const PG8_LAS bf16x8*)(lds + PG8_SB(b, h) + boff + n * 2048 + k * 1024); } while (0)
#define PG8_MMA(ai, bj, At, Bt) do { __builtin_amdgcn_s_setprio(1); _Pragma("unroll") for (int m = 0; m < 4; ++m) _Pragma("unroll") for (int n = 0; n < 2; ++n) _Pragma("unroll") for (int k = 0; k < 2; ++k) \
        acc[ai][bj][m][n] = __builtin_amdgcn_mfma_f32_16x16x32_bf16(Bt[n][k], At[m][k], acc[ai][bj][m][n], 0, 0, 0); __builtin_amdgcn_s_setprio(0); } while (0)
#define PG8_WAIT_V(n) asm volatile("s_waitcnt vmcnt(" #n ")" ::: "memory")
#define PG8_WAIT_L(n) asm volatile("s_waitcnt lgkmcnt(" #n ")" ::: "memory")
#define PG8_BAR __builtin_amdgcn_s_barrier()
#define PG8_SCHED __builtin_amdgcn_sched_barrier(0)
    Unit cur, nxt; int ui = 0;
    if (!S.next(0, cur)) return;
    f32x4 acc[2][2][4][2];
#pragma unroll
    for (int a = 0; a < 2; ++a)
#pragma unroll
        for (int b = 0; b < 2; ++b)
#pragma unroll
            for (int m = 0; m < 4; ++m)
#pragma unroll
                for (int n = 0; n < 2; ++n) acc[a][b][m][n] = (f32x4){0.f, 0.f, 0.f, 0.f};
    bf16x8 At[4][2], B0[2][2], B1[2][2];
    const char* cA = (const char*)g.A + (size_t)cur.pm * tstep; const char* cB = (const char*)g.Bt + (size_t)cur.pn * tstep;
    S.a_ready(cur);
    if constexpr (SP2) {
        PG8_STAGE(PG8_SB(0, 0), cB, voffB); PG8_STAGE(PG8_SB(0, 1), cB + hstepB, voffB1); PG8_STAGE(PG8_SA(0, 0), cA, voffA); PG8_STAGE(PG8_SA(0, 1), cA + hstep, voffA);
        if (wr == 1) PG8_BAR;
        PG8_WAIT_V(2); PG8_BAR;
        PG8_STAGE(PG8_SB(1, 0), cB + kstep, voffB); PG8_STAGE(PG8_SA(1, 0), cA + kstep, voffA); PG8_STAGE(PG8_SB(1, 1), cB + hstepB + kstep, voffB1);
        PG8_WAIT_V(6); PG8_BAR;
    } else {
        PG8_STAGE(PG8_SB(0, 0), cB, voffB); PG8_STAGE(PG8_SA(0, 0), cA, voffA); PG8_STAGE(PG8_SB(0, 1), cB + hstepB, voffB1); PG8_STAGE(PG8_SA(0, 1), cA + hstep, voffA);
        if (wr == 1) PG8_BAR;
        PG8_WAIT_V(4); PG8_BAR;
        PG8_STAGE(PG8_SB(1, 0), cB + kstep, voffB); PG8_STAGE(PG8_SA(1, 0), cA + kstep, voffA); PG8_STAGE(PG8_SB(1, 1), cB + hstepB + kstep, voffB1);
        PG8_WAIT_V(6); PG8_BAR;
    }
    for (;;) {
        const bool has_next = S.next(ui + 1, nxt);
        const char* nA = has_next ? (const char*)g.A + (size_t)nxt.pm * tstep : cA; const char* nB = has_next ? (const char*)g.Bt + (size_t)nxt.pn * tstep : cB;
        for (int t = 0; t < nt; t += 2) {
            const bool last = (t == nt - 2);
            const char* a1 = cA + (size_t)(t + 1) * kstep;
            const char* a2 = last ? nA : cA + (size_t)(t + 2) * kstep; const char* b2 = last ? nB : cB + (size_t)(t + 2) * kstep;
            const char* a3 = a2 + kstep; const char* b3 = b2 + kstep;
            if (last && has_next) S.a_ready(nxt);
            if constexpr (SP2) {
            PG8_LDB(B0, 0, 0); PG8_LDB(B1, 0, 1); PG8_SCHED; PG8_LDA(At, 0, 0); PG8_STAGE(PG8_SA(1, 1), a1 + hstep, voffA);
            PG8_WAIT_V(8); PG8_WAIT_L(0); PG8_BAR; PG8_MMA(0, 0, At, B0); PG8_MMA(0, 1, At, B1); PG8_BAR; PG8_SCHED;
            PG8_LDA(At, 0, 1); PG8_STAGE(PG8_SB(0, 0), b2, voffB); PG8_STAGE(PG8_SB(0, 1), b2 + hstepB, voffB1); PG8_STAGE(PG8_SA(0, 0), a2, voffA);
            PG8_WAIT_V(8); PG8_WAIT_L(0); PG8_BAR; PG8_MMA(1, 0, At, B0); PG8_MMA(1, 1, At, B1); PG8_BAR; PG8_SCHED;
            PG8_LDB(B0, 1, 0); PG8_LDB(B1, 1, 1); PG8_SCHED; PG8_LDA(At, 1, 0); PG8_STAGE(PG8_SA(0, 1), a2 + hstep, voffA);
            PG8_WAIT_V(8); PG8_WAIT_L(0); PG8_BAR; PG8_MMA(0, 0, At, B0); PG8_MMA(0, 1, At, B1); PG8_BAR; PG8_SCHED;
            PG8_LDA(At, 1, 1); PG8_STAGE(PG8_SB(1, 0), b3, voffB); PG8_STAGE(PG8_SB(1, 1), b3 + hstepB, voffB1); PG8_STAGE(PG8_SA(1, 0), a3, voffA);
            PG8_WAIT_V(8); PG8_WAIT_L(0); PG8_BAR; PG8_MMA(1, 0, At, B0); PG8_MMA(1, 1, At, B1); PG8_BAR; PG8_SCHED;
            } else {
            PG8_LDB(B0, 0, 0); PG8_SCHED; PG8_LDA(At, 0, 0); PG8_STAGE(PG8_SA(1, 1), a1 + hstep, voffA);
            PG8_WAIT_L(8); PG8_BAR; PG8_WAIT_L(0); PG8_MMA(0, 0, At, B0); PG8_BAR; PG8_SCHED;
            PG8_LDB(B1, 0, 1); PG8_STAGE(PG8_SB(0, 0), b2, voffB);
            PG8_BAR; PG8_WAIT_L(0); PG8_MMA(0, 1, At, B1); PG8_BAR;
            PG8_LDA(At, 0, 1); PG8_STAGE(PG8_SA(0, 0), a2, voffA);
            PG8_BAR; PG8_WAIT_L(0); PG8_MMA(1, 0, At, B0); PG8_BAR; PG8_SCHED;
            PG8_STAGE(PG8_SB(0, 1), b2 + hstepB, voffB1);
            PG8_WAIT_V(6); PG8_BAR; PG8_MMA(1, 1, At, B1); PG8_BAR;
            PG8_LDB(B0, 1, 0); PG8_SCHED; PG8_LDA(At, 1, 0); PG8_STAGE(PG8_SA(0, 1), a2 + hstep, voffA);
            PG8_WAIT_L(8); PG8_BAR; PG8_WAIT_L(0); PG8_MMA(0, 0, At, B0); PG8_BAR; PG8_SCHED;
            PG8_LDB(B1, 1, 1); PG8_STAGE(PG8_SB(1, 0), b3, voffB);
            PG8_BAR; PG8_WAIT_L(0); PG8_MMA(0, 1, At, B1); PG8_BAR;
            PG8_LDA(At, 1, 1); PG8_STAGE(PG8_SA(1, 0), a3, voffA);
            PG8_BAR; PG8_WAIT_L(0); PG8_MMA(1, 0, At, B0); PG8_BAR; PG8_SCHED;
            PG8_STAGE(PG8_SB(1, 1), b3 + hstepB, voffB1);
            PG8_WAIT_V(6); PG8_BAR; PG8_MMA(1, 1, At, B1); PG8_BAR;
            }
        }
        if constexpr (ALIGN_EPI) { if (wr == 0) PG8_BAR; }
        if constexpr (!Epi::AFTER_DRAIN) { E(acc, cur, wr, wc, fr, fq); S.done(cur); }
        if (!has_next) break;
#pragma unroll
        for (int a = 0; a < 2; ++a)
#pragma unroll
            for (int b = 0; b < 2; ++b)
#pragma unroll
                for (int m = 0; m < 4; ++m)
#pragma unroll
                    for (int n = 0; n < 2; ++n) acc[a][b][m][n] = (f32x4){0.f, 0.f, 0.f, 0.f};
        cur = nxt; cA = nA; cB = nB; ++ui;
        if constexpr (ALIGN_EPI) { if (wr == 1) PG8_BAR; }
    }
    PG8_WAIT_V(0);
    if constexpr (!ALIGN_EPI) { if (wr == 0) PG8_BAR; }
    PG8_BAR;
    if constexpr (Epi::AFTER_DRAIN) { E.fused(acc, cur, wr, wc, fr, fq, lds, wid, lane); S.done(cur); }
#undef PG8_SA
#undef PG8_SB
#undef PG8_STAGE
#undef PG8_LDA
#undef PG8_LDB
#undef PG8_MMA
#undef PG8_WAIT_V
#undef PG8_WAIT_L
#undef PG8_BAR
#undef PG8_SCHED
}
}
__device__ __forceinline__ size_t gbuf_off(int gate, int rb, int cb, int lane) { return ((((size_t)gate * 256 + rb) * 128 + cb) * 64 + lane) * 8; }

struct EpiG1 {
  static constexpr bool PERM = true, AFTER_DRAIN = false, COLMAP = true;
  bf16_t* proj; bf16_t* gbuf; const float2* rope; const float* qn_g; const float* kn_g; float* xch;
  __device__ __forceinline__ void operator()(const pg8::f32x4 (&acc)[2][2][4][2], const pg8::Unit& u, int wr, int wc, int fr, int fq) const {
    const int colt = u.pn * 256;
    if (colt >= C_QB && colt < C_VB) { qknorm(acc, u, wr, wc, fr, fq); return; }
    const int type = (colt < C_VA) ? 0 : (colt >= C_GA) ? 3 : (((colt >= C_ZA && colt < C_QB) || (colt >= C_ZB && colt < C_GA)) ? 2 : 4);
#pragma unroll
    for (int ai = 0; ai < 2; ++ai)
#pragma unroll
      for (int m = 0; m < 4; ++m) {
        const int row = u.pm * 256 + ai * 128 + wr * 64 + m * 16 + fr;
        float v[2][8];
#pragma unroll
        for (int bj = 0; bj < 2; ++bj)
#pragma unroll
          for (int e = 0; e < 4; ++e) { v[bj][e] = acc[ai][bj][m][0][e]; v[bj][4 + e] = acc[ai][bj][m][1][e]; }
        if (type == 0) {
          const f32x4* tp = (const f32x4*)(rope + (row & (SEQ - 1)) * 32 + 8 * fq);
#pragma unroll
          for (int q = 0; q < 4; ++q) { const f32x4 cs = tp[q];
            { const float x1 = v[0][2 * q], x2 = v[1][2 * q]; v[0][2 * q] = x1 * cs[0] - x2 * cs[1]; v[1][2 * q] = x2 * cs[0] + x1 * cs[1]; }
            { const float x1 = v[0][2 * q + 1], x2 = v[1][2 * q + 1]; v[0][2 * q + 1] = x1 * cs[2] - x2 * cs[3]; v[1][2 * q + 1] = x2 * cs[2] + x1 * cs[3]; } }
        } else if (type == 2) {
#pragma unroll
          for (int bj = 0; bj < 2; ++bj)
#pragma unroll
            for (int e = 0; e < 8; ++e) v[bj][e] = v[bj][e] * sigmoidf_(v[bj][e]);
        } else if (type == 3) {
#pragma unroll
          for (int bj = 0; bj < 2; ++bj)
#pragma unroll
            for (int e = 0; e < 8; ++e) v[bj][e] = sigmoidf_(v[bj][e]);
        }
#pragma unroll
        for (int bj = 0; bj < 2; ++bj) {
          const int col8 = colt + 64 * wc + 32 * bj + 8 * fq;
          u32x4 w; w[0] = cvtpk(v[bj][0], v[bj][1]); w[1] = cvtpk(v[bj][2], v[bj][3]); w[2] = cvtpk(v[bj][4], v[bj][5]); w[3] = cvtpk(v[bj][6], v[bj][7]);
          if (type == 3) {
            const int gate = (col8 >= C_GB) ? 1 : 0, gc = col8 - (gate ? C_GB : C_GA);
            *(u32x4*)(gbuf + gbuf_off(gate, row >> 5, gc >> 4, ((gc >> 3) & 1) * 32 + (row & 31))) = w;
          } else {
            *(u32x4*)(proj + (size_t)row * CT + col8) = w;
          }
        }
        asm volatile("" ::: "memory");
      }
  }
  __device__ __forceinline__ void qknorm(const pg8::f32x4 (&acc)[2][2][4][2], const pg8::Unit& u, int wr, int wc, int fr, int fq) const {
    const int colt = u.pn * 256, wid = wr * 4 + wc;
    const float* g = (colt < C_KB) ? qn_g : kn_g;
#pragma unroll
    for (int ai = 0; ai < 2; ++ai)
#pragma unroll
      for (int m = 0; m < 4; ++m) {
        float ss = 0.f;
#pragma unroll
        for (int bj = 0; bj < 2; ++bj)
#pragma unroll
          for (int n = 0; n < 2; ++n)
#pragma unroll
            for (int e = 0; e < 4; ++e) ss += acc[ai][bj][m][n][e] * acc[ai][bj][m][n][e];
        ss += __shfl_xor(ss, 16); ss += __shfl_xor(ss, 32);
        if (fq == 0) xch[wid * 128 + (ai * 4 + m) * 16 + fr] = ss;
        asm volatile("" ::: "memory");
      }
    asm volatile("s_waitcnt lgkmcnt(0)" ::: "memory");
    __builtin_amdgcn_s_barrier();
    asm volatile("" ::: "memory");
    const int hg = wc & 1;
#pragma unroll
    for (int ai = 0; ai < 2; ++ai)
#pragma unroll
      for (int m = 0; m < 4; ++m) {
        const int row = u.pm * 256 + ai * 128 + wr * 64 + m * 16 + fr;
        const float tot = xch[wid * 128 + (ai * 4 + m) * 16 + fr] + xch[(wid ^ 1) * 128 + (ai * 4 + m) * 16 + fr];
        const float rinv = rsqrtf(tot * (1.0f / 128.0f) + EPS);
        float v[2][8];
#pragma unroll
        for (int bj = 0; bj < 2; ++bj) { const f32x4 g0 = *(const f32x4*)(g + hg * 64 + bj * 32 + 8 * fq), g1 = *(const f32x4*)(g + hg * 64 + bj * 32 + 8 * fq + 4);
#pragma unroll
          for (int e = 0; e < 4; ++e) { v[bj][e] = acc[ai][bj][m][0][e] * rinv * g0[e]; v[bj][4 + e] = acc[ai][bj][m][1][e] * rinv * g1[e]; } }
        const int s_ = row & (SEQ - 1), pos = hg ? (s_ & 63) : (s_ >> 6);
        const f32x4* tp = (const f32x4*)(rope + pos * 32 + 8 * fq);
#pragma unroll
        for (int q = 0; q < 4; ++q) { const f32x4 cs = tp[q];
          { const float x1 = v[0][2 * q], x2 = v[1][2 * q]; v[0][2 * q] = x1 * cs[0] - x2 * cs[1]; v[1][2 * q] = x2 * cs[0] + x1 * cs[1]; }
          { const float x1 = v[0][2 * q + 1], x2 = v[1][2 * q + 1]; v[0][2 * q + 1] = x1 * cs[2] - x2 * cs[3]; v[1][2 * q + 1] = x2 * cs[2] + x1 * cs[3]; } }
#pragma unroll
        for (int bj = 0; bj < 2; ++bj) {
          const int col8 = colt + 64 * wc + 32 * bj + 8 * fq;
          u32x4 w; w[0] = cvtpk(v[bj][0], v[bj][1]); w[1] = cvtpk(v[bj][2], v[bj][3]); w[2] = cvtpk(v[bj][4], v[bj][5]); w[3] = cvtpk(v[bj][6], v[bj][7]);
          *(u32x4*)(proj + (size_t)row * CT + col8) = w;
        }
        asm volatile("" ::: "memory");
      }
  }
};
struct SchedG1 {
  int b;
  __device__ __forceinline__ bool next(int i, pg8::Unit& u) const {
    int id;
    if (b < 160) { if (i >= 5) return false; if (i == 4) { u.pm = b & 31; u.pn = 16 + (b >> 5); return true; } id = b + 160 * i; }
    else { if (i >= 5) return false; id = 640 + (b - 160) + 96 * i; }
    const int ct = id >> 5; u.pm = id & 31; u.pn = (ct < 16) ? ct : (21 + (ct - 16)); return true;
  }
  __device__ __forceinline__ void a_ready(const pg8::Unit&) const {}
  __device__ __forceinline__ void done(const pg8::Unit&) const {}
};

#define XB_TMO      128
#define XB_XCNT(j)  (256  + 64 * (j))
#define XB_XSUB(j)  (1280 + 64 * (j))
#define XB_XGEN(j)  (2304 + 64 * (j))
#define XB_TOP      3328
#define XB_TOPGEN   3392
#define XCD_BAR_WORDS 3456
#define XB_SPIN_CAP (1u << 18)

__device__ __forceinline__ unsigned xb_ld(unsigned* p)              { return __hip_atomic_load(p, __ATOMIC_RELAXED, __HIP_MEMORY_SCOPE_AGENT); }
__device__ __forceinline__ unsigned xb_add(unsigned* p, unsigned v) { return __hip_atomic_fetch_add(p, v, __ATOMIC_RELAXED, __HIP_MEMORY_SCOPE_AGENT); }
__device__ __forceinline__ unsigned xb_xcc_id() { return (unsigned)__builtin_amdgcn_s_getreg((3 << 11) | 20) & 0xFu; }
#define XB_SPIN(cond, bar) do { unsigned _sp = 0; while (cond) { __builtin_amdgcn_s_sleep(1); \
    if ((++_sp & 255u) == 0u) { if (xb_ld(&(bar)[XB_TMO])) break; if (_sp > XB_SPIN_CAP) { atomicAdd(&(bar)[XB_TMO], 1u); break; } } } } while (0)

struct XcdBarrier {
    unsigned* bar; unsigned x;
    volatile LAS unsigned* st;
};

__device__ __forceinline__ XcdBarrier xcd_barrier_post(unsigned* bar, volatile LAS unsigned* st) {
    XcdBarrier b; b.bar = bar; b.x = xb_xcc_id(); b.st = st;
    if (threadIdx.x == 0) (void)xb_add(&bar[XB_XCNT(b.x)], 1u);
    return b;
}
__device__ __forceinline__ void xcd_barrier_complete(unsigned* bar, unsigned x, unsigned& nloc, unsigned& nx) {
    const unsigned G = gridDim.x * gridDim.y * gridDim.z;
    unsigned sum, cnt, mine, sp = 0u;
    for (;;) {
        sum = 0u; cnt = 0u; mine = 0u;
#pragma unroll
        for (unsigned j = 0; j < 16; ++j) { const unsigned c = xb_ld(&bar[XB_XCNT(j)]); sum += c; cnt += (c > 0u) ? 1u : 0u; mine = (j == x) ? c : mine; }
        if (sum == G) break;
        __builtin_amdgcn_s_sleep(1);
        if ((++sp & 255u) == 0u) { if (xb_ld(&bar[XB_TMO])) break; if (sp > XB_SPIN_CAP) { atomicAdd(&bar[XB_TMO], 1u); break; } }
    }
    nloc = mine > 0u ? mine : 1u; nx = cnt > 0u ? cnt : 1u;
}

__device__ __forceinline__ void xcd_barrier(const XcdBarrier& b) {
    asm volatile("s_waitcnt vmcnt(0)" ::: "memory");
    __syncthreads();
    if (threadIdx.x == 0) {
        unsigned* bar = b.bar;
        __builtin_amdgcn_s_waitcnt(0);
        unsigned nloc = b.st[0], nx = b.st[1];
        if (nloc == 0u) { xcd_barrier_complete(bar, b.x, nloc, nx); b.st[0] = nloc; b.st[1] = nx; }
        const unsigned old = xb_add(&bar[XB_XSUB(b.x)], 1u);
        const unsigned gen = old / nloc;
        if (old + 1u == (gen + 1u) * nloc) {
            __builtin_amdgcn_fence(__ATOMIC_RELEASE, "agent");
            asm volatile("s_waitcnt vmcnt(0)" ::: "memory");
            const unsigned og = xb_add(&bar[XB_TOP], 1u);
            const unsigned tg = og / nx;
            if (og + 1u == (tg + 1u) * nx) xb_add(&bar[XB_TOPGEN], 1u);
            else XB_SPIN(xb_ld(&bar[XB_TOPGEN]) == tg, bar);
            __builtin_amdgcn_fence(__ATOMIC_ACQUIRE, "agent");
            xb_add(&bar[XB_XGEN(b.x)], 1u);
            asm volatile("s_waitcnt vmcnt(0)" ::: "memory");
        } else {
            XB_SPIN(xb_ld(&bar[XB_XGEN(b.x)]) == gen, bar);
            __builtin_amdgcn_fence(__ATOMIC_ACQUIRE, "agent");
            asm volatile("s_waitcnt vmcnt(0)" ::: "memory");
        }
    }
    __syncthreads();
}


__device__ __forceinline__ int launder(int x) { asm volatile("" : "+v"(x)); return x; }

__device__ __forceinline__ void rot4(float (&x1)[4], float (&x2)[4], const f32x4 ca, const f32x4 cb) {
  const float c[4] = {ca[0], ca[2], cb[0], cb[2]}, sn[4] = {ca[1], ca[3], cb[1], cb[3]};
#pragma unroll
  for (int e = 0; e < 4; ++e) { const float a = x1[e] * c[e] - x2[e] * sn[e], bb = x2[e] * c[e] + x1[e] * sn[e]; x1[e] = a; x2[e] = bb; }
}
__device__ __forceinline__ u32x4 pack8(const float (&a)[4], const float (&b)[4]) {
  const unsigned a0 = cvtpk(a[0], a[1]), a1 = cvtpk(a[2], a[3]), b0 = cvtpk(b[0], b[1]), b1 = cvtpk(b[2], b[3]);
  auto r0 = __builtin_amdgcn_permlane32_swap(a0, b0, false, false); auto r1 = __builtin_amdgcn_permlane32_swap(a1, b1, false, false);
  u32x4 w = {r0[0], r1[0], r0[1], r1[1]}; return w;
}
template <int TYPE>
__device__ __forceinline__ void epi1_group(const Params& p, const f32x16 (&acc)[2][4], int mi, int gq, int s, int hi, float rinv, const float* g, float (&v)[4][4]) {
  const int i0 = 8 * gq + 4 * hi;
#pragma unroll
  for (int ni = 0; ni < 4; ++ni)
#pragma unroll
    for (int e = 0; e < 4; ++e) v[ni][e] = acc[mi][ni][4 * gq + e];
  if (TYPE == 0) {
    const f32x4* tp = (const f32x4*)(p.rope + s * 32 + i0);
    const f32x4 ca = tp[0], cb = tp[1];
    rot4(v[0], v[1], ca, cb); rot4(v[2], v[3], ca, cb);
  } else if (TYPE == 1) {
#pragma unroll
    for (int ni = 0; ni < 4; ++ni) { const f32x4 gv = *(const f32x4*)(g + ni * 32 + i0);
#pragma unroll
      for (int e = 0; e < 4; ++e) v[ni][e] = v[ni][e] * rinv * gv[e]; }
    const f32x4* t0 = (const f32x4*)(p.rope + (s >> 6) * 32 + i0);
    const f32x4* t1 = (const f32x4*)(p.rope + (s & 63) * 32 + i0);
    const f32x4 a0 = t0[0], b0 = t0[1], a1 = t1[0], b1 = t1[1];
    rot4(v[0], v[1], a0, b0); rot4(v[2], v[3], a1, b1);
  } else if (TYPE == 2) {
#pragma unroll
    for (int ni = 0; ni < 4; ++ni)
#pragma unroll
      for (int e = 0; e < 4; ++e) v[ni][e] = v[ni][e] * sigmoidf_(v[ni][e]);
  } else if (TYPE == 3) {
#pragma unroll
    for (int ni = 0; ni < 4; ++ni)
#pragma unroll
      for (int e = 0; e < 4; ++e) v[ni][e] = sigmoidf_(v[ni][e]);
  }
}
template <int TYPE>
__device__ __forceinline__ void epi1(const Params& p, const f32x16 (&acc)[2][4], int rowb, int col0, int r32, int hi, const float* g) {
#pragma unroll
  for (int mi = 0; mi < 2; ++mi) {
    const int row = rowb + mi * 32 + r32;
    const int s = row & (SEQ - 1);
    float rinv = 1.f;
    if (TYPE == 1) {
      float ss = 0.f;
#pragma unroll
      for (int ni = 0; ni < 4; ++ni)
#pragma unroll
        for (int r = 0; r < 16; ++r) ss += acc[mi][ni][r] * acc[mi][ni][r];
      ss += __shfl_xor(ss, 32);
      rinv = rsqrtf(ss * (1.0f / 128.0f) + EPS);
    }
    bf16_t* dst = p.proj + (size_t)row * CT + col0 + 8 * hi;
#pragma unroll
    for (int j = 0; j < 2; ++j) {
      float va[4][4], vb[4][4];
      epi1_group<TYPE>(p, acc, mi, 2 * j, s, hi, rinv, g, va);
      epi1_group<TYPE>(p, acc, mi, 2 * j + 1, s, hi, rinv, g, vb);
      if (TYPE == 3) {
        const int gate = (col0 >= C_GB) ? 1 : 0, gc = col0 - (gate ? C_GB : C_GA);
        const int rb = (rowb >> 5) + mi, lane_ = hi * 32 + r32;
#pragma unroll
        for (int ni = 0; ni < 4; ++ni) *(u32x4*)(p.gbuf + gbuf_off(gate, rb, (gc >> 4) + ni * 2 + j, lane_)) = pack8(va[ni], vb[ni]);
      } else {
#pragma unroll
        for (int ni = 0; ni < 4; ++ni) *(u32x4*)(dst + ni * 32 + 16 * j) = pack8(va[ni], vb[ni]);
      }
    }
    asm volatile("" ::: "memory");
  }
}

__device__ __forceinline__ void phase_gemm1(const Params& p, char* lds) {
  const int tid = threadIdx.x, wid = tid >> 6, lane = tid & 63, wm = wid >> 1, wn = wid & 1;
  const int b = blockIdx.x;
  const bool has_tail = b < 128;
  {
    pg8::Gemm g{p.h, p.winT, MTOK, CT, DM};
    SchedG1 S{b}; EpiG1 E{p.proj, p.gbuf, p.rope, p.qn_g, p.kn_g, (float*)(lds + 131072 + 64)};
    pg8::gemm_phase<EpiG1, SchedG1, true, true>((LAS unsigned char*)lds, g, S, E);
  }
  const int nmine = 0;
#define MINE_ID(i_) (b)
#define MINE_PN(id_) (16 + ((id_) >> 5))
  if (nmine > 0) { const int id0 = MINE_ID(0); gemm_prefetch<4>(p.h + (size_t)(id0 & 31) * 256 * DM, DM, p.winT + (size_t)MINE_PN(id0) * 256 * DM, DM, lds); }
  for (int i = 0; i < nmine; ++i) {
    const int id = MINE_ID(i);
    const int pm = id & 31, pn = MINE_PN(id);
    f32x16 acc[2][4];
#pragma unroll
    for (int mi = 0; mi < 2; ++mi)
#pragma unroll
      for (int ni = 0; ni < 4; ++ni) acc[mi][ni] = f32x16{};
    gemm_mainloop<4, true>(p.h + (size_t)pm * 256 * DM, DM, p.winT + (size_t)pn * 256 * DM, DM, DM, acc, lds);
    if (i + 1 < nmine) { const int idn = MINE_ID(i + 1); gemm_prefetch<4>(p.h + (size_t)(idn & 31) * 256 * DM, DM, p.winT + (size_t)MINE_PN(idn) * 256 * DM, DM, lds); }
    else if (has_tail) gemm_prefetch<2>(p.h + (size_t)(b & 31) * 256 * DM, DM, p.winT + (size_t)(40 * 256 + (b >> 5) * 128) * DM, DM, lds);
    const int l2 = launder(lane), r32 = l2 & 31, hi = l2 >> 5;
    const int col0 = pn * 256 + wn * 128;
    const int rowb = pm * 256 + wm * 64;
    if (col0 < C_KB) epi1<1>(p, acc, rowb, col0, r32, hi, p.qn_g);
    else epi1<1>(p, acc, rowb, col0, r32, hi, p.kn_g);
  }
  if (nmine == 0 && has_tail) gemm_prefetch<2>(p.h + (size_t)(b & 31) * 256 * DM, DM, p.winT + (size_t)(40 * 256 + (b >> 5) * 128) * DM, DM, lds);
#undef MINE_ID
#undef MINE_PN
  if (!has_tail) transpose_late_weights(p, lds, (int)blockIdx.x - 128, (int)gridDim.x - 128);
  if (has_tail) {
    const int u = blockIdx.x;
    const int pm = u & 31, cbase = 40 * 256 + (u >> 5) * 128;
    f32x16 acc[2][2];
#pragma unroll
    for (int mi = 0; mi < 2; ++mi)
#pragma unroll
      for (int ni = 0; ni < 2; ++ni) acc[mi][ni] = f32x16{};
    gemm_mainloop<2, true>(p.h + (size_t)pm * 256 * DM, DM, p.winT + (size_t)cbase * DM, DM, DM, acc, lds);
    const int l2 = launder(lane), r32 = l2 & 31, hi = l2 >> 5;
    const int col0 = cbase + wn * 64;
    const int rowb = pm * 256 + wm * 64;
#pragma unroll
    for (int mi = 0; mi < 2; ++mi) {
      const int rb = (rowb >> 5) + mi, cb0 = (col0 - C_GB) >> 4;
#pragma unroll
      for (int ni = 0; ni < 2; ++ni) {
        float o[4][4];
#pragma unroll
        for (int gq = 0; gq < 4; ++gq)
#pragma unroll
          for (int e = 0; e < 4; ++e) o[gq][e] = sigmoidf_(acc[mi][ni][4 * gq + e]);
        *(u32x4*)(p.gbuf + gbuf_off(1, rb, cb0 + ni * 2, l2)) = pack8(o[0], o[1]);
        *(u32x4*)(p.gbuf + gbuf_off(1, rb, cb0 + ni * 2 + 1, l2)) = pack8(o[2], o[3]);
      }
    }
  }
}

struct EpiG2 {
  static constexpr bool PERM = true, AFTER_DRAIN = false, COLMAP = false;
  const bf16_t* gbuf; bf16_t* merged;
  __device__ __forceinline__ void operator()(const pg8::f32x4 (&acc)[2][2][4][2], const pg8::Unit& u, int wr, int wc, int fr, int fq) const {
    const int pass = u.pm >> 5, pm = u.pm & 31, pn = u.pn & 7;
#pragma unroll
    for (int ai = 0; ai < 2; ++ai)
#pragma unroll
      for (int m = 0; m < 4; ++m) {
        const int row = pm * 256 + ai * 128 + wr * 64 + m * 16 + fr;
#pragma unroll
        for (int bj = 0; bj < 2; ++bj) {
          const int col8 = pn * 256 + bj * 128 + wc * 32 + 8 * fq;
          const u32x4 gw = __builtin_nontemporal_load((const u32x4*)(gbuf + gbuf_off(pass, row >> 5, col8 >> 4, ((col8 >> 3) & 1) * 32 + (row & 31))));
          bf16_t* mp = merged + (size_t)row * DM + col8;
          float sg[8], o[8];
#pragma unroll
          for (int i = 0; i < 4; ++i) { sg[2 * i] = __uint_as_float(gw[i] << 16); sg[2 * i + 1] = __uint_as_float(gw[i] & 0xffff0000u); }
#pragma unroll
          for (int e = 0; e < 4; ++e) { o[e] = sg[e] * acc[ai][bj][m][0][e]; o[4 + e] = sg[4 + e] * acc[ai][bj][m][1][e]; }
          if (pass) {
            const u32x4 tw = *(const u32x4*)mp;
#pragma unroll
            for (int i = 0; i < 4; ++i) { o[2 * i] += __uint_as_float(tw[i] << 16); o[2 * i + 1] += __uint_as_float(tw[i] & 0xffff0000u); }
          }
          u32x4 w; w[0] = cvtpk(o[0], o[1]); w[1] = cvtpk(o[2], o[3]); w[2] = cvtpk(o[4], o[5]); w[3] = cvtpk(o[6], o[7]);
          *(u32x4*)mp = w;
        }
        asm volatile("" ::: "memory");
      }
  }
};
struct SchedG2 {
  int b;
  __device__ __forceinline__ bool next(int i, pg8::Unit& u) const { if (i >= 2) return false; u.pm = (b & 31) + 32 * i; u.pn = (b >> 5) + 8 * i; return true; }
  __device__ __forceinline__ void a_ready(const pg8::Unit&) const {}
  __device__ __forceinline__ void done(const pg8::Unit&) const {}
};
__device__ __forceinline__ void phase_gemm2(const Params& p, char* lds) {
  pg8::Gemm g{p.U, p.waT, 2 * MTOK, 2 * DM, BW};
  SchedG2 S{(int)blockIdx.x}; EpiG2 E{p.gbuf, p.merged};
  pg8::gemm_phase<EpiG2, SchedG2, true, true>((LAS unsigned char*)lds, g, S, E);
}

struct EpiG3 {
  static constexpr bool PERM = true, AFTER_DRAIN = true, COLMAP = false;
  const float* x; float* out; float* ssq; const float* fg; const XcdBarrier* xb;
  __device__ __forceinline__ void fused(pg8::f32x4 (&acc)[2][2][4][2], const pg8::Unit& u, int wr, int wc, int fr, int fq, LAS unsigned char*, int, int) const {
    const int colw = u.pn * 256 + wc * 32 + 8 * fq;
#pragma unroll
    for (int ai = 0; ai < 2; ++ai)
#pragma unroll
      for (int m = 0; m < 4; ++m) {
        const int row = u.pm * 256 + ai * 128 + wr * 64 + m * 16 + fr;
        float ss = 0.f;
#pragma unroll
        for (int bj = 0; bj < 2; ++bj) {
          const float* xp = x + (size_t)row * DM + colw + bj * 128;
          const f32x4 xa = __builtin_nontemporal_load((const f32x4*)xp), xc = __builtin_nontemporal_load((const f32x4*)(xp + 4));
#pragma unroll
          for (int e = 0; e < 4; ++e) { const float y0 = acc[ai][bj][m][0][e] + xa[e], y1 = acc[ai][bj][m][1][e] + xc[e]; acc[ai][bj][m][0][e] = y0; acc[ai][bj][m][1][e] = y1; ss += y0 * y0 + y1 * y1; }
        }
        ss += __shfl_xor(ss, 16); ss += __shfl_xor(ss, 32);
        if (fq == 0) ssq[row * 32 + u.pn * 4 + wc] = ss;
        asm volatile("" ::: "memory");
      }
    xcd_barrier(*xb);
#pragma unroll
    for (int ai = 0; ai < 2; ++ai)
#pragma unroll
      for (int m = 0; m < 4; ++m) {
        const int row = u.pm * 256 + ai * 128 + wr * 64 + m * 16 + fr;
        const f32x4* sp = (const f32x4*)(ssq + row * 32);
        float tot = 0.f;
#pragma unroll
        for (int q = 0; q < 8; ++q) { const f32x4 t = sp[q]; tot += (t[0] + t[1]) + (t[2] + t[3]); }
        const float rinv = rsqrtf(tot * (1.0f / DM) + EPS);
#pragma unroll
        for (int bj = 0; bj < 2; ++bj) {
          const int col = colw + bj * 128;
          const f32x4 g0 = *(const f32x4*)(fg + col), g1 = *(const f32x4*)(fg + col + 4);
          f32x4 o0, o1;
#pragma unroll
          for (int e = 0; e < 4; ++e) { o0[e] = acc[ai][bj][m][0][e] * rinv * g0[e]; o1[e] = acc[ai][bj][m][1][e] * rinv * g1[e]; }
          float* op = out + (size_t)row * DM + col;
          __builtin_nontemporal_store(o0, (f32x4*)op); __builtin_nontemporal_store(o1, (f32x4*)(op + 4));
        }
        asm volatile("" ::: "memory");
      }
  }
};
struct SchedOne {
  int b;
  __device__ __forceinline__ bool next(int i, pg8::Unit& u) const { if (i >= 1) return false; u.pm = b & 31; u.pn = b >> 5; return true; }
  __device__ __forceinline__ void a_ready(const pg8::Unit&) const {}
  __device__ __forceinline__ void done(const pg8::Unit&) const {}
};
__device__ __forceinline__ void phase_gemm3_final(const Params& p, char* lds, const XcdBarrier& xb) {
  pg8::Gemm g{p.merged, p.woT, MTOK, DM, DM};
  SchedOne S{(int)blockIdx.x}; EpiG3 E{p.x, p.out, p.ssq, p.final_g, &xb};
  pg8::gemm_phase<EpiG3, SchedOne, false, true>((LAS unsigned char*)lds, g, S, E);
}

constexpr int KVBLK = 64;
constexpr size_t SHM_V = KVBLK * 128 * 2, SHM_K = KVBLK * 128 * 2;
constexpr int ATT_TILE = 32768, ATT_WS = 131072 + 64;
constexpr float THR = 8.f;
#define KSWZ(row, colB) ((row) * 256 + ((colB) ^ (((row) & 7) << 4)))

template <int DQK> struct AttnC { static constexpr float SCALE = (DQK == 64) ? 0.125f : 0.088388347648318440f; };

template <int DQK>
__device__ __forceinline__ void partialSM(f32x16& p0, f32x16& p1, float& m_reg, float& mn, float& alpha) {
  constexpr float SCALE = AttnC<DQK>::SCALE;
  constexpr float C = SCALE * 1.4426950408889634f;
  float pmax = p0[0];
#pragma unroll
  for (int r = 1; r < 16; ++r) pmax = fmaxf(pmax, p0[r]);
#pragma unroll
  for (int r = 0; r < 16; ++r) pmax = fmaxf(pmax, p1[r]);
  { auto rr = __builtin_amdgcn_permlane32_swap(__float_as_uint(pmax), __float_as_uint(pmax), false, false);
    pmax = fmaxf(__uint_as_float(rr[0]), __uint_as_float(rr[1])); }
  if (__builtin_expect(__all(pmax - m_reg <= THR / SCALE), 1)) { mn = m_reg; alpha = 1.f; }
  else { mn = fmaxf(m_reg, pmax); alpha = __builtin_amdgcn_exp2f((m_reg - mn) * C); m_reg = mn; }
  const float mnC = -mn * C;
#pragma unroll
  for (int r = 0; r < 16; ++r) p0[r] = fmaf(p0[r], C, mnC);
#pragma unroll
  for (int r = 0; r < 16; ++r) p1[r] = fmaf(p1[r], C, mnC);
#pragma unroll
  for (int r = 0; r < 16; ++r) p0[r] = __builtin_amdgcn_exp2f(p0[r]);
}
__device__ __forceinline__ void finishSM(f32x16& p0, f32x16& p1, float alpha, float& l_reg, bf16x8& pa0, bf16x8& pa1, bf16x8& pa2, bf16x8& pa3) {
#pragma unroll
  for (int r = 0; r < 16; ++r) p1[r] = __builtin_amdgcn_exp2f(p1[r]);
  float ps = 0;
#pragma unroll
  for (int r = 0; r < 16; ++r) ps += p0[r];
#pragma unroll
  for (int r = 0; r < 16; ++r) ps += p1[r];
  { auto rr = __builtin_amdgcn_permlane32_swap(__float_as_uint(ps), __float_as_uint(ps), false, false);
    ps = __uint_as_float(rr[0]) + __uint_as_float(rr[1]); }
  l_reg = l_reg * alpha + ps;
#define PK4(P, BASE, OUT) do { unsigned a0 = cvtpk(P[BASE + 0], P[BASE + 1]), a1 = cvtpk(P[BASE + 2], P[BASE + 3]);   \
    unsigned b0 = cvtpk(P[BASE + 4], P[BASE + 5]), b1 = cvtpk(P[BASE + 6], P[BASE + 7]);                              \
    auto r0 = __builtin_amdgcn_permlane32_swap(a0, b0, false, false); auto r1 = __builtin_amdgcn_permlane32_swap(a1, b1, false, false); \
    u32x4 w = {r0[0], r1[0], r0[1], r1[1]}; OUT = *reinterpret_cast<bf16x8*>(&w); } while (0)
  PK4(p0, 0, pa0); PK4(p0, 8, pa1); PK4(p1, 0, pa2); PK4(p1, 8, pa3);
#undef PK4
}
template <int DQK>
__device__ __forceinline__ void qkt(f32x16& p0, f32x16& p1, const LAS char* Ks, const bf16x8* qr, int r32, int hi) {
  constexpr int PITCH = DQK * 2;
  const int sw = (DQK == 128) ? (r32 & 7) : ((r32 >> 1) & 7);
  p0 = f32x16{}; p1 = f32x16{};
#pragma unroll
  for (int d0 = 0; d0 < DQK / 16; ++d0) { const int co = ((d0 * 2 + hi) ^ sw) << 4;
    bf16x8 b0 = *reinterpret_cast<const LAS bf16x8*>(Ks + r32 * PITCH + co);
    bf16x8 b1 = *reinterpret_cast<const LAS bf16x8*>(Ks + (32 + r32) * PITCH + co);
    p0 = __builtin_amdgcn_mfma_f32_32x32x16_bf16(b0, qr[d0], p0, 0, 0, 0);
    p1 = __builtin_amdgcn_mfma_f32_32x32x16_bf16(b1, qr[d0], p1, 0, 0, 0); }
}
__device__ __forceinline__ int v_st(int k, int c) { const int kk = (k & ~0xC) | ((k & 4) << 1) | ((k & 8) >> 1); return ((kk >> 3) * 4 + (c >> 5)) * 512 + ((kk & 7) * 32 + (c & 31)) * 2; }
__device__ __forceinline__ int v_rd_base(int lane) { return ((lane & 3) << 3) | (((lane >> 2) & 3) << 6) | (((lane >> 4) & 1) << 5) | (((lane >> 5) & 1) << 8); }
constexpr int v_rd_off(int d0, int ks, int half) { return d0 * 512 + ks * 4096 + half * 2048; }
template <int OFF> __device__ __forceinline__ s16x4 tr_read(int vb) {
  s16x4 r; asm volatile("ds_read_b64_tr_b16 %0, %1 offset:%2" : "=&v"(r) : "v"(vb), "i"(OFF) : "memory"); return r;
}
template <int D0> __device__ __forceinline__ void pv_one(f32x16& od, int vb, bf16x8 pa0, bf16x8 pa1, bf16x8 pa2, bf16x8 pa3) {
  const s16x4 l0 = tr_read<v_rd_off(D0, 0, 0)>(vb), h0 = tr_read<v_rd_off(D0, 0, 1)>(vb), l1 = tr_read<v_rd_off(D0, 1, 0)>(vb), h1 = tr_read<v_rd_off(D0, 1, 1)>(vb);
  const s16x4 l2 = tr_read<v_rd_off(D0, 2, 0)>(vb), h2 = tr_read<v_rd_off(D0, 2, 1)>(vb), l3 = tr_read<v_rd_off(D0, 3, 0)>(vb), h3 = tr_read<v_rd_off(D0, 3, 1)>(vb);
  asm volatile("s_waitcnt lgkmcnt(0)" ::: "memory"); SBAR();
#define PK(L, H) (bf16x8){L[0], L[1], L[2], L[3], H[0], H[1], H[2], H[3]}
  od = __builtin_amdgcn_mfma_f32_32x32x16_bf16(pa0, PK(l0, h0), od, 0, 0, 0);
  od = __builtin_amdgcn_mfma_f32_32x32x16_bf16(pa1, PK(l1, h1), od, 0, 0, 0);
  od = __builtin_amdgcn_mfma_f32_32x32x16_bf16(pa2, PK(l2, h2), od, 0, 0, 0);
  od = __builtin_amdgcn_mfma_f32_32x32x16_bf16(pa3, PK(l3, h3), od, 0, 0, 0);
#undef PK
}
template <int DQK, class ISS>
__device__ __forceinline__ void pv_sm(f32x16 (&o)[4], int vb, bf16x8 pa0, bf16x8 pa1, bf16x8 pa2, bf16x8 pa3,
                                      f32x16& p0, f32x16& p1, float& m_reg, float& mn, float& alpha, const ISS& iss) {
  constexpr float SCALE = AttnC<DQK>::SCALE;
  constexpr float C = SCALE * 1.4426950408889634f;
#define PK(L, H) (bf16x8){L[0], L[1], L[2], L[3], H[0], H[1], H[2], H[3]}
#define PV_READS(D0) const s16x4 l0 = tr_read<v_rd_off(D0, 0, 0)>(vb), h0 = tr_read<v_rd_off(D0, 0, 1)>(vb), l1 = tr_read<v_rd_off(D0, 1, 0)>(vb), h1 = tr_read<v_rd_off(D0, 1, 1)>(vb); \
    const s16x4 l2 = tr_read<v_rd_off(D0, 2, 0)>(vb), h2 = tr_read<v_rd_off(D0, 2, 1)>(vb), l3 = tr_read<v_rd_off(D0, 3, 0)>(vb), h3 = tr_read<v_rd_off(D0, 3, 1)>(vb); \
    asm volatile("s_waitcnt lgkmcnt(0)" ::: "memory"); SBAR();
#define PV_MMA(D0) o[D0] = __builtin_amdgcn_mfma_f32_32x32x16_bf16(pa0, PK(l0, h0), o[D0], 0, 0, 0); o[D0] = __builtin_amdgcn_mfma_f32_32x32x16_bf16(pa1, PK(l1, h1), o[D0], 0, 0, 0); \
    o[D0] = __builtin_amdgcn_mfma_f32_32x32x16_bf16(pa2, PK(l2, h2), o[D0], 0, 0, 0); o[D0] = __builtin_amdgcn_mfma_f32_32x32x16_bf16(pa3, PK(l3, h3), o[D0], 0, 0, 0);
  float pmax, mnC;
  { PV_READS(0)
    iss(0);
    pmax = p0[0];
#pragma unroll
    for (int r = 1; r < 16; ++r) pmax = fmaxf(pmax, p0[r]);
    PV_MMA(0) }
  { PV_READS(1)
    iss(1);
#pragma unroll
    for (int r = 0; r < 16; ++r) pmax = fmaxf(pmax, p1[r]);
    { auto rr = __builtin_amdgcn_permlane32_swap(__float_as_uint(pmax), __float_as_uint(pmax), false, false);
      pmax = fmaxf(__uint_as_float(rr[0]), __uint_as_float(rr[1])); }
    const bool keep = __all(pmax - m_reg <= THR / SCALE);
    mn = keep ? m_reg : fmaxf(m_reg, pmax);
    alpha = __builtin_amdgcn_exp2f((m_reg - mn) * C);
    m_reg = mn; mnC = -mn * C;
    PV_MMA(1) }
  { PV_READS(2)
    iss(2);
#pragma unroll
    for (int r = 0; r < 16; ++r) p0[r] = fmaf(p0[r], C, mnC);
#pragma unroll
    for (int r = 0; r < 16; ++r) p1[r] = fmaf(p1[r], C, mnC);
    PV_MMA(2) }
  { PV_READS(3)
    iss(3);
#pragma unroll
    for (int r = 0; r < 16; ++r) p0[r] = __builtin_amdgcn_exp2f(p0[r]);
    PV_MMA(3) }
#undef PK
#undef PV_READS
#undef PV_MMA
}
__device__ __forceinline__ void pv_d0(f32x16 (&o)[4], int vb, bf16x8 pa0, bf16x8 pa1, bf16x8 pa2, bf16x8 pa3) {
  pv_one<0>(o[0], vb, pa0, pa1, pa2, pa3); pv_one<1>(o[1], vb, pa0, pa1, pa2, pa3); pv_one<2>(o[2], vb, pa0, pa1, pa2, pa3); pv_one<3>(o[3], vb, pa0, pa1, pa2, pa3);
}

template <int DQK>
__device__ __forceinline__ void attn_body(const bf16_t* __restrict__ Qb, const bf16_t* __restrict__ Kh, const bf16_t* __restrict__ Vh,
                                          char* lds, f32x16 (&o)[4], float& l_out) {
  constexpr int LD = CT;
  constexpr int NQ = DQK / 16, PK = DQK / 64, P = 2 + PK;
  const int tid = threadIdx.x, wid = __builtin_amdgcn_readfirstlane(tid >> 6), lane = tid & 63, r32 = lane & 31, hi = lane >> 5;
  LAS char* ldsl = (LAS char*)lds;
  float* ws = (float*)(lds + ATT_WS) + wid * 64; float* al_l = ws + 32;
  float m_reg = -1e30f, l_reg = 0;
#pragma unroll
  for (int d = 0; d < 4; ++d) o[d] = f32x16{};
  bf16x8 qr[NQ];
  const bf16_t* Qw = Qb + (size_t)(wid * 32 + r32) * LD + hi * 8;
#pragma unroll
  for (int d0 = 0; d0 < NQ; ++d0) qr[d0] = __builtin_nontemporal_load((const bf16x8*)(Qw + d0 * 16));
  unsigned vgo[2], kgo[2];
#pragma unroll
  for (int i = 0; i < 2; ++i) {
    const int kk = (i * 4 + (tid >> 7)) * 8 + ((tid & 31) >> 2), c = ((tid >> 5) & 3) * 32 + (tid & 3) * 8;
    const int k = (kk & ~0xC) | ((kk & 4) << 1) | ((kk & 8) >> 1);
    vgo[i] = (unsigned)(k * LD + c) * 2u;
    if (DQK == 128) { const int row = i * 32 + (tid >> 4), lc = (tid & 15) ^ (row & 7); kgo[i] = (unsigned)(row * LD + lc * 8) * 2u; }
    else { const int row = tid >> 3, lc = (tid & 7) ^ ((row >> 1) & 7); kgo[i] = (unsigned)(row * LD + lc * 8) * 2u; }
  }
  const char* Vb = (const char*)Vh; const char* Kb = (const char*)Kh;
#define A_ISSUE(t_) do { const size_t ko_ = (size_t)(t_) * (KVBLK * LD * 2); LAS char* bb_ = ldsl + ((t_) & 3) * ATT_TILE + wid * 1024; \
    __builtin_amdgcn_global_load_lds((const unsigned*)(Vb + ko_ + vgo[0]), (LAS unsigned*)(bb_), 16, 0, 0); \
    __builtin_amdgcn_global_load_lds((const unsigned*)(Vb + ko_ + vgo[1]), (LAS unsigned*)(bb_ + 8192), 16, 0, 0); \
    __builtin_amdgcn_global_load_lds((const unsigned*)(Kb + ko_ + kgo[0]), (LAS unsigned*)(bb_ + 16384), 16, 0, 0); \
    if constexpr (DQK == 128) __builtin_amdgcn_global_load_lds((const unsigned*)(Kb + ko_ + kgo[1]), (LAS unsigned*)(bb_ + 16384 + 8192), 16, 0, 0); } while (0)
  auto a_piece = [&](int t_, int j_) {
    const size_t ko_ = (size_t)t_ * (KVBLK * LD * 2); LAS char* bb_ = ldsl + (t_ & 3) * ATT_TILE + wid * 1024;
    if (j_ == 0) __builtin_amdgcn_global_load_lds((const unsigned*)(Vb + ko_ + vgo[0]), (LAS unsigned*)(bb_), 16, 0, 0);
    else if (j_ == 1) __builtin_amdgcn_global_load_lds((const unsigned*)(Vb + ko_ + vgo[1]), (LAS unsigned*)(bb_ + 8192), 16, 0, 0);
    else if (j_ == 2) __builtin_amdgcn_global_load_lds((const unsigned*)(Kb + ko_ + kgo[0]), (LAS unsigned*)(bb_ + 16384), 16, 0, 0);
    else if (DQK == 128) __builtin_amdgcn_global_load_lds((const unsigned*)(Kb + ko_ + kgo[1]), (LAS unsigned*)(bb_ + 16384 + 8192), 16, 0, 0);
  };
#define A_WAITBAR(N) do { asm volatile("s_waitcnt vmcnt(%0)" :: "n"(N) : "memory"); __builtin_amdgcn_s_barrier(); asm volatile("" ::: "memory"); } while (0)
#define KBUF(t_) ((const LAS char*)(ldsl + ((t_) & 3) * ATT_TILE + 16384))
#define VBUF(t_) ((int)(uintptr_t)(ldsl + ((t_) & 3) * ATT_TILE) + vrb)
#define RESC(a) do { if (__any((a) < 1.f)) { if (hi == 0) al_l[r32] = (a); asm volatile("s_waitcnt lgkmcnt(0)" ::: "memory"); \
    _Pragma("unroll") for (int d = 0; d < 4; ++d) _Pragma("unroll") for (int r = 0; r < 16; ++r) o[d][r] *= al_l[crow(r, hi)]; } } while (0)
  const int vrb = v_rd_base(lane);
  f32x16 pA0, pA1, pB0, pB1; float mnA, mnB, alA, alB; bf16x8 pa0, pa1, pa2, pa3; constexpr int NT = SEQ / KVBLK;
  A_ISSUE(0); A_ISSUE(1);
  A_WAITBAR(P);
  qkt<DQK>(pA0, pA1, KBUF(0), qr, r32, hi); partialSM<DQK>(pA0, pA1, m_reg, mnA, alA);
  A_ISSUE(2);
  A_WAITBAR(P);
  for (int n = 1; n + 1 < NT; n += 2) {
    SBAR(); qkt<DQK>(pB0, pB1, KBUF(n), qr, r32, hi);
    finishSM(pA0, pA1, alA, l_reg, pa0, pa1, pa2, pa3); SBAR();
    pv_sm<DQK>(o, VBUF(n - 1), pa0, pa1, pa2, pa3, pB0, pB1, m_reg, mnB, alB, [&](int j_) { a_piece(n + 2, j_); });
    A_WAITBAR(P);
    RESC(alB);
    SBAR(); qkt<DQK>(pA0, pA1, KBUF(n + 1), qr, r32, hi);
    finishSM(pB0, pB1, alB, l_reg, pa0, pa1, pa2, pa3); SBAR();
    { const bool more_ = (n + 3 < NT); pv_sm<DQK>(o, VBUF(n), pa0, pa1, pa2, pa3, pA0, pA1, m_reg, mnA, alA, [&](int j_) { if (more_) a_piece(n + 3, j_); }); }
    if (n + 3 < NT) A_WAITBAR(P); else A_WAITBAR(0);
    RESC(alA);
  }
  SBAR(); qkt<DQK>(pB0, pB1, KBUF(NT - 1), qr, r32, hi);
  finishSM(pA0, pA1, alA, l_reg, pa0, pa1, pa2, pa3); SBAR();
  pv_sm<DQK>(o, VBUF(NT - 2), pa0, pa1, pa2, pa3, pB0, pB1, m_reg, mnB, alB, [](int) {});
  RESC(alB);
  finishSM(pB0, pB1, alB, l_reg, pa0, pa1, pa2, pa3); SBAR();
  pv_d0(o, VBUF(NT - 1), pa0, pa1, pa2, pa3);
  l_out = l_reg;
#undef A_ISSUE
#undef A_WAITBAR
#undef KBUF
#undef VBUF
#undef RESC
}

__device__ __forceinline__ void attn_rli(float l_reg, char* lds, float (&rli)[16]) {
  const int tid = threadIdx.x, wid = tid >> 6, lane = tid & 63, r32 = lane & 31, hi = lane >> 5;
  float* li_l = (float*)(lds + ATT_WS) + wid * 64;
  if (hi == 0) li_l[r32] = l_reg;
  asm volatile("s_waitcnt lgkmcnt(0)" ::: "memory");
#pragma unroll
  for (int r = 0; r < 16; ++r) rli[r] = __builtin_amdgcn_rcpf(li_l[crow(r, hi)]);
  asm volatile("s_waitcnt lgkmcnt(0)" ::: "memory");
}

constexpr int EPI_RS = 68, EPI_WAVE_BYTES = 32 * EPI_RS * 4;
__device__ __forceinline__ void epi_put_half(const f32x16 (&o)[4], const float (&rli)[16], float* sc, int half, int r32, int hi) {
#pragma unroll
  for (int d0h = 0; d0h < 2; ++d0h)
#pragma unroll
    for (int r = 0; r < 16; ++r) sc[crow(r, hi) * EPI_RS + d0h * 32 + r32] = o[half * 2 + d0h][r] * rli[r];
}
__device__ __forceinline__ void epi_get(const float* sc, int q, int lane, float (&v)[8]) {
  const f32x4* sp = (const f32x4*)(sc + (q * 8 + (lane >> 3)) * EPI_RS + (lane & 7) * 8);
  const f32x4 a = sp[0], bq = sp[1];
  v[0] = a[0]; v[1] = a[1]; v[2] = a[2]; v[3] = a[3]; v[4] = bq[0]; v[5] = bq[1]; v[6] = bq[2]; v[7] = bq[3];
}
__device__ __forceinline__ void unpack8(const u32x4 w, float (&z)[8]) {
#pragma unroll
  for (int i = 0; i < 4; ++i) { z[2 * i] = __uint_as_float(w[i] << 16); z[2 * i + 1] = __uint_as_float(w[i] & 0xffff0000u); }
}

__device__ __forceinline__ void phase_attn(const Params& p, char* lds) {
  const int tid = threadIdx.x, wid = tid >> 6, lane = tid & 63;
  float* sc = (float*)(lds + wid * EPI_WAVE_BYTES);
  for (int it = blockIdx.x; it < 512; it += gridDim.x) {
    const int j = it & 255, xcd = j & 7, slot = j >> 3;
    const int bh = xcd * 2 + (slot >> 4), qblk = slot & 15;
    const int b = bh >> 3, h = bh & 7;
    const size_t tok0 = (size_t)b * SEQ;
    const size_t rowq = tok0 + qblk * 256;
    const int rowbase = (int)rowq + wid * 32;
    f32x16 o[4]; float l_reg; float rli[16];
    if (it < 256) {
      const int kvh = h >> 2;
      attn_body<128>(p.proj + rowq * CT + C_QB + h * 128, p.proj + tok0 * CT + C_KB + kvh * 128, p.proj + tok0 * CT + C_VB + kvh * 128, lds, o, l_reg);
      attn_rli(l_reg, lds, rli);
      __syncthreads();
      const int l2 = launder(lane), r32 = l2 & 31, hi = l2 >> 5;
#pragma unroll
      for (int half = 0; half < 2; ++half) {
        epi_put_half(o, rli, sc, half, r32, hi);
#pragma unroll
        for (int q = 0; q < 4; ++q) {
          float v[8], z[8]; epi_get(sc, q, l2, v);
          const size_t row = (size_t)(rowbase + q * 8 + (l2 >> 3)); const int col = h * 128 + half * 64 + (l2 & 7) * 8;
          unpack8(__builtin_nontemporal_load((const u32x4*)(p.proj + row * CT + C_ZB + col)), z);
          u32x4 w; w[0] = cvtpk(v[0] * z[0], v[1] * z[1]); w[1] = cvtpk(v[2] * z[2], v[3] * z[3]); w[2] = cvtpk(v[4] * z[4], v[5] * z[5]); w[3] = cvtpk(v[6] * z[6], v[7] * z[7]);
          *(u32x4*)(p.U + (size_t)MTOK * BW + row * BW + (col - h * 128) + h * 128) = w;
        }
      }
    } else {
      const bf16_t* Vp = p.proj + tok0 * CT + C_VA + h * 128;
      attn_body<64>(p.proj + rowq * CT + C_QA + h * 128, p.proj + tok0 * CT + C_KA + h * 128, Vp, lds, o, l_reg);
      attn_rli(l_reg, lds, rli);
      __syncthreads();
      {
        const int l2 = launder(lane), r32 = l2 & 31, hi = l2 >> 5;
#pragma unroll
        for (int half = 0; half < 2; ++half) {
          epi_put_half(o, rli, sc, half, r32, hi);
#pragma unroll
          for (int q = 0; q < 4; ++q) {
            float v[8]; epi_get(sc, q, l2, v);
            float* op = p.o1 + (size_t)(rowbase + q * 8 + (l2 >> 3)) * BW + h * 128 + half * 64 + (l2 & 7) * 8;
            f32x4 a = {v[0], v[1], v[2], v[3]}, c = {v[4], v[5], v[6], v[7]};
            *(f32x4*)op = a; *(f32x4*)(op + 4) = c;
          }
        }
      }
      __syncthreads();
      attn_body<64>(p.proj + rowq * CT + C_QA + h * 128 + 64, p.proj + tok0 * CT + C_KA + h * 128 + 64, Vp, lds, o, l_reg);
      attn_rli(l_reg, lds, rli);
      __syncthreads();
      const int l2 = launder(lane), r32 = l2 & 31, hi = l2 >> 5;
      float d1 = 0.f, d2 = 0.f;
      for (int i = 0; i < 64; ++i) { d1 += p.lq1[i] * p.lk1[i]; d2 += p.lq2[i] * p.lk2[i]; }
      const float lam = __expf(d1) - __expf(d2) + 0.2f;
      float t[2][4][8]; float ss[4] = {0.f, 0.f, 0.f, 0.f};
#pragma unroll
      for (int half = 0; half < 2; ++half) {
        epi_put_half(o, rli, sc, half, r32, hi);
#pragma unroll
        for (int q = 0; q < 4; ++q) {
          float v[8]; epi_get(sc, q, l2, v);
          const float* op = p.o1 + (size_t)(rowbase + q * 8 + (l2 >> 3)) * BW + h * 128 + half * 64 + (l2 & 7) * 8;
          const f32x4 a = *(const f32x4*)op, c = *(const f32x4*)(op + 4);
          const float o1v[8] = {a[0], a[1], a[2], a[3], c[0], c[1], c[2], c[3]};
#pragma unroll
          for (int e = 0; e < 8; ++e) { const float tv = o1v[e] - lam * v[e]; t[half][q][e] = tv; ss[q] += tv * tv; }
        }
      }
      float rinv[4];
#pragma unroll
      for (int q = 0; q < 4; ++q) { float x = ss[q]; x += __shfl_xor(x, 1); x += __shfl_xor(x, 2); x += __shfl_xor(x, 4); rinv[q] = rsqrtf(x * (1.0f / 128.0f) + EPS) * 0.8f; }
#pragma unroll
      for (int half = 0; half < 2; ++half) {
        const int colh = half * 64 + (l2 & 7) * 8;
        const f32x4 g0 = *(const f32x4*)(p.subln_g + colh), g1 = *(const f32x4*)(p.subln_g + colh + 4);
        const float sg[8] = {g0[0], g0[1], g0[2], g0[3], g1[0], g1[1], g1[2], g1[3]};
#pragma unroll
        for (int q = 0; q < 4; ++q) {
          const size_t row = (size_t)(rowbase + q * 8 + (l2 >> 3)); const int col = h * 128 + colh;
          float z[8]; unpack8(__builtin_nontemporal_load((const u32x4*)(p.proj + row * CT + C_ZA + col)), z);
          float ov[8];
#pragma unroll
          for (int e = 0; e < 8; ++e) ov[e] = t[half][q][e] * rinv[q] * sg[e] * z[e];
          u32x4 w; w[0] = cvtpk(ov[0], ov[1]); w[1] = cvtpk(ov[2], ov[3]); w[2] = cvtpk(ov[4], ov[5]); w[3] = cvtpk(ov[6], ov[7]);
          *(u32x4*)(p.U + row * BW + col) = w;
        }
      }
    }
    __syncthreads();
  }
}

__global__ void __launch_bounds__(512) mega(Params p) {
  extern __shared__ __attribute__((aligned(16))) char lds[];
  cg::grid_group grid = cg::this_grid();
  if (p.phase_lo < 0) grid.sync();
  volatile LAS unsigned* xst = (volatile LAS unsigned*)((LAS char*)lds + 131072);
  if (threadIdx.x < 4) xst[threadIdx.x] = 0u;
  __syncthreads();
  XcdBarrier xb = xcd_barrier_post(p.bar, xst);
  const int hi = p.phase_hi;
  if (hi >= 0) phase_prologue(p, lds);
  xcd_barrier(xb);
  if (hi >= 1) phase_gemm1(p, lds);
  xcd_barrier(xb);
  if (hi >= 2) phase_attn(p, lds);
  xcd_barrier(xb);
  if (hi >= 3) phase_gemm2(p, lds);
  xcd_barrier(xb);
  if (hi >= 4) phase_gemm3_final(p, lds, xb);
}

extern "C" void kernel_launch(void* const* d_in, const int* in_sizes, int n_in, void* d_out, int out_size, void* d_ws, size_t ws_size, hipStream_t stream) {
  static int grid_blocks = 0;
  if (!grid_blocks) {
    hipFuncSetAttribute((const void*)mega, hipFuncAttributeMaxDynamicSharedMemorySize, LDS_BYTES);
    int dev = 0, cus = 0, per_cu = 0;
    hipGetDevice(&dev);
    hipDeviceGetAttribute(&cus, hipDeviceAttributeMultiprocessorCount, dev);
    hipOccupancyMaxActiveBlocksPerMultiprocessor(&per_cu, mega, 512, LDS_BYTES);
    if (per_cu < 1) { fprintf(stderr, "occupancy query returned %d\n", per_cu); per_cu = 1; }
    grid_blocks = cus * per_cu;
    if (grid_blocks > 256) grid_blocks = 256;
    if (grid_blocks != 256) fprintf(stderr, "unexpected grid %d (need 256)\n", grid_blocks);
  }
  Params p{};
  p.x = (const float*)d_in[0]; p.norm_g = (const float*)d_in[1]; p.w_in = (const float*)d_in[2];
  p.lq1 = (const float*)d_in[3]; p.lk1 = (const float*)d_in[4]; p.lq2 = (const float*)d_in[5]; p.lk2 = (const float*)d_in[6];
  p.subln_g = (const float*)d_in[7]; p.qn_g = (const float*)d_in[8]; p.kn_g = (const float*)d_in[9];
  p.w_out_a = (const float*)d_in[10]; p.w_out_b = (const float*)d_in[11]; p.w_o = (const float*)d_in[12]; p.final_g = (const float*)d_in[13];
  p.out = (float*)d_out;
  char* w = (char*)d_ws; size_t off = 0;
  auto take = [&](size_t bytes) { char* r = w + off; off += (bytes + 255) & ~(size_t)255; return r; };
  p.h      = (bf16_t*)take((size_t)MTOK * DM * 2);
  p.o1     = (float*)p.h;
  p.merged = (bf16_t*)p.h;
  p.winT   = (bf16_t*)take((size_t)CT * DM * 2);
  p.waT    = (bf16_t*)take((size_t)DM * BW * 2);
  p.wbT    = (bf16_t*)take((size_t)DM * BW * 2);
  p.woT    = (bf16_t*)take((size_t)DM * DM * 2);
  p.proj   = (bf16_t*)take((size_t)MTOK * CT * 2);
  p.U      = (bf16_t*)d_out;
  p.gbuf   = (bf16_t*)take((size_t)2 * MTOK * DM * 2);
  p.rope   = (float2*)take((size_t)SEQ * 32 * 8);
  p.ssq    = (float*)take((size_t)MTOK * 32 * 4);
  p.bar    = (unsigned*)take(XCD_BAR_WORDS * 4);
  if (off > ws_size) { fprintf(stderr, "workspace too small: need %zu have %zu\n", off, ws_size); return; }
  if (grid_blocks != 256) return;
  p.phase_lo = 0; p.phase_hi = 5;
  hipMemsetAsync(p.bar, 0, XCD_BAR_WORDS * 4, stream);
  void* args[] = {&p};
  hipError_t e = hipLaunchCooperativeKernel((void*)mega, dim3(grid_blocks), dim3(512), args, LDS_BYTES, stream);
  if (e != hipSuccess) fprintf(stderr, "cooperative launch failed: %s (grid %d)\n", hipGetErrorString(e), grid_blocks);
}
```

```cpp
#include <hip/hip_runtime.h>
#include <hip/hip_cooperative_groups.h>
#include <cstdio>
#include <cstdint>
namespace cg = cooperative_groups;

#ifndef MK_LAUNCHES
#define MK_LAUNCHES 1
#endif

typedef unsigned short bf16_t;
using bf16x8 = __attribute__((ext_vector_type(8))) short;
using s16x4  = __attribute__((ext_vector_type(4))) short;
using f32x16 = __attribute__((ext_vector_type(16))) float;
using f32x4  = __attribute__((ext_vector_type(4))) float;
using u32x4  = __attribute__((ext_vector_type(4))) unsigned;
using u32x2  = __attribute__((ext_vector_type(2))) unsigned;

constexpr int MTOK = 8192, SEQ = 4096, DM = 2048, CT = 10752, BW = 1024;
constexpr int C_QA = 0, C_KA = 1024, C_VA = 2048, C_ZA = 3072, C_QB = 4096, C_KB = 5120, C_VB = 5376, C_ZB = 5632, C_GA = 6656, C_GB = 8704;
constexpr float EPS = 1e-6f;
constexpr int LDS_BYTES = 131072 + 64 + 4096;

struct Params {
  const float *x, *norm_g, *w_in, *lq1, *lk1, *lq2, *lk2, *subln_g, *qn_g, *kn_g, *w_out_a, *w_out_b, *w_o, *final_g;
  float* out;
  bf16_t *h, *winT, *waT, *wbT, *woT, *proj, *U, *merged;
  float* o1;
  float2* rope;
  float* ssq;
  unsigned* bar;
  bf16_t* gbuf;
  void* pad0;
  int phase_lo, phase_hi;
};

#define SBAR() __builtin_amdgcn_sched_barrier(0)
#define LAS __attribute__((address_space(3)))
__device__ __forceinline__ int crow(int r, int hi) { return (r & 3) + 8 * (r >> 2) + 4 * hi; }
__device__ __forceinline__ unsigned cvtpk(float lo, float hi) {
  unsigned r; asm volatile("s_nop 0\n\tv_cvt_pk_bf16_f32 %0, %1, %2" : "=v"(r) : "v"(lo), "v"(hi)); return r;
}
__device__ __forceinline__ float bf2f(bf16_t v) { return __uint_as_float(((unsigned)v) << 16); }
__device__ __forceinline__ bf16_t f2bf(float f) { return (bf16_t)(cvtpk(f, f) & 0xffffu); }
__device__ __forceinline__ float sigmoidf_(float v) { return __builtin_amdgcn_rcpf(1.f + __expf(-v)); }

__device__ __forceinline__ void transpose_cvt_strip(const float* __restrict__ W, bf16_t* __restrict__ Wt, int K, int N, int strip, float* tl) {
  const int tid = threadIdx.x;
  const int nsn = N >> 7;
  const int n0 = (strip % nsn) * 128, k0 = (strip / nsn) * 64;
  const int r = tid >> 5, c4 = (tid & 31) * 4;
  f32x4 v[4];
#pragma unroll
  for (int j = 0; j < 4; ++j) v[j] = __builtin_nontemporal_load((const f32x4*)(W + (size_t)(k0 + r + 16 * j) * N + n0 + c4));
#pragma unroll
  for (int j = 0; j < 4; ++j) { float* d = tl + (r + 16 * j) * 129 + c4; d[0] = v[j][0]; d[1] = v[j][1]; d[2] = v[j][2]; d[3] = v[j][3]; }
  __syncthreads();
#pragma unroll
  for (int i = 0; i < 2; ++i) {
    const int id = tid + 512 * i, n = id >> 3, kc = (id & 7) * 8;
    u32x4 w;
    w[0] = cvtpk(tl[(kc + 0) * 129 + n], tl[(kc + 1) * 129 + n]);
    w[1] = cvtpk(tl[(kc + 2) * 129 + n], tl[(kc + 3) * 129 + n]);
    w[2] = cvtpk(tl[(kc + 4) * 129 + n], tl[(kc + 5) * 129 + n]);
    w[3] = cvtpk(tl[(kc + 6) * 129 + n], tl[(kc + 7) * 129 + n]);
    *(u32x4*)(Wt + (size_t)(n0 + n) * K + k0 + kc) = w;
  }
  __syncthreads();
}
__device__ __forceinline__ void transpose_late_weights(const Params& p, char* lds, int worker, int nworkers) {
  float* tl = (float*)lds;
  constexpr int S_OA = (BW / 64) * (DM / 128), S_WO = (DM / 64) * (DM / 128);
  for (int t = worker; t < 2 * S_OA + S_WO; t += nworkers) {
    if (t < S_OA) transpose_cvt_strip(p.w_out_a, p.waT, BW, DM, t, tl);
    else if (t < 2 * S_OA) transpose_cvt_strip(p.w_out_b, p.wbT, BW, DM, t - S_OA, tl);
    else transpose_cvt_strip(p.w_o, p.woT, DM, DM, t - 2 * S_OA, tl);
  }
}

__device__ __forceinline__ void phase_prologue(const Params& p, char* lds) {
  const int tid = threadIdx.x, wid = tid >> 6, lane = tid & 63;
  for (int i = blockIdx.x * 512 + tid; i < SEQ * 32; i += gridDim.x * 512) {
    const int pos = i >> 5, f = i & 31;
    const float inv = 1.0f / exp2f((float)f * (13.287712379549449f / 32.0f));
    const float ang = (float)pos * inv;
    const double rev = (double)ang * 0.15915494309189535;
    const float fr = (float)(rev - rint(rev));
    float2 cs; cs.x = __builtin_amdgcn_cosf(fr); cs.y = __builtin_amdgcn_sinf(fr);
    p.rope[i] = cs;
  }
  for (int row = blockIdx.x * 8 + wid; row < MTOK; row += gridDim.x * 8) {
    const float* xr = p.x + (size_t)row * DM;
    f32x4 v[8]; float ss = 0.f;
#pragma unroll
    for (int j = 0; j < 8; ++j) { v[j] = __builtin_nontemporal_load((const f32x4*)(xr + j * 256 + lane * 4)); ss += v[j][0] * v[j][0] + v[j][1] * v[j][1] + v[j][2] * v[j][2] + v[j][3] * v[j][3]; }
#pragma unroll
    for (int m = 1; m < 64; m <<= 1) ss += __shfl_xor(ss, m);
    const float rinv = rsqrtf(ss * (1.0f / DM) + EPS);
    bf16_t* hr = p.h + (size_t)row * DM;
#pragma unroll
    for (int j = 0; j < 8; ++j) {
      const f32x4 g = *(const f32x4*)(p.norm_g + j * 256 + lane * 4);
      u32x2 w; w[0] = cvtpk(v[j][0] * rinv * g[0], v[j][1] * rinv * g[1]); w[1] = cvtpk(v[j][2] * rinv * g[2], v[j][3] * rinv * g[3]);
      *(u32x2*)(hr + j * 256 + lane * 4) = w;
    }
  }
  float* tl = (float*)lds;
  constexpr int S_IN = (DM / 64) * (CT / 128);
  for (int t = blockIdx.x; t < S_IN; t += gridDim.x) transpose_cvt_strip(p.w_in, p.winT, DM, CT, t, tl);
}

template <int NI>
__device__ __forceinline__ void gemm_prefetch(const bf16_t* __restrict__ A, int lda, const bf16_t* __restrict__ Bt, int ldb, char* lds_) {
  constexpr int BN = NI * 64, NPB = BN / 128;
  constexpr int SA = 256 * 64, SB = BN * 64, STG = SA + SB;
  LAS char* lds = (LAS char*)lds_;
  const int tid = threadIdx.x, wid = __builtin_amdgcn_readfirstlane(tid >> 6);
  const int rowq = tid >> 2, lc = (tid & 3) ^ ((tid >> 4) & 3);
  const unsigned goA = (unsigned)(rowq * lda + lc * 8) * 2u, goB = (unsigned)(rowq * ldb + lc * 8) * 2u;
  const char* Ab0 = (const char*)A; const char* Bb0 = (const char*)Bt;
#pragma unroll
  for (int kt = 0; kt < 2; ++kt) {
    LAS char* sb_ = lds + kt * STG + wid * 1024;
#pragma unroll
    for (int i_ = 0; i_ < 2; ++i_) __builtin_amdgcn_global_load_lds((const unsigned*)(Ab0 + (size_t)kt * 64 + (size_t)(128 * i_) * lda * 2 + goA), (LAS unsigned*)(sb_ + i_ * 8192), 16, 0, 0);
#pragma unroll
    for (int i_ = 0; i_ < NPB; ++i_) __builtin_amdgcn_global_load_lds((const unsigned*)(Bb0 + (size_t)kt * 64 + (size_t)(128 * i_) * ldb * 2 + goB), (LAS unsigned*)(sb_ + SA + i_ * 8192), 16, 0, 0);
  }
}
template <int NI, bool PRE = false>
__device__ __forceinline__ void gemm_mainloop(const bf16_t* __restrict__ A, int lda, const bf16_t* __restrict__ Bt, int ldb, int K,
                                              f32x16 (&acc)[2][NI], char* lds_) {
  constexpr int BN = NI * 64, NPB = BN / 128;
  constexpr int SA = 256 * 64, SB = BN * 64, STG = SA + SB;
  constexpr int P = 2 + NPB;
  LAS char* lds = (LAS char*)lds_;
  const int tid = threadIdx.x, wid = __builtin_amdgcn_readfirstlane(tid >> 6), lane = tid & 63, r32 = lane & 31, hi = lane >> 5, wm = wid >> 1, wn = wid & 1;
  const int rowq = tid >> 2, lc = (tid & 3) ^ ((tid >> 4) & 3);
  const unsigned goA = (unsigned)(rowq * lda + lc * 8) * 2u, goB = (unsigned)(rowq * ldb + lc * 8) * 2u;
  const char* Ab0 = (const char*)A; const char* Bb0 = (const char*)Bt;
  const int nt = K >> 5;
#define G_ISSUE(kt_) do { const int st_ = (kt_) & 3; const char* An_ = Ab0 + (size_t)(kt_) * 64; const char* Bn_ = Bb0 + (size_t)(kt_) * 64; \
    LAS char* sb_ = lds + st_ * STG + wid * 1024; \
    _Pragma("unroll") for (int i_ = 0; i_ < 2; ++i_) __builtin_amdgcn_global_load_lds((const unsigned*)(An_ + (size_t)(128 * i_) * lda * 2 + goA), (LAS unsigned*)(sb_ + i_ * 8192), 16, 0, 0); \
    _Pragma("unroll") for (int i_ = 0; i_ < NPB; ++i_) __builtin_amdgcn_global_load_lds((const unsigned*)(Bn_ + (size_t)(128 * i_) * ldb * 2 + goB), (LAS unsigned*)(sb_ + SA + i_ * 8192), 16, 0, 0); } while (0)
#define G_PIECE(kt_, j_) do { const int st_ = (kt_) & 3; LAS char* sb_ = lds + st_ * STG + wid * 1024; \
    if ((j_) < 2) __builtin_amdgcn_global_load_lds((const unsigned*)(Ab0 + (size_t)(kt_) * 64 + (size_t)(128 * (j_)) * lda * 2 + goA), (LAS unsigned*)(sb_ + (j_) * 8192), 16, 0, 0); \
    else __builtin_amdgcn_global_load_lds((const unsigned*)(Bb0 + (size_t)(kt_) * 64 + (size_t)(128 * ((j_) - 2)) * ldb * 2 + goB), (LAS unsigned*)(sb_ + SA + ((j_) - 2) * 8192), 16, 0, 0); } while (0)
  if (!PRE) { asm volatile("s_waitcnt vmcnt(0)" ::: "memory"); G_ISSUE(0); G_ISSUE(1); }
  const int sw = (r32 >> 2) & 3;
  const int co0 = (hi ^ sw) << 4;
  const int aoff = (wm * 64 + r32) * 64, boff = SA + (wn * (BN / 2) + r32) * 64;
  constexpr int STEP = (2 * NI) / P;
#define DSR(dst, addr, OFF) asm volatile("ds_read_b128 %0, %1 offset:%2" : "=&v"(dst) : "v"(addr), "i"(OFF) : "memory")
#define DSR_SET(F, pa, pb) do { DSR(F.a[0], pa, 0); DSR(F.a[1], pa, 2048); _Pragma("unroll") for (int ni_ = 0; ni_ < NI; ++ni_) DSR(F.b[ni_], pb, ni_ * 2048); } while (0)
#define MMA_SET(F, KT_ISSUE) do { _Pragma("unroll") for (int mi_ = 0; mi_ < 2; ++mi_) _Pragma("unroll") for (int ni_ = 0; ni_ < NI; ++ni_) { \
      acc[mi_][ni_] = __builtin_amdgcn_mfma_f32_32x32x16_bf16(F.b[ni_], F.a[mi_], acc[mi_][ni_], 0, 0, 0); \
      const int idx_ = mi_ * NI + ni_; \
      if ((KT_ISSUE) >= 0 && (idx_ + 1) % STEP == 0 && (idx_ + 1) / STEP - 1 < P) { SBAR(); if (issue) G_PIECE((KT_ISSUE), (idx_ + 1) / STEP - 1); SBAR(); } } } while (0)
#define LWAIT(N) do { SBAR(); asm volatile("s_waitcnt lgkmcnt(%0)" :: "n"(N) : "memory"); SBAR(); } while (0)
  struct Frag { bf16x8 a[2]; bf16x8 b[NI]; };
  for (int kt = 0; kt < nt; kt += 2) {
    asm volatile("s_waitcnt vmcnt(0)" ::: "memory");
    __builtin_amdgcn_s_barrier();
    asm volatile("" ::: "memory");
    const bool issue = (kt + 2 < nt);
    const int sa_ = (int)(uintptr_t)(lds + (kt & 3) * STG), sb2_ = (int)(uintptr_t)(lds + ((kt + 1) & 3) * STG);
    Frag F0, F1;
    DSR_SET(F0, sa_ + aoff + co0, sa_ + boff + co0);
    DSR_SET(F1, sa_ + aoff + (co0 ^ 32), sa_ + boff + (co0 ^ 32));
    LWAIT(2 + NI);
    MMA_SET(F0, kt + 2);
    SBAR(); DSR_SET(F0, sb2_ + aoff + co0, sb2_ + boff + co0); SBAR();
    LWAIT(2 + NI);
    MMA_SET(F1, kt + 3);
    SBAR(); DSR_SET(F1, sb2_ + aoff + (co0 ^ 32), sb2_ + boff + (co0 ^ 32)); SBAR();
    LWAIT(2 + NI);
    MMA_SET(F0, -1);
    LWAIT(0);
    MMA_SET(F1, -1);
  }
#undef DSR
#undef DSR_SET
#undef MMA_SET
#undef LWAIT
  asm volatile("" ::: "memory");
  __builtin_amdgcn_s_barrier();
  asm volatile("" ::: "memory");
#undef G_ISSUE
#undef G_PIECE
}

namespace pg8 {
#define PG8_LAS __attribute__((address_space(3)))
typedef unsigned short bf16_t;
typedef short bf16x8 __attribute__((ext_vector_type(8)));
typedef float f32x4 __attribute__((ext_vector_type(4)));
typedef unsigned u32x4 __attribute__((ext_vector_type(4)));
constexpr int BM = 256, BK = 64, HALF = 128, HTB = HALF * BK * 2  , STAGE_BYTES = 8 * HTB, NXCD = 8, WGM = 8;

__host__ __device__ __forceinline__ int lds_byte(int r, int c) { const int st = (r >> 4) * 2 + (c >> 5), rr = r & 15, cc = c & 31, ob = rr * 64 + cc * 2; return st * 1024 + (ob ^ (((ob >> 9) & 1) << 5)); }
__host__ __device__ __forceinline__ void stage_rc(int b, int& R, int& C) { const int st = b / 1024, sb = b % 1024, swz = sb ^ (((sb >> 9) & 1) << 5); R = (st >> 1) * 16 + swz / 64; C = (st & 1) * 32 + (swz % 64) / 2; }
__host__ __device__ __forceinline__ int perm32(int rho) { const int n = rho >> 4, i = rho & 15; return 8 * (i >> 2) + 4 * n + (i & 3); }

struct Unit { int pm, pn; };
struct Gemm { const bf16_t* A; const bf16_t* Bt; int M, N, K; };

__device__ __forceinline__ unsigned cvt_pk_bf16(float lo, float hi) { unsigned r; asm volatile("v_cvt_pk_bf16_f32 %0, %1, %2" : "=v"(r) : "v"(lo), "v"(hi)); return r; }
template <class Epi, class Sched, bool ALIGN_EPI = false, bool SP2 = false>
__device__ __forceinline__ void gemm_phase(PG8_LAS unsigned char* lds, const Gemm g, const Sched& S, const Epi& E) {
    const int tid = threadIdx.x, wid = __builtin_amdgcn_readfirstlane(tid >> 6), lane = tid & 63, wr = wid >> 2, wc = wid & 3, fr = lane & 15, fq = lane >> 4;
    const int K = g.K, nt = K / BK;
    unsigned voffA[2], voffB[2];
#pragma unroll
    for (int i = 0; i < 2; ++i) { int R, C; stage_rc(tid * 16 + i * 8192, R, C); const int Rb = Epi::PERM ? ((R & ~31) + perm32(R & 31)) : R;
        voffA[i] = (unsigned)(R * K + C) * 2u; voffB[i] = (unsigned)(Rb * K + C) * 2u; }
    unsigned voffB1[2]; size_t hstepB = (size_t)HALF * K * 2;
#pragma unroll
    for (int i = 0; i < 2; ++i) { voffB1[i] = voffB[i];
        if constexpr (Epi::COLMAP) { int R, C; stage_rc(tid * 16 + i * 8192, R, C); const int c0 = 64 * (R >> 5) + perm32(R & 31);
            voffB[i] = (unsigned)(c0 * K + C) * 2u; voffB1[i] = (unsigned)((c0 + 32) * K + C) * 2u; } }
    if constexpr (Epi::COLMAP) hstepB = 0;
    const size_t kstep = (size_t)(BK * 2);
    const size_t hstep = (size_t)HALF * K * 2;
    const size_t tstep = 2 * hstep;
    const unsigned ldsw = (unsigned)wid * 1024u;
    const int aoff = lds_byte(wr * 64 + fr, fq * 8), boff = lds_byte(wc * 32 + fr, fq * 8);
#define PG8_SA(b, h) (((b) * 2 + (h)) * HTB)
#define PG8_SB(b, h) ((4 + (b) * 2 + (h)) * HTB)
#define PG8_STAGE(bufoff, gbase, voff) do { _Pragma("unroll") for (int _i = 0; _i < 2; ++_i) \
        __builtin_amdgcn_global_load_lds((const unsigned*)((const char*)(gbase) + (voff)[_i]), (PG8_LAS unsigned*)(lds + (bufoff) + ldsw + _i * 8192), 16, 0, 0); } while (0)
#define PG8_LDA(dst, b, h) do { _Pragma("unroll") for (int m = 0; m < 4; ++m) _Pragma("unroll") for (int k = 0; k < 2; ++k) dst[m][k] = *(const PG8_LAS bf16x8*)(lds + PG8_SA(b, h) + aoff + m * 2048 + k * 1024); } while (0)
#define PG8_LDB(dst, b, h) do { _Pragma("unroll") for (int n = 0; n < 2; ++n) _Pragma("unroll") for (int k = 0; k < 2; ++k) dst[n][k] = *(const PG8_LAS bf16x8*)(lds + PG8_SB(b, h) + boff + n * 2048 + k * 1024); } while (0)
#define PG8_MMA(ai, bj, At, Bt) do { __builtin_amdgcn_s_setprio(1); _Pragma("unroll") for (int m = 0; m < 4; ++m) _Pragma("unroll") for (int n = 0; n < 2; ++n) _Pragma("unroll") for (int k = 0; k < 2; ++k) \
        acc[ai][bj][m][n] = __builtin_amdgcn_mfma_f32_16x16x32_bf16(Bt[n][k], At[m][k], acc[ai][bj][m][n], 0, 0, 0); __builtin_amdgcn_s_setprio(0); } while (0)
#define PG8_WAIT_V(n) asm volatile("s_waitcnt vmcnt(" #n ")" ::: "memory")
#define PG8_WAIT_L(n) asm volatile("s_waitcnt lgkmcnt(" #n ")" ::: "memory")
#define PG8_BAR __builtin_amdgcn_s_barrier()
#define PG8_SCHED __builtin_amdgcn_sched_barrier(0)
    Unit cur, nxt; int ui = 0;
    if (!S.next(0, cur)) return;
    f32x4 acc[2][2][4][2];
#pragma unroll
    for (int a = 0; a < 2; ++a)
#pragma unroll
        for (int b = 0; b < 2; ++b)
#pragma unroll
            for (int m = 0; m < 4; ++m)
#pragma unroll
                for (int n = 0; n < 2; ++n) acc[a][b][m][n] = (f32x4){0.f, 0.f, 0.f, 0.f};
    bf16x8 At[4][2], B0[2][2], B1[2][2];
    const char* cA = (const char*)g.A + (size_t)cur.pm * tstep; const char* cB = (const char*)g.Bt + (size_t)cur.pn * tstep;
    S.a_ready(cur);
    if constexpr (SP2) {
        PG8_STAGE(PG8_SB(0, 0), cB, voffB); PG8_STAGE(PG8_SB(0, 1), cB + hstepB, voffB1); PG8_STAGE(PG8_SA(0, 0), cA, voffA); PG8_STAGE(PG8_SA(0, 1), cA + hstep, voffA);
        if (wr == 1) PG8_BAR;
        PG8_WAIT_V(2); PG8_BAR;
        PG8_STAGE(PG8_SB(1, 0), cB + kstep, voffB); PG8_STAGE(PG8_SA(1, 0), cA + kstep, voffA); PG8_STAGE(PG8_SB(1, 1), cB + hstepB + kstep, voffB1);
        PG8_WAIT_V(6); PG8_BAR;
    } else {
        PG8_STAGE(PG8_SB(0, 0), cB, voffB); PG8_STAGE(PG8_SA(0, 0), cA, voffA); PG8_STAGE(PG8_SB(0, 1), cB + hstepB, voffB1); PG8_STAGE(PG8_SA(0, 1), cA + hstep, voffA);
        if (wr == 1) PG8_BAR;
        PG8_WAIT_V(4); PG8_BAR;
        PG8_STAGE(PG8_SB(1, 0), cB + kstep, voffB); PG8_STAGE(PG8_SA(1, 0), cA + kstep, voffA); PG8_STAGE(PG8_SB(1, 1), cB + hstepB + kstep, voffB1);
        PG8_WAIT_V(6); PG8_BAR;
    }
    for (;;) {
        const bool has_next = S.next(ui + 1, nxt);
        const char* nA = has_next ? (const char*)g.A + (size_t)nxt.pm * tstep : cA; const char* nB = has_next ? (const char*)g.Bt + (size_t)nxt.pn * tstep : cB;
        for (int t = 0; t < nt; t += 2) {
            const bool last = (t == nt - 2);
            const char* a1 = cA + (size_t)(t + 1) * kstep;
            const char* a2 = last ? nA : cA + (size_t)(t + 2) * kstep; const char* b2 = last ? nB : cB + (size_t)(t + 2) * kstep;
            const char* a3 = a2 + kstep; const char* b3 = b2 + kstep;
            if (last && has_next) S.a_ready(nxt);
            if constexpr (SP2) {
            PG8_LDB(B0, 0, 0); PG8_LDB(B1, 0, 1); PG8_SCHED; PG8_LDA(At, 0, 0); PG8_STAGE(PG8_SA(1, 1), a1 + hstep, voffA);
            PG8_WAIT_V(8); PG8_WAIT_L(0); PG8_BAR; PG8_MMA(0, 0, At, B0); PG8_MMA(0, 1, At, B1); PG8_BAR; PG8_SCHED;
            PG8_LDA(At, 0, 1); PG8_STAGE(PG8_SB(0, 0), b2, voffB); PG8_STAGE(PG8_SB(0, 1), b2 + hstepB, voffB1); PG8_STAGE(PG8_SA(0, 0), a2, voffA);
            PG8_WAIT_V(8); PG8_WAIT_L(0); PG8_BAR; PG8_MMA(1, 0, At, B0); PG8_MMA(1, 1, At, B1); PG8_BAR; PG8_SCHED;
            PG8_LDB(B0, 1, 0); PG8_LDB(B1, 1, 1); PG8_SCHED; PG8_LDA(At, 1, 0); PG8_STAGE(PG8_SA(0, 1), a2 + hstep, voffA);
            PG8_WAIT_V(8); PG8_WAIT_L(0); PG8_BAR; PG8_MMA(0, 0, At, B0); PG8_MMA(0, 1, At, B1); PG8_BAR; PG8_SCHED;
            PG8_LDA(At, 1, 1); PG8_STAGE(PG8_SB(1, 0), b3, voffB); PG8_STAGE(PG8_SB(1, 1), b3 + hstepB, voffB1); PG8_STAGE(PG8_SA(1, 0), a3, voffA);
            PG8_WAIT_V(8); PG8_WAIT_L(0); PG8_BAR; PG8_MMA(1, 0, At, B0); PG8_MMA(1, 1, At, B1); PG8_BAR; PG8_SCHED;
            } else {
            PG8_LDB(B0, 0, 0); PG8_SCHED; PG8_LDA(At, 0, 0); PG8_STAGE(PG8_SA(1, 1), a1 + hstep, voffA);
            PG8_WAIT_L(8); PG8_BAR; PG8_WAIT_L(0); PG8_MMA(0, 0, At, B0); PG8_BAR; PG8_SCHED;
            PG8_LDB(B1, 0, 1); PG8_STAGE(PG8_SB(0, 0), b2, voffB);
            PG8_BAR; PG8_WAIT_L(0); PG8_MMA(0, 1, At, B1); PG8_BAR;
            PG8_LDA(At, 0, 1); PG8_STAGE(PG8_SA(0, 0), a2, voffA);
            PG8_BAR; PG8_WAIT_L(0); PG8_MMA(1, 0, At, B0); PG8_BAR; PG8_SCHED;
            PG8_STAGE(PG8_SB(0, 1), b2 + hstepB, voffB1);
            PG8_WAIT_V(6); PG8_BAR; PG8_MMA(1, 1, At, B1); PG8_BAR;
            PG8_LDB(B0, 1, 0); PG8_SCHED; PG8_LDA(At, 1, 0); PG8_STAGE(PG8_SA(0, 1), a2 + hstep, voffA);
            PG8_WAIT_L(8); PG8_BAR; PG8_WAIT_L(0); PG8_MMA(0, 0, At, B0); PG8_BAR; PG8_SCHED;
            PG8_LDB(B1, 1, 1); PG8_STAGE(PG8_SB(1, 0), b3, voffB);
            PG8_BAR; PG8_WAIT_L(0); PG8_MMA(0, 1, At, B1); PG8_BAR;
            PG8_LDA(At, 1, 1); PG8_STAGE(PG8_SA(1, 0), a3, voffA);
            PG8_BAR; PG8_WAIT_L(0); PG8_MMA(1, 0, At, B0); PG8_BAR; PG8_SCHED;
            PG8_STAGE(PG8_SB(1, 1), b3 + hstepB, voffB1);
            PG8_WAIT_V(6); PG8_BAR; PG8_MMA(1, 1, At, B1); PG8_BAR;
            }
        }
        if constexpr (ALIGN_EPI) { if (wr == 0) PG8_BAR; }
        if constexpr (!Epi::AFTER_DRAIN) { E(acc, cur, wr, wc, fr, fq); S.done(cur); }
        if (!has_next) break;
#pragma unroll
        for (int a = 0; a < 2; ++a)
#pragma unroll
            for (int b = 0; b < 2; ++b)
#pragma unroll
                for (int m = 0; m < 4; ++m)
#pragma unroll
                    for (int n = 0; n < 2; ++n) acc[a][b][m][n] = (f32x4){0.f, 0.f, 0.f, 0.f};
        cur = nxt; cA = nA; cB = nB; ++ui;
        if constexpr (ALIGN_EPI) { if (wr == 1) PG8_BAR; }
    }
    PG8_WAIT_V(0);
    if constexpr (!ALIGN_EPI) { if (wr == 0) PG8_BAR; }
    PG8_BAR;
    if constexpr (Epi::AFTER_DRAIN) { E.fused(acc, cur, wr, wc, fr, fq, lds, wid, lane); S.done(cur); }
#undef PG8_SA
#undef PG8_SB
#undef PG8_STAGE
#undef PG8_LDA
#undef PG8_LDB
#undef PG8_MMA
#undef PG8_WAIT_V
#undef PG8_WAIT_L
#undef PG8_BAR
#undef PG8_SCHED
}
}
__device__ __forceinline__ size_t gbuf_off(int gate, int rb, int cb, int lane) { return ((((size_t)gate * 256 + rb) * 128 + cb) * 64 + lane) * 8; }

struct EpiG1 {
  static constexpr bool PERM = true, AFTER_DRAIN = false, COLMAP = true;
  bf16_t* proj; bf16_t* gbuf; const float2* rope; const float* qn_g; const float* kn_g; float* xch;
  __device__ __forceinline__ void operator()(const pg8::f32x4 (&acc)[2][2][4][2], const pg8::Unit& u, int wr, int wc, int fr, int fq) const {
    const int colt = u.pn * 256;
    if (colt >= C_QB && colt < C_VB) { qknorm(acc, u, wr, wc, fr, fq); return; }
    const int type = (colt < C_VA) ? 0 : (colt >= C_GA) ? 3 : (((colt >= C_ZA && colt < C_QB) || (colt >= C_ZB && colt < C_GA)) ? 2 : 4);
#pragma unroll
    for (int ai = 0; ai < 2; ++ai)
#pragma unroll
      for (int m = 0; m < 4; ++m) {
        const int row = u.pm * 256 + ai * 128 + wr * 64 + m * 16 + fr;
        float v[2][8];
#pragma unroll
        for (int bj = 0; bj < 2; ++bj)
#pragma unroll
          for (int e = 0; e < 4; ++e) { v[bj][e] = acc[ai][bj][m][0][e]; v[bj][4 + e] = acc[ai][bj][m][1][e]; }
        if (type == 0) {
          const f32x4* tp = (const f32x4*)(rope + (row & (SEQ - 1)) * 32 + 8 * fq);
#pragma unroll
          for (int q = 0; q < 4; ++q) { const f32x4 cs = tp[q];
            { const float x1 = v[0][2 * q], x2 = v[1][2 * q]; v[0][2 * q] = x1 * cs[0] - x2 * cs[1]; v[1][2 * q] = x2 * cs[0] + x1 * cs[1]; }
            { const float x1 = v[0][2 * q + 1], x2 = v[1][2 * q + 1]; v[0][2 * q + 1] = x1 * cs[2] - x2 * cs[3]; v[1][2 * q + 1] = x2 * cs[2] + x1 * cs[3]; } }
        } else if (type == 2) {
#pragma unroll
          for (int bj = 0; bj < 2; ++bj)
#pragma unroll
            for (int e = 0; e < 8; ++e) v[bj][e] = v[bj][e] * sigmoidf_(v[bj][e]);
        } else if (type == 3) {
#pragma unroll
          for (int bj = 0; bj < 2; ++bj)
#pragma unroll
            for (int e = 0; e < 8; ++e) v[bj][e] = sigmoidf_(v[bj][e]);
        }
#pragma unroll
        for (int bj = 0; bj < 2; ++bj) {
          const int col8 = colt + 64 * wc + 32 * bj + 8 * fq;
          u32x4 w; w[0] = cvtpk(v[bj][0], v[bj][1]); w[1] = cvtpk(v[bj][2], v[bj][3]); w[2] = cvtpk(v[bj][4], v[bj][5]); w[3] = cvtpk(v[bj][6], v[bj][7]);
          if (type == 3) {
            const int gate = (col8 >= C_GB) ? 1 : 0, gc = col8 - (gate ? C_GB : C_GA);
            *(u32x4*)(gbuf + gbuf_off(gate, row >> 5, gc >> 4, ((gc >> 3) & 1) * 32 + (row & 31))) = w;
          } else {
            *(u32x4*)(proj + (size_t)row * CT + col8) = w;
          }
        }
        asm volatile("" ::: "memory");
      }
  }
  __device__ __forceinline__ void qknorm(const pg8::f32x4 (&acc)[2][2][4][2], const pg8::Unit& u, int wr, int wc, int fr, int fq) const {
    const int colt = u.pn * 256, wid = wr * 4 + wc;
    const float* g = (colt < C_KB) ? qn_g : kn_g;
#pragma unroll
    for (int ai = 0; ai < 2; ++ai)
#pragma unroll
      for (int m = 0; m < 4; ++m) {
        float ss = 0.f;
#pragma unroll
        for (int bj = 0; bj < 2; ++bj)
#pragma unroll
          for (int n = 0; n < 2; ++n)
#pragma unroll
            for (int e = 0; e < 4; ++e) ss += acc[ai][bj][m][n][e] * acc[ai][bj][m][n][e];
        ss += __shfl_xor(ss, 16); ss += __shfl_xor(ss, 32);
        if (fq == 0) xch[wid * 128 + (ai * 4 + m) * 16 + fr] = ss;
        asm volatile("" ::: "memory");
      }
    asm volatile("s_waitcnt lgkmcnt(0)" ::: "memory");
    __builtin_amdgcn_s_barrier();
    asm volatile("" ::: "memory");
    const int hg = wc & 1;
#pragma unroll
    for (int ai = 0; ai < 2; ++ai)
#pragma unroll
      for (int m = 0; m < 4; ++m) {
        const int row = u.pm * 256 + ai * 128 + wr * 64 + m * 16 + fr;
        const float tot = xch[wid * 128 + (ai * 4 + m) * 16 + fr] + xch[(wid ^ 1) * 128 + (ai * 4 + m) * 16 + fr];
        const float rinv = rsqrtf(tot * (1.0f / 128.0f) + EPS);
        float v[2][8];
#pragma unroll
        for (int bj = 0; bj < 2; ++bj) { const f32x4 g0 = *(const f32x4*)(g + hg * 64 + bj * 32 + 8 * fq), g1 = *(const f32x4*)(g + hg * 64 + bj * 32 + 8 * fq + 4);
#pragma unroll
          for (int e = 0; e < 4; ++e) { v[bj][e] = acc[ai][bj][m][0][e] * rinv * g0[e]; v[bj][4 + e] = acc[ai][bj][m][1][e] * rinv * g1[e]; } }
        const int s_ = row & (SEQ - 1), pos = hg ? (s_ & 63) : (s_ >> 6);
        const f32x4* tp = (const f32x4*)(rope + pos * 32 + 8 * fq);
#pragma unroll
        for (int q = 0; q < 4; ++q) { const f32x4 cs = tp[q];
          { const float x1 = v[0][2 * q], x2 = v[1][2 * q]; v[0][2 * q] = x1 * cs[0] - x2 * cs[1]; v[1][2 * q] = x2 * cs[0] + x1 * cs[1]; }
          { const float x1 = v[0][2 * q + 1], x2 = v[1][2 * q + 1]; v[0][2 * q + 1] = x1 * cs[2] - x2 * cs[3]; v[1][2 * q + 1] = x2 * cs[2] + x1 * cs[3]; } }
#pragma unroll
        for (int bj = 0; bj < 2; ++bj) {
          const int col8 = colt + 64 * wc + 32 * bj + 8 * fq;
          u32x4 w; w[0] = cvtpk(v[bj][0], v[bj][1]); w[1] = cvtpk(v[bj][2], v[bj][3]); w[2] = cvtpk(v[bj][4], v[bj][5]); w[3] = cvtpk(v[bj][6], v[bj][7]);
          *(u32x4*)(proj + (size_t)row * CT + col8) = w;
        }
        asm volatile("" ::: "memory");
      }
  }
};
struct SchedG1 {
  int b;
  __device__ __forceinline__ bool next(int i, pg8::Unit& u) const {
    int id;
    if (b < 160) { if (i >= 5) return false; if (i == 4) { u.pm = b & 31; u.pn = 16 + (b >> 5); return true; } id = b + 160 * i; }
    else { if (i >= 5) return false; id = 640 + (b - 160) + 96 * i; }
    const int ct = id >> 5; u.pm = id & 31; u.pn = (ct < 16) ? ct : (21 + (ct - 16)); return true;
  }
  __device__ __forceinline__ void a_ready(const pg8::Unit&) const {}
  __device__ __forceinline__ void done(const pg8::Unit&) const {}
};

#define XB_TMO      128
#define XB_XCNT(j)  (256  + 64 * (j))
#define XB_XSUB(j)  (1280 + 64 * (j))
#define XB_XGEN(j)  (2304 + 64 * (j))
#define XB_TOP      3328
#define XB_TOPGEN   3392
#define XCD_BAR_WORDS 3456
#define XB_SPIN_CAP (1u << 18)

__device__ __forceinline__ unsigned xb_ld(unsigned* p)              { return __hip_atomic_load(p, __ATOMIC_RELAXED, __HIP_MEMORY_SCOPE_AGENT); }
__device__ __forceinline__ unsigned xb_add(unsigned* p, unsigned v) { return __hip_atomic_fetch_add(p, v, __ATOMIC_RELAXED, __HIP_MEMORY_SCOPE_AGENT); }
__device__ __forceinline__ unsigned xb_xcc_id() { return (unsigned)__builtin_amdgcn_s_getreg((3 << 11) | 20) & 0xFu; }
#define XB_SPIN(cond, bar) do { unsigned _sp = 0; while (cond) { __builtin_amdgcn_s_sleep(1); \
    if ((++_sp & 255u) == 0u) { if (xb_ld(&(bar)[XB_TMO])) break; if (_sp > XB_SPIN_CAP) { atomicAdd(&(bar)[XB_TMO], 1u); break; } } } } while (0)

struct XcdBarrier {
    unsigned* bar; unsigned x;
    volatile LAS unsigned* st;
};

__device__ __forceinline__ XcdBarrier xcd_barrier_post(unsigned* bar, volatile LAS unsigned* st) {
    XcdBarrier b; b.bar = bar; b.x = xb_xcc_id(); b.st = st;
    if (threadIdx.x == 0) (void)xb_add(&bar[XB_XCNT(b.x)], 1u);
    return b;
}
__device__ __forceinline__ void xcd_barrier_complete(unsigned* bar, unsigned x, unsigned& nloc, unsigned& nx) {
    const unsigned G = gridDim.x * gridDim.y * gridDim.z;
    unsigned sum, cnt, mine, sp = 0u;
    for (;;) {
        sum = 0u; cnt = 0u; mine = 0u;
#pragma unroll
        for (unsigned j = 0; j < 16; ++j) { const unsigned c = xb_ld(&bar[XB_XCNT(j)]); sum += c; cnt += (c > 0u) ? 1u : 0u; mine = (j == x) ? c : mine; }
        if (sum == G) break;
        __builtin_amdgcn_s_sleep(1);
        if ((++sp & 255u) == 0u) { if (xb_ld(&bar[XB_TMO])) break; if (sp > XB_SPIN_CAP) { atomicAdd(&bar[XB_TMO], 1u); break; } }
    }
    nloc = mine > 0u ? mine : 1u; nx = cnt > 0u ? cnt : 1u;
}

__device__ __forceinline__ void xcd_barrier(const XcdBarrier& b) {
    asm volatile("s_waitcnt vmcnt(0)" ::: "memory");
    __syncthreads();
    if (threadIdx.x == 0) {
        unsigned* bar = b.bar;
        __builtin_amdgcn_s_waitcnt(0);
        unsigned nloc = b.st[0], nx = b.st[1];
        if (nloc == 0u) { xcd_barrier_complete(bar, b.x, nloc, nx); b.st[0] = nloc; b.st[1] = nx; }
        const unsigned old = xb_add(&bar[XB_XSUB(b.x)], 1u);
        const unsigned gen = old / nloc;
        if (old + 1u == (gen + 1u) * nloc) {
            __builtin_amdgcn_fence(__ATOMIC_RELEASE, "agent");
            asm volatile("s_waitcnt vmcnt(0)" ::: "memory");
            const unsigned og = xb_add(&bar[XB_TOP], 1u);
            const unsigned tg = og / nx;
            if (og + 1u == (tg + 1u) * nx) xb_add(&bar[XB_TOPGEN], 1u);
            else XB_SPIN(xb_ld(&bar[XB_TOPGEN]) == tg, bar);
            __builtin_amdgcn_fence(__ATOMIC_ACQUIRE, "agent");
            xb_add(&bar[XB_XGEN(b.x)], 1u);
            asm volatile("s_waitcnt vmcnt(0)" ::: "memory");
        } else {
            XB_SPIN(xb_ld(&bar[XB_XGEN(b.x)]) == gen, bar);
            __builtin_amdgcn_fence(__ATOMIC_ACQUIRE, "agent");
            asm volatile("s_waitcnt vmcnt(0)" ::: "memory");
        }
    }
    __syncthreads();
}


__device__ __forceinline__ int launder(int x) { asm volatile("" : "+v"(x)); return x; }

__device__ __forceinline__ void rot4(float (&x1)[4], float (&x2)[4], const f32x4 ca, const f32x4 cb) {
  const float c[4] = {ca[0], ca[2], cb[0], cb[2]}, sn[4] = {ca[1], ca[3], cb[1], cb[3]};
#pragma unroll
  for (int e = 0; e < 4; ++e) { const float a = x1[e] * c[e] - x2[e] * sn[e], bb = x2[e] * c[e] + x1[e] * sn[e]; x1[e] = a; x2[e] = bb; }
}
__device__ __forceinline__ u32x4 pack8(const float (&a)[4], const float (&b)[4]) {
  const unsigned a0 = cvtpk(a[0], a[1]), a1 = cvtpk(a[2], a[3]), b0 = cvtpk(b[0], b[1]), b1 = cvtpk(b[2], b[3]);
  auto r0 = __builtin_amdgcn_permlane32_swap(a0, b0, false, false); auto r1 = __builtin_amdgcn_permlane32_swap(a1, b1, false, false);
  u32x4 w = {r0[0], r1[0], r0[1], r1[1]}; return w;
}
template <int TYPE>
__device__ __forceinline__ void epi1_group(const Params& p, const f32x16 (&acc)[2][4], int mi, int gq, int s, int hi, float rinv, const float* g, float (&v)[4][4]) {
  const int i0 = 8 * gq + 4 * hi;
#pragma unroll
  for (int ni = 0; ni < 4; ++ni)
#pragma unroll
    for (int e = 0; e < 4; ++e) v[ni][e] = acc[mi][ni][4 * gq + e];
  if (TYPE == 0) {
    const f32x4* tp = (const f32x4*)(p.rope + s * 32 + i0);
    const f32x4 ca = tp[0], cb = tp[1];
    rot4(v[0], v[1], ca, cb); rot4(v[2], v[3], ca, cb);
  } else if (TYPE == 1) {
#pragma unroll
    for (int ni = 0; ni < 4; ++ni) { const f32x4 gv = *(const f32x4*)(g + ni * 32 + i0);
#pragma unroll
      for (int e = 0; e < 4; ++e) v[ni][e] = v[ni][e] * rinv * gv[e]; }
    const f32x4* t0 = (const f32x4*)(p.rope + (s >> 6) * 32 + i0);
    const f32x4* t1 = (const f32x4*)(p.rope + (s & 63) * 32 + i0);
    const f32x4 a0 = t0[0], b0 = t0[1], a1 = t1[0], b1 = t1[1];
    rot4(v[0], v[1], a0, b0); rot4(v[2], v[3], a1, b1);
  } else if (TYPE == 2) {
#pragma unroll
    for (int ni = 0; ni < 4; ++ni)
#pragma unroll
      for (int e = 0; e < 4; ++e) v[ni][e] = v[ni][e] * sigmoidf_(v[ni][e]);
  } else if (TYPE == 3) {
#pragma unroll
    for (int ni = 0; ni < 4; ++ni)
#pragma unroll
      for (int e = 0; e < 4; ++e) v[ni][e] = sigmoidf_(v[ni][e]);
  }
}
template <int TYPE>
__device__ __forceinline__ void epi1(const Params& p, const f32x16 (&acc)[2][4], int rowb, int col0, int r32, int hi, const float* g) {
#pragma unroll
  for (int mi = 0; mi < 2; ++mi) {
    const int row = rowb + mi * 32 + r32;
    const int s = row & (SEQ - 1);
    float rinv = 1.f;
    if (TYPE == 1) {
      float ss = 0.f;
#pragma unroll
      for (int ni = 0; ni < 4; ++ni)
#pragma unroll
        for (int r = 0; r < 16; ++r) ss += acc[mi][ni][r] * acc[mi][ni][r];
      ss += __shfl_xor(ss, 32);
      rinv = rsqrtf(ss * (1.0f / 128.0f) + EPS);
    }
    bf16_t* dst = p.proj + (size_t)row * CT + col0 + 8 * hi;
#pragma unroll
    for (int j = 0; j < 2; ++j) {
      float va[4][4], vb[4][4];
      epi1_group<TYPE>(p, acc, mi, 2 * j, s, hi, rinv, g, va);
      epi1_group<TYPE>(p, acc, mi, 2 * j + 1, s, hi, rinv, g, vb);
      if (TYPE == 3) {
        const int gate = (col0 >= C_GB) ? 1 : 0, gc = col0 - (gate ? C_GB : C_GA);
        const int rb = (rowb >> 5) + mi, lane_ = hi * 32 + r32;
#pragma unroll
        for (int ni = 0; ni < 4; ++ni) *(u32x4*)(p.gbuf + gbuf_off(gate, rb, (gc >> 4) + ni * 2 + j, lane_)) = pack8(va[ni], vb[ni]);
      } else {
#pragma unroll
        for (int ni = 0; ni < 4; ++ni) *(u32x4*)(dst + ni * 32 + 16 * j) = pack8(va[ni], vb[ni]);
      }
    }
    asm volatile("" ::: "memory");
  }
}

__device__ __forceinline__ void phase_gemm1(const Params& p, char* lds) {
  const int tid = threadIdx.x, wid = tid >> 6, lane = tid & 63, wm = wid >> 1, wn = wid & 1;
  const int b = blockIdx.x;
  const bool has_tail = b < 128;
  {
    pg8::Gemm g{p.h, p.winT, MTOK, CT, DM};
    SchedG1 S{b}; EpiG1 E{p.proj, p.gbuf, p.rope, p.qn_g, p.kn_g, (float*)(lds + 131072 + 64)};
    pg8::gemm_phase<EpiG1, SchedG1, true, true>((LAS unsigned char*)lds, g, S, E);
  }
  const int nmine = 0;
#define MINE_ID(i_) (b)
#define MINE_PN(id_) (16 + ((id_) >> 5))
  if (nmine > 0) { const int id0 = MINE_ID(0); gemm_prefetch<4>(p.h + (size_t)(id0 & 31) * 256 * DM, DM, p.winT + (size_t)MINE_PN(id0) * 256 * DM, DM, lds); }
  for (int i = 0; i < nmine; ++i) {
    const int id = MINE_ID(i);
    const int pm = id & 31, pn = MINE_PN(id);
    f32x16 acc[2][4];
#pragma unroll
    for (int mi = 0; mi < 2; ++mi)
#pragma unroll
      for (int ni = 0; ni < 4; ++ni) acc[mi][ni] = f32x16{};
    gemm_mainloop<4, true>(p.h + (size_t)pm * 256 * DM, DM, p.winT + (size_t)pn * 256 * DM, DM, DM, acc, lds);
    if (i + 1 < nmine) { const int idn = MINE_ID(i + 1); gemm_prefetch<4>(p.h + (size_t)(idn & 31) * 256 * DM, DM, p.winT + (size_t)MINE_PN(idn) * 256 * DM, DM, lds); }
    else if (has_tail) gemm_prefetch<2>(p.h + (size_t)(b & 31) * 256 * DM, DM, p.winT + (size_t)(40 * 256 + (b >> 5) * 128) * DM, DM, lds);
    const int l2 = launder(lane), r32 = l2 & 31, hi = l2 >> 5;
    const int col0 = pn * 256 + wn * 128;
    const int rowb = pm * 256 + wm * 64;
    if (col0 < C_KB) epi1<1>(p, acc, rowb, col0, r32, hi, p.qn_g);
    else epi1<1>(p, acc, rowb, col0, r32, hi, p.kn_g);
  }
  if (nmine == 0 && has_tail) gemm_prefetch<2>(p.h + (size_t)(b & 31) * 256 * DM, DM, p.winT + (size_t)(40 * 256 + (b >> 5) * 128) * DM, DM, lds);
#undef MINE_ID
#undef MINE_PN
  if (!has_tail) transpose_late_weights(p, lds, (int)blockIdx.x - 128, (int)gridDim.x - 128);
  if (has_tail) {
    const int u = blockIdx.x;
    const int pm = u & 31, cbase = 40 * 256 + (u >> 5) * 128;
    f32x16 acc[2][2];
#pragma unroll
    for (int mi = 0; mi < 2; ++mi)
#pragma unroll
      for (int ni = 0; ni < 2; ++ni) acc[mi][ni] = f32x16{};
    gemm_mainloop<2, true>(p.h + (size_t)pm * 256 * DM, DM, p.winT + (size_t)cbase * DM, DM, DM, acc, lds);
    const int l2 = launder(lane), r32 = l2 & 31, hi = l2 >> 5;
    const int col0 = cbase + wn * 64;
    const int rowb = pm * 256 + wm * 64;
#pragma unroll
    for (int mi = 0; mi < 2; ++mi) {
      const int rb = (rowb >> 5) + mi, cb0 = (col0 - C_GB) >> 4;
#pragma unroll
      for (int ni = 0; ni < 2; ++ni) {
        float o[4][4];
#pragma unroll
        for (int gq = 0; gq < 4; ++gq)
#pragma unroll
          for (int e = 0; e < 4; ++e) o[gq][e] = sigmoidf_(acc[mi][ni][4 * gq + e]);
        *(u32x4*)(p.gbuf + gbuf_off(1, rb, cb0 + ni * 2, l2)) = pack8(o[0], o[1]);
        *(u32x4*)(p.gbuf + gbuf_off(1, rb, cb0 + ni * 2 + 1, l2)) = pack8(o[2], o[3]);
      }
    }
  }
}

struct EpiG2 {
  static constexpr bool PERM = true, AFTER_DRAIN = false, COLMAP = false;
  const bf16_t* gbuf; bf16_t* merged;
  __device__ __forceinline__ void operator()(const pg8::f32x4 (&acc)[2][2][4][2], const pg8::Unit& u, int wr, int wc, int fr, int fq) const {
    const int pass = u.pm >> 5, pm = u.pm & 31, pn = u.pn & 7;
#pragma unroll
    for (int ai = 0; ai < 2; ++ai)
#pragma unroll
      for (int m = 0; m < 4; ++m) {
        const int row = pm * 256 + ai * 128 + wr * 64 + m * 16 + fr;
#pragma unroll
        for (int bj = 0; bj < 2; ++bj) {
          const int col8 = pn * 256 + bj * 128 + wc * 32 + 8 * fq;
          const u32x4 gw = __builtin_nontemporal_load((const u32x4*)(gbuf + gbuf_off(pass, row >> 5, col8 >> 4, ((col8 >> 3) & 1) * 32 + (row & 31))));
          bf16_t* mp = merged + (size_t)row * DM + col8;
          float sg[8], o[8];
#pragma unroll
          for (int i = 0; i < 4; ++i) { sg[2 * i] = __uint_as_float(gw[i] << 16); sg[2 * i + 1] = __uint_as_float(gw[i] & 0xffff0000u); }
#pragma unroll
          for (int e = 0; e < 4; ++e) { o[e] = sg[e] * acc[ai][bj][m][0][e]; o[4 + e] = sg[4 + e] * acc[ai][bj][m][1][e]; }
          if (pass) {
            const u32x4 tw = *(const u32x4*)mp;
#pragma unroll
            for (int i = 0; i < 4; ++i) { o[2 * i] += __uint_as_float(tw[i] << 16); o[2 * i + 1] += __uint_as_float(tw[i] & 0xffff0000u); }
          }
          u32x4 w; w[0] = cvtpk(o[0], o[1]); w[1] = cvtpk(o[2], o[3]); w[2] = cvtpk(o[4], o[5]); w[3] = cvtpk(o[6], o[7]);
          *(u32x4*)mp = w;
        }
        asm volatile("" ::: "memory");
      }
  }
};
struct SchedG2 {
  int b;
  __device__ __forceinline__ bool next(int i, pg8::Unit& u) const { if (i >= 2) return false; u.pm = (b & 31) + 32 * i; u.pn = (b >> 5) + 8 * i; return true; }
  __device__ __forceinline__ void a_ready(const pg8::Unit&) const {}
  __device__ __forceinline__ void done(const pg8::Unit&) const {}
};
__device__ __forceinline__ void phase_gemm2(const Params& p, char* lds) {
  pg8::Gemm g{p.U, p.waT, 2 * MTOK, 2 * DM, BW};
  SchedG2 S{(int)blockIdx.x}; EpiG2 E{p.gbuf, p.merged};
  pg8::gemm_phase<EpiG2, SchedG2, true, true>((LAS unsigned char*)lds, g, S, E);
}

struct EpiG3 {
  static constexpr bool PERM = true, AFTER_DRAIN = true, COLMAP = false;
  const float* x; float* out; float* ssq; const float* fg; const XcdBarrier* xb;
  __device__ __forceinline__ void fused(pg8::f32x4 (&acc)[2][2][4][2], const pg8::Unit& u, int wr, int wc, int fr, int fq, LAS unsigned char*, int, int) const {
    const int colw = u.pn * 256 + wc * 32 + 8 * fq;
#pragma unroll
    for (int ai = 0; ai < 2; ++ai)
#pragma unroll
      for (int m = 0; m < 4; ++m) {
        const int row = u.pm * 256 + ai * 128 + wr * 64 + m * 16 + fr;
        float ss = 0.f;
#pragma unroll
        for (int bj = 0; bj < 2; ++bj) {
          const float* xp = x + (size_t)row * DM + colw + bj * 128;
          const f32x4 xa = __builtin_nontemporal_load((const f32x4*)xp), xc = __builtin_nontemporal_load((const f32x4*)(xp + 4));
#pragma unroll
          for (int e = 0; e < 4; ++e) { const float y0 = acc[ai][bj][m][0][e] + xa[e], y1 = acc[ai][bj][m][1][e] + xc[e]; acc[ai][bj][m][0][e] = y0; acc[ai][bj][m][1][e] = y1; ss += y0 * y0 + y1 * y1; }
        }
        ss += __shfl_xor(ss, 16); ss += __shfl_xor(ss, 32);
        if (fq == 0) ssq[row * 32 + u.pn * 4 + wc] = ss;
        asm volatile("" ::: "memory");
      }
    xcd_barrier(*xb);
#pragma unroll
    for (int ai = 0; ai < 2; ++ai)
#pragma unroll
      for (int m = 0; m < 4; ++m) {
        const int row = u.pm * 256 + ai * 128 + wr * 64 + m * 16 + fr;
        const f32x4* sp = (const f32x4*)(ssq + row * 32);
        float tot = 0.f;
#pragma unroll
        for (int q = 0; q < 8; ++q) { const f32x4 t = sp[q]; tot += (t[0] + t[1]) + (t[2] + t[3]); }
        const float rinv = rsqrtf(tot * (1.0f / DM) + EPS);
#pragma unroll
        for (int bj = 0; bj < 2; ++bj) {
          const int col = colw + bj * 128;
          const f32x4 g0 = *(const f32x4*)(fg + col), g1 = *(const f32x4*)(fg + col + 4);
          f32x4 o0, o1;
#pragma unroll
          for (int e = 0; e < 4; ++e) { o0[e] = acc[ai][bj][m][0][e] * rinv * g0[e]; o1[e] = acc[ai][bj][m][1][e] * rinv * g1[e]; }
          float* op = out + (size_t)row * DM + col;
          __builtin_nontemporal_store(o0, (f32x4*)op); __builtin_nontemporal_store(o1, (f32x4*)(op + 4));
        }
        asm volatile("" ::: "memory");
      }
  }
};
struct SchedOne {
  int b;
  __device__ __forceinline__ bool next(int i, pg8::Unit& u) const { if (i >= 1) return false; u.pm = b & 31; u.pn = b >> 5; return true; }
  __device__ __forceinline__ void a_ready(const pg8::Unit&) const {}
  __device__ __forceinline__ void done(const pg8::Unit&) const {}
};
__device__ __forceinline__ void phase_gemm3_final(const Params& p, char* lds, const XcdBarrier& xb) {
  pg8::Gemm g{p.merged, p.woT, MTOK, DM, DM};
  SchedOne S{(int)blockIdx.x}; EpiG3 E{p.x, p.out, p.ssq, p.final_g, &xb};
  pg8::gemm_phase<EpiG3, SchedOne, false, true>((LAS unsigned char*)lds, g, S, E);
}

constexpr int KVBLK = 64;
constexpr size_t SHM_V = KVBLK * 128 * 2, SHM_K = KVBLK * 128 * 2;
constexpr int ATT_TILE = 32768, ATT_WS = 131072 + 64;
constexpr float THR = 8.f;
#define KSWZ(row, colB) ((row) * 256 + ((colB) ^ (((row) & 7) << 4)))

template <int DQK> struct AttnC { static constexpr float SCALE = (DQK == 64) ? 0.125f : 0.088388347648318440f; };

template <int DQK>
__device__ __forceinline__ void partialSM(f32x16& p0, f32x16& p1, float& m_reg, float& mn, float& alpha) {
  constexpr float SCALE = AttnC<DQK>::SCALE;
  constexpr float C = SCALE * 1.4426950408889634f;
  float pmax = p0[0];
#pragma unroll
  for (int r = 1; r < 16; ++r) pmax = fmaxf(pmax, p0[r]);
#pragma unroll
  for (int r = 0; r < 16; ++r) pmax = fmaxf(pmax, p1[r]);
  { auto rr = __builtin_amdgcn_permlane32_swap(__float_as_uint(pmax), __float_as_uint(pmax), false, false);
    pmax = fmaxf(__uint_as_float(rr[0]), __uint_as_float(rr[1])); }
  if (__builtin_expect(__all(pmax - m_reg <= THR / SCALE), 1)) { mn = m_reg; alpha = 1.f; }
  else { mn = fmaxf(m_reg, pmax); alpha = __builtin_amdgcn_exp2f((m_reg - mn) * C); m_reg = mn; }
  const float mnC = -mn * C;
#pragma unroll
  for (int r = 0; r < 16; ++r) p0[r] = fmaf(p0[r], C, mnC);
#pragma unroll
  for (int r = 0; r < 16; ++r) p1[r] = fmaf(p1[r], C, mnC);
#pragma unroll
  for (int r = 0; r < 16; ++r) p0[r] = __builtin_amdgcn_exp2f(p0[r]);
}
__device__ __forceinline__ void finishSM(f32x16& p0, f32x16& p1, float alpha, float& l_reg, bf16x8& pa0, bf16x8& pa1, bf16x8& pa2, bf16x8& pa3) {
#pragma unroll
  for (int r = 0; r < 16; ++r) p1[r] = __builtin_amdgcn_exp2f(p1[r]);
  float ps = 0;
#pragma unroll
  for (int r = 0; r < 16; ++r) ps += p0[r];
#pragma unroll
  for (int r = 0; r < 16; ++r) ps += p1[r];
  { auto rr = __builtin_amdgcn_permlane32_swap(__float_as_uint(ps), __float_as_uint(ps), false, false);
    ps = __uint_as_float(rr[0]) + __uint_as_float(rr[1]); }
  l_reg = l_reg * alpha + ps;
#define PK4(P, BASE, OUT) do { unsigned a0 = cvtpk(P[BASE + 0], P[BASE + 1]), a1 = cvtpk(P[BASE + 2], P[BASE + 3]);   \
    unsigned b0 = cvtpk(P[BASE + 4], P[BASE + 5]), b1 = cvtpk(P[BASE + 6], P[BASE + 7]);                              \
    auto r0 = __builtin_amdgcn_permlane32_swap(a0, b0, false, false); auto r1 = __builtin_amdgcn_permlane32_swap(a1, b1, false, false); \
    u32x4 w = {r0[0], r1[0], r0[1], r1[1]}; OUT = *reinterpret_cast<bf16x8*>(&w); } while (0)
  PK4(p0, 0, pa0); PK4(p0, 8, pa1); PK4(p1, 0, pa2); PK4(p1, 8, pa3);
#undef PK4
}
template <int DQK>
__device__ __forceinline__ void qkt(f32x16& p0, f32x16& p1, const LAS char* Ks, const bf16x8* qr, int r32, int hi) {
  constexpr int PITCH = DQK * 2;
  const int sw = (DQK == 128) ? (r32 & 7) : ((r32 >> 1) & 7);
  p0 = f32x16{}; p1 = f32x16{};
#pragma unroll
  for (int d0 = 0; d0 < DQK / 16; ++d0) { const int co = ((d0 * 2 + hi) ^ sw) << 4;
    bf16x8 b0 = *reinterpret_cast<const LAS bf16x8*>(Ks + r32 * PITCH + co);
    bf16x8 b1 = *reinterpret_cast<const LAS bf16x8*>(Ks + (32 + r32) * PITCH + co);
    p0 = __builtin_amdgcn_mfma_f32_32x32x16_bf16(b0, qr[d0], p0, 0, 0, 0);
    p1 = __builtin_amdgcn_mfma_f32_32x32x16_bf16(b1, qr[d0], p1, 0, 0, 0); }
}
__device__ __forceinline__ int v_st(int k, int c) { const int kk = (k & ~0xC) | ((k & 4) << 1) | ((k & 8) >> 1); return ((kk >> 3) * 4 + (c >> 5)) * 512 + ((kk & 7) * 32 + (c & 31)) * 2; }
__device__ __forceinline__ int v_rd_base(int lane) { return ((lane & 3) << 3) | (((lane >> 2) & 3) << 6) | (((lane >> 4) & 1) << 5) | (((lane >> 5) & 1) << 8); }
constexpr int v_rd_off(int d0, int ks, int half) { return d0 * 512 + ks * 4096 + half * 2048; }
template <int OFF> __device__ __forceinline__ s16x4 tr_read(int vb) {
  s16x4 r; asm volatile("ds_read_b64_tr_b16 %0, %1 offset:%2" : "=&v"(r) : "v"(vb), "i"(OFF) : "memory"); return r;
}
template <int D0> __device__ __forceinline__ void pv_one(f32x16& od, int vb, bf16x8 pa0, bf16x8 pa1, bf16x8 pa2, bf16x8 pa3) {
  const s16x4 l0 = tr_read<v_rd_off(D0, 0, 0)>(vb), h0 = tr_read<v_rd_off(D0, 0, 1)>(vb), l1 = tr_read<v_rd_off(D0, 1, 0)>(vb), h1 = tr_read<v_rd_off(D0, 1, 1)>(vb);
  const s16x4 l2 = tr_read<v_rd_off(D0, 2, 0)>(vb), h2 = tr_read<v_rd_off(D0, 2, 1)>(vb), l3 = tr_read<v_rd_off(D0, 3, 0)>(vb), h3 = tr_read<v_rd_off(D0, 3, 1)>(vb);
  asm volatile("s_waitcnt lgkmcnt(0)" ::: "memory"); SBAR();
#define PK(L, H) (bf16x8){L[0], L[1], L[2], L[3], H[0], H[1], H[2], H[3]}
  od = __builtin_amdgcn_mfma_f32_32x32x16_bf16(pa0, PK(l0, h0), od, 0, 0, 0);
  od = __builtin_amdgcn_mfma_f32_32x32x16_bf16(pa1, PK(l1, h1), od, 0, 0, 0);
  od = __builtin_amdgcn_mfma_f32_32x32x16_bf16(pa2, PK(l2, h2), od, 0, 0, 0);
  od = __builtin_amdgcn_mfma_f32_32x32x16_bf16(pa3, PK(l3, h3), od, 0, 0, 0);
#undef PK
}
template <int DQK, class ISS>
__device__ __forceinline__ void pv_sm(f32x16 (&o)[4], int vb, bf16x8 pa0, bf16x8 pa1, bf16x8 pa2, bf16x8 pa3,
                                      f32x16& p0, f32x16& p1, float& m_reg, float& mn, float& alpha, const ISS& iss) {
  constexpr float SCALE = AttnC<DQK>::SCALE;
  constexpr float C = SCALE * 1.4426950408889634f;
#define PK(L, H) (bf16x8){L[0], L[1], L[2], L[3], H[0], H[1], H[2], H[3]}
#define PV_READS(D0) const s16x4 l0 = tr_read<v_rd_off(D0, 0, 0)>(vb), h0 = tr_read<v_rd_off(D0, 0, 1)>(vb), l1 = tr_read<v_rd_off(D0, 1, 0)>(vb), h1 = tr_read<v_rd_off(D0, 1, 1)>(vb); \
    const s16x4 l2 = tr_read<v_rd_off(D0, 2, 0)>(vb), h2 = tr_read<v_rd_off(D0, 2, 1)>(vb), l3 = tr_read<v_rd_off(D0, 3, 0)>(vb), h3 = tr_read<v_rd_off(D0, 3, 1)>(vb); \
    asm volatile("s_waitcnt lgkmcnt(0)" ::: "memory"); SBAR();
#define PV_MMA(D0) o[D0] = __builtin_amdgcn_mfma_f32_32x32x16_bf16(pa0, PK(l0, h0), o[D0], 0, 0, 0); o[D0] = __builtin_amdgcn_mfma_f32_32x32x16_bf16(pa1, PK(l1, h1), o[D0], 0, 0, 0); \
    o[D0] = __builtin_amdgcn_mfma_f32_32x32x16_bf16(pa2, PK(l2, h2), o[D0], 0, 0, 0); o[D0] = __builtin_amdgcn_mfma_f32_32x32x16_bf16(pa3, PK(l3, h3), o[D0], 0, 0, 0);
  float pmax, mnC;
  { PV_READS(0)
    iss(0);
    pmax = p0[0];
#pragma unroll
    for (int r = 1; r < 16; ++r) pmax = fmaxf(pmax, p0[r]);
    PV_MMA(0) }
  { PV_READS(1)
    iss(1);
#pragma unroll
    for (int r = 0; r < 16; ++r) pmax = fmaxf(pmax, p1[r]);
    { auto rr = __builtin_amdgcn_permlane32_swap(__float_as_uint(pmax), __float_as_uint(pmax), false, false);
      pmax = fmaxf(__uint_as_float(rr[0]), __uint_as_float(rr[1])); }
    const bool keep = __all(pmax - m_reg <= THR / SCALE);
    mn = keep ? m_reg : fmaxf(m_reg, pmax);
    alpha = __builtin_amdgcn_exp2f((m_reg - mn) * C);
    m_reg = mn; mnC = -mn * C;
    PV_MMA(1) }
  { PV_READS(2)
    iss(2);
#pragma unroll
    for (int r = 0; r < 16; ++r) p0[r] = fmaf(p0[r], C, mnC);
#pragma unroll
    for (int r = 0; r < 16; ++r) p1[r] = fmaf(p1[r], C, mnC);
    PV_MMA(2) }
  { PV_READS(3)
    iss(3);
#pragma unroll
    for (int r = 0; r < 16; ++r) p0[r] = __builtin_amdgcn_exp2f(p0[r]);
    PV_MMA(3) }
#undef PK
#undef PV_READS
#undef PV_MMA
}
__device__ __forceinline__ void pv_d0(f32x16 (&o)[4], int vb, bf16x8 pa0, bf16x8 pa1, bf16x8 pa2, bf16x8 pa3) {
  pv_one<0>(o[0], vb, pa0, pa1, pa2, pa3); pv_one<1>(o[1], vb, pa0, pa1, pa2, pa3); pv_one<2>(o[2], vb, pa0, pa1, pa2, pa3); pv_one<3>(o[3], vb, pa0, pa1, pa2, pa3);
}

template <int DQK>
__device__ __forceinline__ void attn_body(const bf16_t* __restrict__ Qb, const bf16_t* __restrict__ Kh, const bf16_t* __restrict__ Vh,
                                          char* lds, f32x16 (&o)[4], float& l_out) {
  constexpr int LD = CT;
  constexpr int NQ = DQK / 16, PK = DQK / 64, P = 2 + PK;
  const int tid = threadIdx.x, wid = __builtin_amdgcn_readfirstlane(tid >> 6), lane = tid & 63, r32 = lane & 31, hi = lane >> 5;
  LAS char* ldsl = (LAS char*)lds;
  float* ws = (float*)(lds + ATT_WS) + wid * 64; float* al_l = ws + 32;
  float m_reg = -1e30f, l_reg = 0;
#pragma unroll
  for (int d = 0; d < 4; ++d) o[d] = f32x16{};
  bf16x8 qr[NQ];
  const bf16_t* Qw = Qb + (size_t)(wid * 32 + r32) * LD + hi * 8;
#pragma unroll
  for (int d0 = 0; d0 < NQ; ++d0) qr[d0] = __builtin_nontemporal_load((const bf16x8*)(Qw + d0 * 16));
  unsigned vgo[2], kgo[2];
#pragma unroll
  for (int i = 0; i < 2; ++i) {
    const int kk = (i * 4 + (tid >> 7)) * 8 + ((tid & 31) >> 2), c = ((tid >> 5) & 3) * 32 + (tid & 3) * 8;
    const int k = (kk & ~0xC) | ((kk & 4) << 1) | ((kk & 8) >> 1);
    vgo[i] = (unsigned)(k * LD + c) * 2u;
    if (DQK == 128) { const int row = i * 32 + (tid >> 4), lc = (tid & 15) ^ (row & 7); kgo[i] = (unsigned)(row * LD + lc * 8) * 2u; }
    else { const int row = tid >> 3, lc = (tid & 7) ^ ((row >> 1) & 7); kgo[i] = (unsigned)(row * LD + lc * 8) * 2u; }
  }
  const char* Vb = (const char*)Vh; const char* Kb = (const char*)Kh;
#define A_ISSUE(t_) do { const size_t ko_ = (size_t)(t_) * (KVBLK * LD * 2); LAS char* bb_ = ldsl + ((t_) & 3) * ATT_TILE + wid * 1024; \
    __builtin_amdgcn_global_load_lds((const unsigned*)(Vb + ko_ + vgo[0]), (LAS unsigned*)(bb_), 16, 0, 0); \
    __builtin_amdgcn_global_load_lds((const unsigned*)(Vb + ko_ + vgo[1]), (LAS unsigned*)(bb_ + 8192), 16, 0, 0); \
    __builtin_amdgcn_global_load_lds((const unsigned*)(Kb + ko_ + kgo[0]), (LAS unsigned*)(bb_ + 16384), 16, 0, 0); \
    if constexpr (DQK == 128) __builtin_amdgcn_global_load_lds((const unsigned*)(Kb + ko_ + kgo[1]), (LAS unsigned*)(bb_ + 16384 + 8192), 16, 0, 0); } while (0)
  auto a_piece = [&](int t_, int j_) {
    const size_t ko_ = (size_t)t_ * (KVBLK * LD * 2); LAS char* bb_ = ldsl + (t_ & 3) * ATT_TILE + wid * 1024;
    if (j_ == 0) __builtin_amdgcn_global_load_lds((const unsigned*)(Vb + ko_ + vgo[0]), (LAS unsigned*)(bb_), 16, 0, 0);
    else if (j_ == 1) __builtin_amdgcn_global_load_lds((const unsigned*)(Vb + ko_ + vgo[1]), (LAS unsigned*)(bb_ + 8192), 16, 0, 0);
    else if (j_ == 2) __builtin_amdgcn_global_load_lds((const unsigned*)(Kb + ko_ + kgo[0]), (LAS unsigned*)(bb_ + 16384), 16, 0, 0);
    else if (DQK == 128) __builtin_amdgcn_global_load_lds((const unsigned*)(Kb + ko_ + kgo[1]), (LAS unsigned*)(bb_ + 16384 + 8192), 16, 0, 0);
  };
#define A_WAITBAR(N) do { asm volatile("s_waitcnt vmcnt(%0)" :: "n"(N) : "memory"); __builtin_amdgcn_s_barrier(); asm volatile("" ::: "memory"); } while (0)
#define KBUF(t_) ((const LAS char*)(ldsl + ((t_) & 3) * ATT_TILE + 16384))
#define VBUF(t_) ((int)(uintptr_t)(ldsl + ((t_) & 3) * ATT_TILE) + vrb)
#define RESC(a) do { if (__any((a) < 1.f)) { if (hi == 0) al_l[r32] = (a); asm volatile("s_waitcnt lgkmcnt(0)" ::: "memory"); \
    _Pragma("unroll") for (int d = 0; d < 4; ++d) _Pragma("unroll") for (int r = 0; r < 16; ++r) o[d][r] *= al_l[crow(r, hi)]; } } while (0)
  const int vrb = v_rd_base(lane);
  f32x16 pA0, pA1, pB0, pB1; float mnA, mnB, alA, alB; bf16x8 pa0, pa1, pa2, pa3; constexpr int NT = SEQ / KVBLK;
  A_ISSUE(0); A_ISSUE(1);
  A_WAITBAR(P);
  qkt<DQK>(pA0, pA1, KBUF(0), qr, r32, hi); partialSM<DQK>(pA0, pA1, m_reg, mnA, alA);
  A_ISSUE(2);
  A_WAITBAR(P);
  for (int n = 1; n + 1 < NT; n += 2) {
    SBAR(); qkt<DQK>(pB0, pB1, KBUF(n), qr, r32, hi);
    finishSM(pA0, pA1, alA, l_reg, pa0, pa1, pa2, pa3); SBAR();
    pv_sm<DQK>(o, VBUF(n - 1), pa0, pa1, pa2, pa3, pB0, pB1, m_reg, mnB, alB, [&](int j_) { a_piece(n + 2, j_); });
    A_WAITBAR(P);
    RESC(alB);
    SBAR(); qkt<DQK>(pA0, pA1, KBUF(n + 1), qr, r32, hi);
    finishSM(pB0, pB1, alB, l_reg, pa0, pa1, pa2, pa3); SBAR();
    { const bool more_ = (n + 3 < NT); pv_sm<DQK>(o, VBUF(n), pa0, pa1, pa2, pa3, pA0, pA1, m_reg, mnA, alA, [&](int j_) { if (more_) a_piece(n + 3, j_); }); }
    if (n + 3 < NT) A_WAITBAR(P); else A_WAITBAR(0);
    RESC(alA);
  }
  SBAR(); qkt<DQK>(pB0, pB1, KBUF(NT - 1), qr, r32, hi);
  finishSM(pA0, pA1, alA, l_reg, pa0, pa1, pa2, pa3); SBAR();
  pv_sm<DQK>(o, VBUF(NT - 2), pa0, pa1, pa2, pa3, pB0, pB1, m_reg, mnB, alB, [](int) {});
  RESC(alB);
  finishSM(pB0, pB1, alB, l_reg, pa0, pa1, pa2, pa3); SBAR();
  pv_d0(o, VBUF(NT - 1), pa0, pa1, pa2, pa3);
  l_out = l_reg;
#undef A_ISSUE
#undef A_WAITBAR
#undef KBUF
#undef VBUF
#undef RESC
}

__device__ __forceinline__ void attn_rli(float l_reg, char* lds, float (&rli)[16]) {
  const int tid = threadIdx.x, wid = tid >> 6, lane = tid & 63, r32 = lane & 31, hi = lane >> 5;
  float* li_l = (float*)(lds + ATT_WS) + wid * 64;
  if (hi == 0) li_l[r32] = l_reg;
  asm volatile("s_waitcnt lgkmcnt(0)" ::: "memory");
#pragma unroll
  for (int r = 0; r < 16; ++r) rli[r] = __builtin_amdgcn_rcpf(li_l[crow(r, hi)]);
  asm volatile("s_waitcnt lgkmcnt(0)" ::: "memory");
}

constexpr int EPI_RS = 68, EPI_WAVE_BYTES = 32 * EPI_RS * 4;
__device__ __forceinline__ void epi_put_half(const f32x16 (&o)[4], const float (&rli)[16], float* sc, int half, int r32, int hi) {
#pragma unroll
  for (int d0h = 0; d0h < 2; ++d0h)
#pragma unroll
    for (int r = 0; r < 16; ++r) sc[crow(r, hi) * EPI_RS + d0h * 32 + r32] = o[half * 2 + d0h][r] * rli[r];
}
__device__ __forceinline__ void epi_get(const float* sc, int q, int lane, float (&v)[8]) {
  const f32x4* sp = (const f32x4*)(sc + (q * 8 + (lane >> 3)) * EPI_RS + (lane & 7) * 8);
  const f32x4 a = sp[0], bq = sp[1];
  v[0] = a[0]; v[1] = a[1]; v[2] = a[2]; v[3] = a[3]; v[4] = bq[0]; v[5] = bq[1]; v[6] = bq[2]; v[7] = bq[3];
}
__device__ __forceinline__ void unpack8(const u32x4 w, float (&z)[8]) {
#pragma unroll
  for (int i = 0; i < 4; ++i) { z[2 * i] = __uint_as_float(w[i] << 16); z[2 * i + 1] = __uint_as_float(w[i] & 0xffff0000u); }
}

__device__ __forceinline__ void phase_attn(const Params& p, char* lds) {
  const int tid = threadIdx.x, wid = tid >> 6, lane = tid & 63;
  float* sc = (float*)(lds + wid * EPI_WAVE_BYTES);
  for (int it = blockIdx.x; it < 512; it += gridDim.x) {
    const int j = it & 255, xcd = j & 7, slot = j >> 3;
    const int bh = xcd * 2 + (slot >> 4), qblk = slot & 15;
    const int b = bh >> 3, h = bh & 7;
    const size_t tok0 = (size_t)b * SEQ;
    const size_t rowq = tok0 + qblk * 256;
    const int rowbase = (int)rowq + wid * 32;
    f32x16 o[4]; float l_reg; float rli[16];
    if (it < 256) {
      const int kvh = h >> 2;
      attn_body<128>(p.proj + rowq * CT + C_QB + h * 128, p.proj + tok0 * CT + C_KB + kvh * 128, p.proj + tok0 * CT + C_VB + kvh * 128, lds, o, l_reg);
      attn_rli(l_reg, lds, rli);
      __syncthreads();
      const int l2 = launder(lane), r32 = l2 & 31, hi = l2 >> 5;
#pragma unroll
      for (int half = 0; half < 2; ++half) {
        epi_put_half(o, rli, sc, half, r32, hi);
#pragma unroll
        for (int q = 0; q < 4; ++q) {
          float v[8], z[8]; epi_get(sc, q, l2, v);
          const size_t row = (size_t)(rowbase + q * 8 + (l2 >> 3)); const int col = h * 128 + half * 64 + (l2 & 7) * 8;
          unpack8(__builtin_nontemporal_load((const u32x4*)(p.proj + row * CT + C_ZB + col)), z);
          u32x4 w; w[0] = cvtpk(v[0] * z[0], v[1] * z[1]); w[1] = cvtpk(v[2] * z[2], v[3] * z[3]); w[2] = cvtpk(v[4] * z[4], v[5] * z[5]); w[3] = cvtpk(v[6] * z[6], v[7] * z[7]);
          *(u32x4*)(p.U + (size_t)MTOK * BW + row * BW + (col - h * 128) + h * 128) = w;
        }
      }
    } else {
      const bf16_t* Vp = p.proj + tok0 * CT + C_VA + h * 128;
      attn_body<64>(p.proj + rowq * CT + C_QA + h * 128, p.proj + tok0 * CT + C_KA + h * 128, Vp, lds, o, l_reg);
      attn_rli(l_reg, lds, rli);
      float* o1w = p.o1 + ((size_t)(rowbase >> 5) * 8 + h) * 4096 + launder(lane) * 4;
#pragma unroll
      for (int d0 = 0; d0 < 4; ++d0)
#pragma unroll
        for (int gq = 0; gq < 4; ++gq) {
          f32x4 v4; v4[0] = o[d0][4 * gq + 0] * rli[4 * gq + 0]; v4[1] = o[d0][4 * gq + 1] * rli[4 * gq + 1]; v4[2] = o[d0][4 * gq + 2] * rli[4 * gq + 2]; v4[3] = o[d0][4 * gq + 3] * rli[4 * gq + 3];
          *(f32x4*)(o1w + (d0 * 4 + gq) * 256) = v4;
        }
      asm volatile("" ::: "memory");
      attn_body<64>(p.proj + rowq * CT + C_QA + h * 128 + 64, p.proj + tok0 * CT + C_KA + h * 128 + 64, Vp, lds, o, l_reg);
      attn_rli(l_reg, lds, rli);
      __syncthreads();
      const int l2 = launder(lane), r32 = l2 & 31, hi = l2 >> 5;
      float d1 = 0.f, d2 = 0.f;
      for (int i = 0; i < 64; ++i) { d1 += p.lq1[i] * p.lk1[i]; d2 += p.lq2[i] * p.lk2[i]; }
      const float lam = __expf(d1) - __expf(d2) + 0.2f;
      {
        const float* o1r = p.o1 + ((size_t)(rowbase >> 5) * 8 + h) * 4096 + l2 * 4;
#pragma unroll
        for (int d0 = 0; d0 < 4; ++d0)
#pragma unroll
          for (int gq = 0; gq < 4; ++gq) {
            const f32x4 v4 = *(const f32x4*)(o1r + (d0 * 4 + gq) * 256);
#pragma unroll
            for (int e = 0; e < 4; ++e) o[d0][4 * gq + e] = v4[e] - lam * (o[d0][4 * gq + e] * rli[4 * gq + e]);
          }
#pragma unroll
        for (int r = 0; r < 16; ++r) rli[r] = 1.f;
      }
      float t[2][4][8]; float ss[4] = {0.f, 0.f, 0.f, 0.f};
#pragma unroll
      for (int half = 0; half < 2; ++half) {
        epi_put_half(o, rli, sc, half, r32, hi);
#pragma unroll
        for (int q = 0; q < 4; ++q) {
          float v[8]; epi_get(sc, q, l2, v);
#pragma unroll
          for (int e = 0; e < 8; ++e) { const float tv = v[e]; t[half][q][e] = tv; ss[q] += tv * tv; }
        }
      }
      float rinv[4];
#pragma unroll
      for (int q = 0; q < 4; ++q) { float x = ss[q]; x += __shfl_xor(x, 1); x += __shfl_xor(x, 2); x += __shfl_xor(x, 4); rinv[q] = rsqrtf(x * (1.0f / 128.0f) + EPS) * 0.8f; }
#pragma unroll
      for (int half = 0; half < 2; ++half) {
        const int colh = half * 64 + (l2 & 7) * 8;
        const f32x4 g0 = *(const f32x4*)(p.subln_g + colh), g1 = *(const f32x4*)(p.subln_g + colh + 4);
        const float sg[8] = {g0[0], g0[1], g0[2], g0[3], g1[0], g1[1], g1[2], g1[3]};
#pragma unroll
        for (int q = 0; q < 4; ++q) {
          const size_t row = (size_t)(rowbase + q * 8 + (l2 >> 3)); const int col = h * 128 + colh;
          float z[8]; unpack8(__builtin_nontemporal_load((const u32x4*)(p.proj + row * CT + C_ZA + col)), z);
          float ov[8];
#pragma unroll
          for (int e = 0; e < 8; ++e) ov[e] = t[half][q][e] * rinv[q] * sg[e] * z[e];
          u32x4 w; w[0] = cvtpk(ov[0], ov[1]); w[1] = cvtpk(ov[2], ov[3]); w[2] = cvtpk(ov[4], ov[5]); w[3] = cvtpk(ov[6], ov[7]);
          *(u32x4*)(p.U + row * BW + col) = w;
        }
      }
    }
    __syncthreads();
  }
}

__global__ void __launch_bounds__(512) mega(Params p) {
  extern __shared__ __attribute__((aligned(16))) char lds[];
  cg::grid_group grid = cg::this_grid();
  if (p.phase_lo < 0) grid.sync();
  volatile LAS unsigned* xst = (volatile LAS unsigned*)((LAS char*)lds + 131072);
  if (threadIdx.x < 4) xst[threadIdx.x] = 0u;
  __syncthreads();
  XcdBarrier xb = xcd_barrier_post(p.bar, xst);
  const int hi = p.phase_hi;
  if (hi >= 0) phase_prologue(p, lds);
  xcd_barrier(xb);
  if (hi >= 1) phase_gemm1(p, lds);
  xcd_barrier(xb);
  if (hi >= 2) phase_attn(p, lds);
  xcd_barrier(xb);
  if (hi >= 3) phase_gemm2(p, lds);
  xcd_barrier(xb);
  if (hi >= 4) phase_gemm3_final(p, lds, xb);
}

extern "C" void kernel_launch(void* const* d_in, const int* in_sizes, int n_in, void* d_out, int out_size, void* d_ws, size_t ws_size, hipStream_t stream) {
  static int grid_blocks = 0;
  if (!grid_blocks) {
    hipFuncSetAttribute((const void*)mega, hipFuncAttributeMaxDynamicSharedMemorySize, LDS_BYTES);
    int dev = 0, cus = 0, per_cu = 0;
    hipGetDevice(&dev);
    hipDeviceGetAttribute(&cus, hipDeviceAttributeMultiprocessorCount, dev);
    hipOccupancyMaxActiveBlocksPerMultiprocessor(&per_cu, mega, 512, LDS_BYTES);
    if (per_cu < 1) { fprintf(stderr, "occupancy query returned %d\n", per_cu); per_cu = 1; }
    grid_blocks = cus * per_cu;
    if (grid_blocks > 256) grid_blocks = 256;
    if (grid_blocks != 256) fprintf(stderr, "unexpected grid %d (need 256)\n", grid_blocks);
  }
  Params p{};
  p.x = (const float*)d_in[0]; p.norm_g = (const float*)d_in[1]; p.w_in = (const float*)d_in[2];
  p.lq1 = (const float*)d_in[3]; p.lk1 = (const float*)d_in[4]; p.lq2 = (const float*)d_in[5]; p.lk2 = (const float*)d_in[6];
  p.subln_g = (const float*)d_in[7]; p.qn_g = (const float*)d_in[8]; p.kn_g = (const float*)d_in[9];
  p.w_out_a = (const float*)d_in[10]; p.w_out_b = (const float*)d_in[11]; p.w_o = (const float*)d_in[12]; p.final_g = (const float*)d_in[13];
  p.out = (float*)d_out;
  char* w = (char*)d_ws; size_t off = 0;
  auto take = [&](size_t bytes) { char* r = w + off; off += (bytes + 255) & ~(size_t)255; return r; };
  p.h      = (bf16_t*)take((size_t)MTOK * DM * 2);
  p.o1     = (float*)p.h;
  p.merged = (bf16_t*)p.h;
  p.winT   = (bf16_t*)take((size_t)CT * DM * 2);
  p.waT    = (bf16_t*)take((size_t)DM * BW * 2);
  p.wbT    = (bf16_t*)take((size_t)DM * BW * 2);
  p.woT    = (bf16_t*)take((size_t)DM * DM * 2);
  p.proj   = (bf16_t*)take((size_t)MTOK * CT * 2);
  p.U      = (bf16_t*)d_out;
  p.gbuf   = (bf16_t*)take((size_t)2 * MTOK * DM * 2);
  p.rope   = (float2*)take((size_t)SEQ * 32 * 8);
  p.ssq    = (float*)take((size_t)MTOK * 32 * 4);
  p.bar    = (unsigned*)take(XCD_BAR_WORDS * 4);
  if (off > ws_size) { fprintf(stderr, "workspace too small: need %zu have %zu\n", off, ws_size); return; }
  if (grid_blocks != 256) return;
  p.phase_lo = 0; p.phase_hi = 5;
  hipMemsetAsync(p.bar, 0, XCD_BAR_WORDS * 4, stream);
  void* args[] = {&p};
  hipError_t e = hipLaunchCooperativeKernel((void*)mega, dim3(grid_blocks), dim3(512), args, LDS_BYTES, stream);
  if (e != hipSuccess) fprintf(stderr, "cooperative launch failed: %s (grid %d)\n", hipGetErrorString(e), grid_blocks);
}
```

```cpp
#include <hip/hip_runtime.h>
#include <hip/hip_cooperative_groups.h>
#include <cstdio>
#include <cstdint>
namespace cg = cooperative_groups;

#ifndef MK_LAUNCHES
#define MK_LAUNCHES 1
#endif

typedef unsigned short bf16_t;
using bf16x8 = __attribute__((ext_vector_type(8))) short;
using s16x4  = __attribute__((ext_vector_type(4))) short;
using f32x16 = __attribute__((ext_vector_type(16))) float;
using f32x4  = __attribute__((ext_vector_type(4))) float;
using u32x4  = __attribute__((ext_vector_type(4))) unsigned;
using u32x2  = __attribute__((ext_vector_type(2))) unsigned;

constexpr int MTOK = 8192, SEQ = 4096, DM = 2048, CT = 10752, BW = 1024;
constexpr int C_QA = 0, C_KA = 1024, C_VA = 2048, C_ZA = 3072, C_QB = 4096, C_KB = 5120, C_VB = 5376, C_ZB = 5632, C_GA = 6656, C_GB = 8704;
constexpr float EPS = 1e-6f;
constexpr int LDS_BYTES = 131072 + 64 + 4096 + 8704;

struct Params {
  const float *x, *norm_g, *w_in, *lq1, *lk1, *lq2, *lk2, *subln_g, *qn_g, *kn_g, *w_out_a, *w_out_b, *w_o, *final_g;
  float* out;
  bf16_t *h, *winT, *waT, *wbT, *woT, *proj, *U, *merged;
  float* o1;
  float2* rope;
  float* ssq;
  unsigned* bar;
  bf16_t* gbuf;
  void* pad0;
  int phase_lo, phase_hi;
};

#define SBAR() __builtin_amdgcn_sched_barrier(0)
#define LAS __attribute__((address_space(3)))
__device__ __forceinline__ int crow(int r, int hi) { return (r & 3) + 8 * (r >> 2) + 4 * hi; }
__device__ __forceinline__ unsigned cvtpk(float lo, float hi) {
  unsigned r; asm volatile("s_nop 0\n\tv_cvt_pk_bf16_f32 %0, %1, %2" : "=v"(r) : "v"(lo), "v"(hi)); return r;
}
__device__ __forceinline__ float bf2f(bf16_t v) { return __uint_as_float(((unsigned)v) << 16); }
__device__ __forceinline__ bf16_t f2bf(float f) { return (bf16_t)(cvtpk(f, f) & 0xffffu); }
__device__ __forceinline__ float sigmoidf_(float v) { return __builtin_amdgcn_rcpf(1.f + __expf(-v)); }

__device__ __forceinline__ void transpose_cvt_strip(const float* __restrict__ W, bf16_t* __restrict__ Wt, int K, int N, int strip, float* tl) {
  const int tid = threadIdx.x;
  const int nsn = N >> 7;
  const int n0 = (strip % nsn) * 128, k0 = (strip / nsn) * 64;
  const int r = tid >> 5, c4 = (tid & 31) * 4;
  f32x4 v[4];
#pragma unroll
  for (int j = 0; j < 4; ++j) v[j] = __builtin_nontemporal_load((const f32x4*)(W + (size_t)(k0 + r + 16 * j) * N + n0 + c4));
#pragma unroll
  for (int j = 0; j < 4; ++j) { float* d = tl + (r + 16 * j) * 129 + c4; d[0] = v[j][0]; d[1] = v[j][1]; d[2] = v[j][2]; d[3] = v[j][3]; }
  __syncthreads();
#pragma unroll
  for (int i = 0; i < 2; ++i) {
    const int id = tid + 512 * i, n = id >> 3, kc = (id & 7) * 8;
    u32x4 w;
    w[0] = cvtpk(tl[(kc + 0) * 129 + n], tl[(kc + 1) * 129 + n]);
    w[1] = cvtpk(tl[(kc + 2) * 129 + n], tl[(kc + 3) * 129 + n]);
    w[2] = cvtpk(tl[(kc + 4) * 129 + n], tl[(kc + 5) * 129 + n]);
    w[3] = cvtpk(tl[(kc + 6) * 129 + n], tl[(kc + 7) * 129 + n]);
    *(u32x4*)(Wt + (size_t)(n0 + n) * K + k0 + kc) = w;
  }
  __syncthreads();
}
__device__ __forceinline__ void transpose_late_weights(const Params& p, char* lds, int worker, int nworkers) {
  float* tl = (float*)lds;
  constexpr int S_OA = (BW / 64) * (DM / 128), S_WO = (DM / 64) * (DM / 128);
  for (int t = worker; t < 2 * S_OA + S_WO; t += nworkers) {
    if (t < S_OA) transpose_cvt_strip(p.w_out_a, p.waT, BW, DM, t, tl);
    else if (t < 2 * S_OA) transpose_cvt_strip(p.w_out_b, p.wbT, BW, DM, t - S_OA, tl);
    else transpose_cvt_strip(p.w_o, p.woT, DM, DM, t - 2 * S_OA, tl);
  }
}

__device__ __forceinline__ void phase_prologue(const Params& p, char* lds) {
  const int tid = threadIdx.x, wid = tid >> 6, lane = tid & 63;
  for (int i = blockIdx.x * 512 + tid; i < SEQ * 32; i += gridDim.x * 512) {
    const int pos = i >> 5, f = i & 31;
    const float inv = 1.0f / exp2f((float)f * (13.287712379549449f / 32.0f));
    const float ang = (float)pos * inv;
    const double rev = (double)ang * 0.15915494309189535;
    const float fr = (float)(rev - rint(rev));
    float2 cs; cs.x = __builtin_amdgcn_cosf(fr); cs.y = __builtin_amdgcn_sinf(fr);
    p.rope[i] = cs;
  }
  for (int row = blockIdx.x * 8 + wid; row < MTOK; row += gridDim.x * 8) {
    const float* xr = p.x + (size_t)row * DM;
    f32x4 v[8]; float ss = 0.f;
#pragma unroll
    for (int j = 0; j < 8; ++j) { v[j] = __builtin_nontemporal_load((const f32x4*)(xr + j * 256 + lane * 4)); ss += v[j][0] * v[j][0] + v[j][1] * v[j][1] + v[j][2] * v[j][2] + v[j][3] * v[j][3]; }
#pragma unroll
    for (int m = 1; m < 64; m <<= 1) ss += __shfl_xor(ss, m);
    const float rinv = rsqrtf(ss * (1.0f / DM) + EPS);
    bf16_t* hr = p.h + (size_t)row * DM;
#pragma unroll
    for (int j = 0; j < 8; ++j) {
      const f32x4 g = *(const f32x4*)(p.norm_g + j * 256 + lane * 4);
      u32x2 w; w[0] = cvtpk(v[j][0] * rinv * g[0], v[j][1] * rinv * g[1]); w[1] = cvtpk(v[j][2] * rinv * g[2], v[j][3] * rinv * g[3]);
      *(u32x2*)(hr + j * 256 + lane * 4) = w;
    }
  }
  float* tl = (float*)lds;
  constexpr int S_IN = (DM / 64) * (CT / 128);
  for (int t = blockIdx.x; t < S_IN; t += gridDim.x) transpose_cvt_strip(p.w_in, p.winT, DM, CT, t, tl);
}

template <int NI>
__device__ __forceinline__ void gemm_prefetch(const bf16_t* __restrict__ A, int lda, const bf16_t* __restrict__ Bt, int ldb, char* lds_) {
  constexpr int BN = NI * 64, NPB = BN / 128;
  constexpr int SA = 256 * 64, SB = BN * 64, STG = SA + SB;
  LAS char* lds = (LAS char*)lds_;
  const int tid = threadIdx.x, wid = __builtin_amdgcn_readfirstlane(tid >> 6);
  const int rowq = tid >> 2, lc = (tid & 3) ^ ((tid >> 4) & 3);
  const unsigned goA = (unsigned)(rowq * lda + lc * 8) * 2u, goB = (unsigned)(rowq * ldb + lc * 8) * 2u;
  const char* Ab0 = (const char*)A; const char* Bb0 = (const char*)Bt;
#pragma unroll
  for (int kt = 0; kt < 2; ++kt) {
    LAS char* sb_ = lds + kt * STG + wid * 1024;
#pragma unroll
    for (int i_ = 0; i_ < 2; ++i_) __builtin_amdgcn_global_load_lds((const unsigned*)(Ab0 + (size_t)kt * 64 + (size_t)(128 * i_) * lda * 2 + goA), (LAS unsigned*)(sb_ + i_ * 8192), 16, 0, 0);
#pragma unroll
    for (int i_ = 0; i_ < NPB; ++i_) __builtin_amdgcn_global_load_lds((const unsigned*)(Bb0 + (size_t)kt * 64 + (size_t)(128 * i_) * ldb * 2 + goB), (LAS unsigned*)(sb_ + SA + i_ * 8192), 16, 0, 0);
  }
}
template <int NI, bool PRE = false>
__device__ __forceinline__ void gemm_mainloop(const bf16_t* __restrict__ A, int lda, const bf16_t* __restrict__ Bt, int ldb, int K,
                                              f32x16 (&acc)[2][NI], char* lds_) {
  constexpr int BN = NI * 64, NPB = BN / 128;
  constexpr int SA = 256 * 64, SB = BN * 64, STG = SA + SB;
  constexpr int P = 2 + NPB;
  LAS char* lds = (LAS char*)lds_;
  const int tid = threadIdx.x, wid = __builtin_amdgcn_readfirstlane(tid >> 6), lane = tid & 63, r32 = lane & 31, hi = lane >> 5, wm = wid >> 1, wn = wid & 1;
  const int rowq = tid >> 2, lc = (tid & 3) ^ ((tid >> 4) & 3);
  const unsigned goA = (unsigned)(rowq * lda + lc * 8) * 2u, goB = (unsigned)(rowq * ldb + lc * 8) * 2u;
  const char* Ab0 = (const char*)A; const char* Bb0 = (const char*)Bt;
  const int nt = K >> 5;
#define G_ISSUE(kt_) do { const int st_ = (kt_) & 3; const char* An_ = Ab0 + (size_t)(kt_) * 64; const char* Bn_ = Bb0 + (size_t)(kt_) * 64; \
    LAS char* sb_ = lds + st_ * STG + wid * 1024; \
    _Pragma("unroll") for (int i_ = 0; i_ < 2; ++i_) __builtin_amdgcn_global_load_lds((const unsigned*)(An_ + (size_t)(128 * i_) * lda * 2 + goA), (LAS unsigned*)(sb_ + i_ * 8192), 16, 0, 0); \
    _Pragma("unroll") for (int i_ = 0; i_ < NPB; ++i_) __builtin_amdgcn_global_load_lds((const unsigned*)(Bn_ + (size_t)(128 * i_) * ldb * 2 + goB), (LAS unsigned*)(sb_ + SA + i_ * 8192), 16, 0, 0); } while (0)
#define G_PIECE(kt_, j_) do { const int st_ = (kt_) & 3; LAS char* sb_ = lds + st_ * STG + wid * 1024; \
    if ((j_) < 2) __builtin_amdgcn_global_load_lds((const unsigned*)(Ab0 + (size_t)(kt_) * 64 + (size_t)(128 * (j_)) * lda * 2 + goA), (LAS unsigned*)(sb_ + (j_) * 8192), 16, 0, 0); \
    else __builtin_amdgcn_global_load_lds((const unsigned*)(Bb0 + (size_t)(kt_) * 64 + (size_t)(128 * ((j_) - 2)) * ldb * 2 + goB), (LAS unsigned*)(sb_ + SA + ((j_) - 2) * 8192), 16, 0, 0); } while (0)
  if (!PRE) { asm volatile("s_waitcnt vmcnt(0)" ::: "memory"); G_ISSUE(0); G_ISSUE(1); }
  const int sw = (r32 >> 2) & 3;
  const int co0 = (hi ^ sw) << 4;
  const int aoff = (wm * 64 + r32) * 64, boff = SA + (wn * (BN / 2) + r32) * 64;
  constexpr int STEP = (2 * NI) / P;
#define DSR(dst, addr, OFF) asm volatile("ds_read_b128 %0, %1 offset:%2" : "=&v"(dst) : "v"(addr), "i"(OFF) : "memory")
#define DSR_SET(F, pa, pb) do { DSR(F.a[0], pa, 0); DSR(F.a[1], pa, 2048); _Pragma("unroll") for (int ni_ = 0; ni_ < NI; ++ni_) DSR(F.b[ni_], pb, ni_ * 2048); } while (0)
#define MMA_SET(F, KT_ISSUE) do { _Pragma("unroll") for (int mi_ = 0; mi_ < 2; ++mi_) _Pragma("unroll") for (int ni_ = 0; ni_ < NI; ++ni_) { \
      acc[mi_][ni_] = __builtin_amdgcn_mfma_f32_32x32x16_bf16(F.b[ni_], F.a[mi_], acc[mi_][ni_], 0, 0, 0); \
      const int idx_ = mi_ * NI + ni_; \
      if ((KT_ISSUE) >= 0 && (idx_ + 1) % STEP == 0 && (idx_ + 1) / STEP - 1 < P) { SBAR(); if (issue) G_PIECE((KT_ISSUE), (idx_ + 1) / STEP - 1); SBAR(); } } } while (0)
#define LWAIT(N) do { SBAR(); asm volatile("s_waitcnt lgkmcnt(%0)" :: "n"(N) : "memory"); SBAR(); } while (0)
  struct Frag { bf16x8 a[2]; bf16x8 b[NI]; };
  for (int kt = 0; kt < nt; kt += 2) {
    asm volatile("s_waitcnt vmcnt(0)" ::: "memory");
    __builtin_amdgcn_s_barrier();
    asm volatile("" ::: "memory");
    const bool issue = (kt + 2 < nt);
    const int sa_ = (int)(uintptr_t)(lds + (kt & 3) * STG), sb2_ = (int)(uintptr_t)(lds + ((kt + 1) & 3) * STG);
    Frag F0, F1;
    DSR_SET(F0, sa_ + aoff + co0, sa_ + boff + co0);
    DSR_SET(F1, sa_ + aoff + (co0 ^ 32), sa_ + boff + (co0 ^ 32));
    LWAIT(2 + NI);
    MMA_SET(F0, kt + 2);
    SBAR(); DSR_SET(F0, sb2_ + aoff + co0, sb2_ + boff + co0); SBAR();
    LWAIT(2 + NI);
    MMA_SET(F1, kt + 3);
    SBAR(); DSR_SET(F1, sb2_ + aoff + (co0 ^ 32), sb2_ + boff + (co0 ^ 32)); SBAR();
    LWAIT(2 + NI);
    MMA_SET(F0, -1);
    LWAIT(0);
    MMA_SET(F1, -1);
  }
#undef DSR
#undef DSR_SET
#undef MMA_SET
#undef LWAIT
  asm volatile("" ::: "memory");
  __builtin_amdgcn_s_barrier();
  asm volatile("" ::: "memory");
#undef G_ISSUE
#undef G_PIECE
}

namespace pg8 {
#define PG8_LAS __attribute__((address_space(3)))
typedef unsigned short bf16_t;
typedef short bf16x8 __attribute__((ext_vector_type(8)));
typedef float f32x4 __attribute__((ext_vector_type(4)));
typedef unsigned u32x4 __attribute__((ext_vector_type(4)));
constexpr int BM = 256, BK = 64, HALF = 128, HTB = HALF * BK * 2  , STAGE_BYTES = 8 * HTB, NXCD = 8, WGM = 8;

__host__ __device__ __forceinline__ int lds_byte(int r, int c) { const int st = (r >> 4) * 2 + (c >> 5), rr = r & 15, cc = c & 31, ob = rr * 64 + cc * 2; return st * 1024 + (ob ^ (((ob >> 9) & 1) << 5)); }
__host__ __device__ __forceinline__ void stage_rc(int b, int& R, int& C) { const int st = b / 1024, sb = b % 1024, swz = sb ^ (((sb >> 9) & 1) << 5); R = (st >> 1) * 16 + swz / 64; C = (st & 1) * 32 + (swz % 64) / 2; }
__host__ __device__ __forceinline__ int perm32(int rho) { const int n = rho >> 4, i = rho & 15; return 8 * (i >> 2) + 4 * n + (i & 3); }

struct Unit { int pm, pn; };
struct Gemm { const bf16_t* A; const bf16_t* Bt; int M, N, K; };

__device__ __forceinline__ unsigned cvt_pk_bf16(float lo, float hi) { unsigned r; asm volatile("v_cvt_pk_bf16_f32 %0, %1, %2" : "=v"(r) : "v"(lo), "v"(hi)); return r; }
template <class Epi, class Sched, bool ALIGN_EPI = false, bool SP2 = false>
__device__ __forceinline__ void gemm_phase(PG8_LAS unsigned char* lds, const Gemm g, const Sched& S, const Epi& E) {
    const int tid = threadIdx.x, wid = __builtin_amdgcn_readfirstlane(tid >> 6), lane = tid & 63, wr = wid >> 2, wc = wid & 3, fr = lane & 15, fq = lane >> 4;
    const int K = g.K, nt = K / BK;
    unsigned voffA[2], voffB[2];
#pragma unroll
    for (int i = 0; i < 2; ++i) { int R, C; stage_rc(tid * 16 + i * 8192, R, C); const int Rb = Epi::PERM ? ((R & ~31) + perm32(R & 31)) : R;
        voffA[i] = (unsigned)(R * K + C) * 2u; voffB[i] = (unsigned)(Rb * K + C) * 2u; }
    unsigned voffB1[2]; size_t hstepB = (size_t)HALF * K * 2;
#pragma unroll
    for (int i = 0; i < 2; ++i) { voffB1[i] = voffB[i];
        if constexpr (Epi::COLMAP) { int R, C; stage_rc(tid * 16 + i * 8192, R, C); const int c0 = 64 * (R >> 5) + perm32(R & 31);
            voffB[i] = (unsigned)(c0 * K + C) * 2u; voffB1[i] = (unsigned)((c0 + 32) * K + C) * 2u; } }
    if constexpr (Epi::COLMAP) hstepB = 0;
    const size_t kstep = (size_t)(BK * 2);
    const size_t hstep = (size_t)HALF * K * 2;
    const size_t tstep = 2 * hstep;
    const unsigned ldsw = (unsigned)wid * 1024u;
    const int aoff = lds_byte(wr * 64 + fr, fq * 8), boff = lds_byte(wc * 32 + fr, fq * 8);
#define PG8_SA(b, h) (((b) * 2 + (h)) * HTB)
#define PG8_SB(b, h) ((4 + (b) * 2 + (h)) * HTB)
#define PG8_STAGE(bufoff, gbase, voff) do { _Pragma("unroll") for (int _i = 0; _i < 2; ++_i) \
        __builtin_amdgcn_global_load_lds((const unsigned*)((const char*)(gbase) + (voff)[_i]), (PG8_LAS unsigned*)(lds + (bufoff) + ldsw + _i * 8192), 16, 0, 0); } while (0)
#define PG8_LDA(dst, b, h) do { _Pragma("unroll") for (int m = 0; m < 4; ++m) _Pragma("unroll") for (int k = 0; k < 2; ++k) dst[m][k] = *(const PG8_LAS bf16x8*)(lds + PG8_SA(b, h) + aoff + m * 2048 + k * 1024); } while (0)
#define PG8_LDB(dst, b, h) do { _Pragma("unroll") for (int n = 0; n < 2; ++n) _Pragma("unroll") for (int k = 0; k < 2; ++k) dst[n][k] = *(const PG8_LAS bf16x8*)(lds + PG8_SB(b, h) + boff + n * 2048 + k * 1024); } while (0)
#define PG8_MMA(ai, bj, At, Bt) do { __builtin_amdgcn_s_setprio(1); _Pragma("unroll") for (int m = 0; m < 4; ++m) _Pragma("unroll") for (int n = 0; n < 2; ++n) _Pragma("unroll") for (int k = 0; k < 2; ++k) \
        acc[ai][bj][m][n] = __builtin_amdgcn_mfma_f32_16x16x32_bf16(Bt[n][k], At[m][k], acc[ai][bj][m][n], 0, 0, 0); __builtin_amdgcn_s_setprio(0); } while (0)
#define PG8_WAIT_V(n) asm volatile("s_waitcnt vmcnt(" #n ")" ::: "memory")
#define PG8_WAIT_L(n) asm volatile("s_waitcnt lgkmcnt(" #n ")" ::: "memory")
#define PG8_BAR __builtin_amdgcn_s_barrier()
#define PG8_SCHED __builtin_amdgcn_sched_barrier(0)
    Unit cur, nxt; int ui = 0;
    if (!S.next(0, cur)) return;
    f32x4 acc[2][2][4][2];
#pragma unroll
    for (int a = 0; a < 2; ++a)
#pragma unroll
        for (int b = 0; b < 2; ++b)
#pragma unroll
            for (int m = 0; m < 4; ++m)
#pragma unroll
                for (int n = 0; n < 2; ++n) acc[a][b][m][n] = (f32x4){0.f, 0.f, 0.f, 0.f};
    bf16x8 At[4][2], B0[2][2], B1[2][2];
    const char* cA = (const char*)g.A + (size_t)cur.pm * tstep; const char* cB = (const char*)g.Bt + (size_t)cur.pn * tstep;
    S.a_ready(cur);
    if constexpr (SP2) {
        PG8_STAGE(PG8_SB(0, 0), cB, voffB); PG8_STAGE(PG8_SB(0, 1), cB + hstepB, voffB1); PG8_STAGE(PG8_SA(0, 0), cA, voffA); PG8_STAGE(PG8_SA(0, 1), cA + hstep, voffA);
        if (wr == 1) PG8_BAR;
        PG8_WAIT_V(2); PG8_BAR;
        PG8_STAGE(PG8_SB(1, 0), cB + kstep, voffB); PG8_STAGE(PG8_SA(1, 0), cA + kstep, voffA); PG8_STAGE(PG8_SB(1, 1), cB + hstepB + kstep, voffB1);
        PG8_WAIT_V(6); PG8_BAR;
    } else {
        PG8_STAGE(PG8_SB(0, 0), cB, voffB); PG8_STAGE(PG8_SA(0, 0), cA, voffA); PG8_STAGE(PG8_SB(0, 1), cB + hstepB, voffB1); PG8_STAGE(PG8_SA(0, 1), cA + hstep, voffA);
        if (wr == 1) PG8_BAR;
        PG8_WAIT_V(4); PG8_BAR;
        PG8_STAGE(PG8_SB(1, 0), cB + kstep, voffB); PG8_STAGE(PG8_SA(1, 0), cA + kstep, voffA); PG8_STAGE(PG8_SB(1, 1), cB + hstepB + kstep, voffB1);
        PG8_WAIT_V(6); PG8_BAR;
    }
    for (;;) {
        const bool has_next = S.next(ui + 1, nxt);
        const char* nA = has_next ? (const char*)g.A + (size_t)nxt.pm * tstep : cA; const char* nB = has_next ? (const char*)g.Bt + (size_t)nxt.pn * tstep : cB;
        for (int t = 0; t < nt; t += 2) {
            const bool last = (t == nt - 2);
            const char* a1 = cA + (size_t)(t + 1) * kstep;
            const char* a2 = last ? nA : cA + (size_t)(t + 2) * kstep; const char* b2 = last ? nB : cB + (size_t)(t + 2) * kstep;
            const char* a3 = a2 + kstep; const char* b3 = b2 + kstep;
            if (last && has_next) S.a_ready(nxt);
            if constexpr (SP2) {
            PG8_LDB(B0, 0, 0); PG8_LDB(B1, 0, 1); PG8_SCHED; PG8_LDA(At, 0, 0); PG8_STAGE(PG8_SA(1, 1), a1 + hstep, voffA);
            PG8_WAIT_V(8); PG8_WAIT_L(0); PG8_BAR; PG8_MMA(0, 0, At, B0); PG8_MMA(0, 1, At, B1); PG8_BAR; PG8_SCHED;
            PG8_LDA(At, 0, 1); PG8_STAGE(PG8_SB(0, 0), b2, voffB); PG8_STAGE(PG8_SB(0, 1), b2 + hstepB, voffB1); PG8_STAGE(PG8_SA(0, 0), a2, voffA);
            PG8_WAIT_V(8); PG8_WAIT_L(0); PG8_BAR; PG8_MMA(1, 0, At, B0); PG8_MMA(1, 1, At, B1); PG8_BAR; PG8_SCHED;
            PG8_LDB(B0, 1, 0); PG8_LDB(B1, 1, 1); PG8_SCHED; PG8_LDA(At, 1, 0); PG8_STAGE(PG8_SA(0, 1), a2 + hstep, voffA);
            PG8_WAIT_V(8); PG8_WAIT_L(0); PG8_BAR; PG8_MMA(0, 0, At, B0); PG8_MMA(0, 1, At, B1); PG8_BAR; PG8_SCHED;
            PG8_LDA(At, 1, 1); PG8_STAGE(PG8_SB(1, 0), b3, voffB); PG8_STAGE(PG8_SB(1, 1), b3 + hstepB, voffB1); PG8_STAGE(PG8_SA(1, 0), a3, voffA);
            PG8_WAIT_V(8); PG8_WAIT_L(0); PG8_BAR; PG8_MMA(1, 0, At, B0); PG8_MMA(1, 1, At, B1); PG8_BAR; PG8_SCHED;
            } else {
            PG8_LDB(B0, 0, 0); PG8_SCHED; PG8_LDA(At, 0, 0); PG8_STAGE(PG8_SA(1, 1), a1 + hstep, voffA);
            PG8_WAIT_L(8); PG8_BAR; PG8_WAIT_L(0); PG8_MMA(0, 0, At, B0); PG8_BAR; PG8_SCHED;
            PG8_LDB(B1, 0, 1); PG8_STAGE(PG8_SB(0, 0), b2, voffB);
            PG8_BAR; PG8_WAIT_L(0); PG8_MMA(0, 1, At, B1); PG8_BAR;
            PG8_LDA(At, 0, 1); PG8_STAGE(PG8_SA(0, 0), a2, voffA);
            PG8_BAR; PG8_WAIT_L(0); PG8_MMA(1, 0, At, B0); PG8_BAR; PG8_SCHED;
            PG8_STAGE(PG8_SB(0, 1), b2 + hstepB, voffB1);
            PG8_WAIT_V(6); PG8_BAR; PG8_MMA(1, 1, At, B1); PG8_BAR;
            PG8_LDB(B0, 1, 0); PG8_SCHED; PG8_LDA(At, 1, 0); PG8_STAGE(PG8_SA(0, 1), a2 + hstep, voffA);
            PG8_WAIT_L(8); PG8_BAR; PG8_WAIT_L(0); PG8_MMA(0, 0, At, B0); PG8_BAR; PG8_SCHED;
            PG8_LDB(B1, 1, 1); PG8_STAGE(PG8_SB(1, 0), b3, voffB);
            PG8_BAR; PG8_WAIT_L(0); PG8_MMA(0, 1, At, B1); PG8_BAR;
            PG8_LDA(At, 1, 1); PG8_STAGE(PG8_SA(1, 0), a3, voffA);
            PG8_BAR; PG8_WAIT_L(0); PG8_MMA(1, 0, At, B0); PG8_BAR; PG8_SCHED;
            PG8_STAGE(PG8_SB(1, 1), b3 + hstepB, voffB1);
            PG8_WAIT_V(6); PG8_BAR; PG8_MMA(1, 1, At, B1); PG8_BAR;
            }
        }
        if constexpr (ALIGN_EPI) { if (wr == 0) PG8_BAR; }
        if constexpr (!Epi::AFTER_DRAIN) { E(acc, cur, wr, wc, fr, fq); S.done(cur); }
        if (!has_next) break;
#pragma unroll
        for (int a = 0; a < 2; ++a)
#pragma unroll
            for (int b = 0; b < 2; ++b)
#pragma unroll
                for (int m = 0; m < 4; ++m)
#pragma unroll
                    for (int n = 0; n < 2; ++n) acc[a][b][m][n] = (f32x4){0.f, 0.f, 0.f, 0.f};
        cur = nxt; cA = nA; cB = nB; ++ui;
        if constexpr (ALIGN_EPI) { if (wr == 1) PG8_BAR; }
    }
    PG8_WAIT_V(0);
    if constexpr (!ALIGN_EPI) { if (wr == 0) PG8_BAR; }
    PG8_BAR;
    if constexpr (Epi::AFTER_DRAIN) { E.fused(acc, cur, wr, wc, fr, fq, lds, wid, lane); S.done(cur); }
#undef PG8_SA
#undef PG8_SB
#undef PG8_STAGE
#undef PG8_LDA
#undef PG8_LDB
#undef PG8_MMA
#undef PG8_WAIT_V
#undef PG8_WAIT_L
#undef PG8_BAR
#undef PG8_SCHED
}
}
__device__ __forceinline__ size_t gbuf_off(int gate, int rb, int cb, int lane) { return ((((size_t)gate * 256 + rb) * 128 + cb) * 64 + lane) * 8; }

struct EpiG1 {
  static constexpr bool PERM = true, AFTER_DRAIN = false, COLMAP = true;
  bf16_t* proj; bf16_t* gbuf; const float2* rope; const float* qn_g; const float* kn_g; float* xch;
  __device__ __forceinline__ void operator()(const pg8::f32x4 (&acc)[2][2][4][2], const pg8::Unit& u, int wr, int wc, int fr, int fq) const {
    const int colt = u.pn * 256;
    if (colt >= C_QB && colt < C_VB) { qknorm(acc, u, wr, wc, fr, fq); return; }
    const int type = (colt < C_VA) ? 0 : (colt >= C_GA) ? 3 : (((colt >= C_ZA && colt < C_QB) || (colt >= C_ZB && colt < C_GA)) ? 2 : 4);
#pragma unroll
    for (int ai = 0; ai < 2; ++ai)
#pragma unroll
      for (int m = 0; m < 4; ++m) {
        const int row = u.pm * 256 + ai * 128 + wr * 64 + m * 16 + fr;
        float v[2][8];
#pragma unroll
        for (int bj = 0; bj < 2; ++bj)
#pragma unroll
          for (int e = 0; e < 4; ++e) { v[bj][e] = acc[ai][bj][m][0][e]; v[bj][4 + e] = acc[ai][bj][m][1][e]; }
        if (type == 0) {
          const f32x4* tp = (const f32x4*)(rope + (row & (SEQ - 1)) * 32 + 8 * fq);
#pragma unroll
          for (int q = 0; q < 4; ++q) { const f32x4 cs = tp[q];
            { const float x1 = v[0][2 * q], x2 = v[1][2 * q]; v[0][2 * q] = x1 * cs[0] - x2 * cs[1]; v[1][2 * q] = x2 * cs[0] + x1 * cs[1]; }
            { const float x1 = v[0][2 * q + 1], x2 = v[1][2 * q + 1]; v[0][2 * q + 1] = x1 * cs[2] - x2 * cs[3]; v[1][2 * q + 1] = x2 * cs[2] + x1 * cs[3]; } }
        } else if (type == 2) {
#pragma unroll
          for (int bj = 0; bj < 2; ++bj)
#pragma unroll
            for (int e = 0; e < 8; ++e) v[bj][e] = v[bj][e] * sigmoidf_(v[bj][e]);
        } else if (type == 3) {
#pragma unroll
          for (int bj = 0; bj < 2; ++bj)
#pragma unroll
            for (int e = 0; e < 8; ++e) v[bj][e] = sigmoidf_(v[bj][e]);
        }
#pragma unroll
        for (int bj = 0; bj < 2; ++bj) {
          const int col8 = colt + 64 * wc + 32 * bj + 8 * fq;
          u32x4 w; w[0] = cvtpk(v[bj][0], v[bj][1]); w[1] = cvtpk(v[bj][2], v[bj][3]); w[2] = cvtpk(v[bj][4], v[bj][5]); w[3] = cvtpk(v[bj][6], v[bj][7]);
          if (type == 3) {
            const int gate = (col8 >= C_GB) ? 1 : 0, gc = col8 - (gate ? C_GB : C_GA);
            *(u32x4*)(gbuf + gbuf_off(gate, row >> 5, gc >> 4, ((gc >> 3) & 1) * 32 + (row & 31))) = w;
          } else {
            *(u32x4*)(proj + (size_t)row * CT + col8) = w;
          }
        }
        asm volatile("" ::: "memory");
      }
  }
  __device__ __forceinline__ void qknorm(const pg8::f32x4 (&acc)[2][2][4][2], const pg8::Unit& u, int wr, int wc, int fr, int fq) const {
    const int colt = u.pn * 256, wid = wr * 4 + wc;
    const float* g = (colt < C_KB) ? qn_g : kn_g;
#pragma unroll
    for (int ai = 0; ai < 2; ++ai)
#pragma unroll
      for (int m = 0; m < 4; ++m) {
        float ss = 0.f;
#pragma unroll
        for (int bj = 0; bj < 2; ++bj)
#pragma unroll
          for (int n = 0; n < 2; ++n)
#pragma unroll
            for (int e = 0; e < 4; ++e) ss += acc[ai][bj][m][n][e] * acc[ai][bj][m][n][e];
        ss += __shfl_xor(ss, 16); ss += __shfl_xor(ss, 32);
        if (fq == 0) xch[wid * 128 + (ai * 4 + m) * 16 + fr] = ss;
        asm volatile("" ::: "memory");
      }
    asm volatile("s_waitcnt lgkmcnt(0)" ::: "memory");
    __builtin_amdgcn_s_barrier();
    asm volatile("" ::: "memory");
    const int hg = wc & 1;
#pragma unroll
    for (int ai = 0; ai < 2; ++ai)
#pragma unroll
      for (int m = 0; m < 4; ++m) {
        const int row = u.pm * 256 + ai * 128 + wr * 64 + m * 16 + fr;
        const float tot = xch[wid * 128 + (ai * 4 + m) * 16 + fr] + xch[(wid ^ 1) * 128 + (ai * 4 + m) * 16 + fr];
        const float rinv = rsqrtf(tot * (1.0f / 128.0f) + EPS);
        float v[2][8];
#pragma unroll
        for (int bj = 0; bj < 2; ++bj) { const f32x4 g0 = *(const f32x4*)(g + hg * 64 + bj * 32 + 8 * fq), g1 = *(const f32x4*)(g + hg * 64 + bj * 32 + 8 * fq + 4);
#pragma unroll
          for (int e = 0; e < 4; ++e) { v[bj][e] = acc[ai][bj][m][0][e] * rinv * g0[e]; v[bj][4 + e] = acc[ai][bj][m][1][e] * rinv * g1[e]; } }
        const int s_ = row & (SEQ - 1), pos = hg ? (s_ & 63) : (s_ >> 6);
        const f32x4* tp = (const f32x4*)(rope + pos * 32 + 8 * fq);
#pragma unroll
        for (int q = 0; q < 4; ++q) { const f32x4 cs = tp[q];
          { const float x1 = v[0][2 * q], x2 = v[1][2 * q]; v[0][2 * q] = x1 * cs[0] - x2 * cs[1]; v[1][2 * q] = x2 * cs[0] + x1 * cs[1]; }
          { const float x1 = v[0][2 * q + 1], x2 = v[1][2 * q + 1]; v[0][2 * q + 1] = x1 * cs[2] - x2 * cs[3]; v[1][2 * q + 1] = x2 * cs[2] + x1 * cs[3]; } }
#pragma unroll
        for (int bj = 0; bj < 2; ++bj) {
          const int col8 = colt + 64 * wc + 32 * bj + 8 * fq;
          u32x4 w; w[0] = cvtpk(v[bj][0], v[bj][1]); w[1] = cvtpk(v[bj][2], v[bj][3]); w[2] = cvtpk(v[bj][4], v[bj][5]); w[3] = cvtpk(v[bj][6], v[bj][7]);
          *(u32x4*)(proj + (size_t)row * CT + col8) = w;
        }
        asm volatile("" ::: "memory");
      }
  }
};
struct SchedG1 {
  int b;
  __device__ __forceinline__ bool next(int i, pg8::Unit& u) const {
    int id;
    if (b < 160) { if (i >= 5) return false; if (i == 4) { u.pm = b & 31; u.pn = 16 + (b >> 5); return true; } id = b + 160 * i; }
    else { if (i >= 5) return false; id = 640 + (b - 160) + 96 * i; }
    const int ct = id >> 5; u.pm = id & 31; u.pn = (ct < 16) ? ct : (21 + (ct - 16)); return true;
  }
  __device__ __forceinline__ void a_ready(const pg8::Unit&) const {}
  __device__ __forceinline__ void done(const pg8::Unit&) const {}
};

#define XB_TMO      128
#define XB_XCNT(j)  (256  + 64 * (j))
#define XB_XSUB(j)  (1280 + 64 * (j))
#define XB_XGEN(j)  (2304 + 64 * (j))
#define XB_TOP      3328
#define XB_TOPGEN   3392
#define XCD_BAR_WORDS 3456
#define XB_SPIN_CAP (1u << 18)

__device__ __forceinline__ unsigned xb_ld(unsigned* p)              { return __hip_atomic_load(p, __ATOMIC_RELAXED, __HIP_MEMORY_SCOPE_AGENT); }
__device__ __forceinline__ unsigned xb_add(unsigned* p, unsigned v) { return __hip_atomic_fetch_add(p, v, __ATOMIC_RELAXED, __HIP_MEMORY_SCOPE_AGENT); }
__device__ __forceinline__ unsigned xb_xcc_id() { return (unsigned)__builtin_amdgcn_s_getreg((3 << 11) | 20) & 0xFu; }
#define XB_SPIN(cond, bar) do { unsigned _sp = 0; while (cond) { __builtin_amdgcn_s_sleep(1); \
    if ((++_sp & 255u) == 0u) { if (xb_ld(&(bar)[XB_TMO])) break; if (_sp > XB_SPIN_CAP) { atomicAdd(&(bar)[XB_TMO], 1u); break; } } } } while (0)

struct XcdBarrier {
    unsigned* bar; unsigned x;
    volatile LAS unsigned* st;
};

__device__ __forceinline__ XcdBarrier xcd_barrier_post(unsigned* bar, volatile LAS unsigned* st) {
    XcdBarrier b; b.bar = bar; b.x = xb_xcc_id(); b.st = st;
    if (threadIdx.x == 0) (void)xb_add(&bar[XB_XCNT(b.x)], 1u);
    return b;
}
__device__ __forceinline__ void xcd_barrier_complete(unsigned* bar, unsigned x, unsigned& nloc, unsigned& nx) {
    const unsigned G = gridDim.x * gridDim.y * gridDim.z;
    unsigned sum, cnt, mine, sp = 0u;
    for (;;) {
        sum = 0u; cnt = 0u; mine = 0u;
#pragma unroll
        for (unsigned j = 0; j < 16; ++j) { const unsigned c = xb_ld(&bar[XB_XCNT(j)]); sum += c; cnt += (c > 0u) ? 1u : 0u; mine = (j == x) ? c : mine; }
        if (sum == G) break;
        __builtin_amdgcn_s_sleep(1);
        if ((++sp & 255u) == 0u) { if (xb_ld(&bar[XB_TMO])) break; if (sp > XB_SPIN_CAP) { atomicAdd(&bar[XB_TMO], 1u); break; } }
    }
    nloc = mine > 0u ? mine : 1u; nx = cnt > 0u ? cnt : 1u;
}

__device__ __forceinline__ void xcd_barrier(const XcdBarrier& b) {
    asm volatile("s_waitcnt vmcnt(0)" ::: "memory");
    __syncthreads();
    if (threadIdx.x == 0) {
        unsigned* bar = b.bar;
        __builtin_amdgcn_s_waitcnt(0);
        unsigned nloc = b.st[0], nx = b.st[1];
        if (nloc == 0u) { xcd_barrier_complete(bar, b.x, nloc, nx); b.st[0] = nloc; b.st[1] = nx; }
        const unsigned old = xb_add(&bar[XB_XSUB(b.x)], 1u);
        const unsigned gen = old / nloc;
        if (old + 1u == (gen + 1u) * nloc) {
            __builtin_amdgcn_fence(__ATOMIC_RELEASE, "agent");
            asm volatile("s_waitcnt vmcnt(0)" ::: "memory");
            const unsigned og = xb_add(&bar[XB_TOP], 1u);
            const unsigned tg = og / nx;
            if (og + 1u == (tg + 1u) * nx) xb_add(&bar[XB_TOPGEN], 1u);
            else XB_SPIN(xb_ld(&bar[XB_TOPGEN]) == tg, bar);
            __builtin_amdgcn_fence(__ATOMIC_ACQUIRE, "agent");
            xb_add(&bar[XB_XGEN(b.x)], 1u);
            asm volatile("s_waitcnt vmcnt(0)" ::: "memory");
        } else {
            XB_SPIN(xb_ld(&bar[XB_XGEN(b.x)]) == gen, bar);
            __builtin_amdgcn_fence(__ATOMIC_ACQUIRE, "agent");
            asm volatile("s_waitcnt vmcnt(0)" ::: "memory");
        }
    }
    __syncthreads();
}


__device__ __forceinline__ int launder(int x) { asm volatile("" : "+v"(x)); return x; }

__device__ __forceinline__ void rot4(float (&x1)[4], float (&x2)[4], const f32x4 ca, const f32x4 cb) {
  const float c[4] = {ca[0], ca[2], cb[0], cb[2]}, sn[4] = {ca[1], ca[3], cb[1], cb[3]};
#pragma unroll
  for (int e = 0; e < 4; ++e) { const float a = x1[e] * c[e] - x2[e] * sn[e], bb = x2[e] * c[e] + x1[e] * sn[e]; x1[e] = a; x2[e] = bb; }
}
__device__ __forceinline__ u32x4 pack8(const float (&a)[4], const float (&b)[4]) {
  const unsigned a0 = cvtpk(a[0], a[1]), a1 = cvtpk(a[2], a[3]), b0 = cvtpk(b[0], b[1]), b1 = cvtpk(b[2], b[3]);
  auto r0 = __builtin_amdgcn_permlane32_swap(a0, b0, false, false); auto r1 = __builtin_amdgcn_permlane32_swap(a1, b1, false, false);
  u32x4 w = {r0[0], r1[0], r0[1], r1[1]}; return w;
}
template <int TYPE>
__device__ __forceinline__ void epi1_group(const Params& p, const f32x16 (&acc)[2][4], int mi, int gq, int s, int hi, float rinv, const float* g, float (&v)[4][4]) {
  const int i0 = 8 * gq + 4 * hi;
#pragma unroll
  for (int ni = 0; ni < 4; ++ni)
#pragma unroll
    for (int e = 0; e < 4; ++e) v[ni][e] = acc[mi][ni][4 * gq + e];
  if (TYPE == 0) {
    const f32x4* tp = (const f32x4*)(p.rope + s * 32 + i0);
    const f32x4 ca = tp[0], cb = tp[1];
    rot4(v[0], v[1], ca, cb); rot4(v[2], v[3], ca, cb);
  } else if (TYPE == 1) {
#pragma unroll
    for (int ni = 0; ni < 4; ++ni) { const f32x4 gv = *(const f32x4*)(g + ni * 32 + i0);
#pragma unroll
      for (int e = 0; e < 4; ++e) v[ni][e] = v[ni][e] * rinv * gv[e]; }
    const f32x4* t0 = (const f32x4*)(p.rope + (s >> 6) * 32 + i0);
    const f32x4* t1 = (const f32x4*)(p.rope + (s & 63) * 32 + i0);
    const f32x4 a0 = t0[0], b0 = t0[1], a1 = t1[0], b1 = t1[1];
    rot4(v[0], v[1], a0, b0); rot4(v[2], v[3], a1, b1);
  } else if (TYPE == 2) {
#pragma unroll
    for (int ni = 0; ni < 4; ++ni)
#pragma unroll
      for (int e = 0; e < 4; ++e) v[ni][e] = v[ni][e] * sigmoidf_(v[ni][e]);
  } else if (TYPE == 3) {
#pragma unroll
    for (int ni = 0; ni < 4; ++ni)
#pragma unroll
      for (int e = 0; e < 4; ++e) v[ni][e] = sigmoidf_(v[ni][e]);
  }
}
template <int TYPE>
__device__ __forceinline__ void epi1(const Params& p, const f32x16 (&acc)[2][4], int rowb, int col0, int r32, int hi, const float* g) {
#pragma unroll
  for (int mi = 0; mi < 2; ++mi) {
    const int row = rowb + mi * 32 + r32;
    const int s = row & (SEQ - 1);
    float rinv = 1.f;
    if (TYPE == 1) {
      float ss = 0.f;
#pragma unroll
      for (int ni = 0; ni < 4; ++ni)
#pragma unroll
        for (int r = 0; r < 16; ++r) ss += acc[mi][ni][r] * acc[mi][ni][r];
      ss += __shfl_xor(ss, 32);
      rinv = rsqrtf(ss * (1.0f / 128.0f) + EPS);
    }
    bf16_t* dst = p.proj + (size_t)row * CT + col0 + 8 * hi;
#pragma unroll
    for (int j = 0; j < 2; ++j) {
      float va[4][4], vb[4][4];
      epi1_group<TYPE>(p, acc, mi, 2 * j, s, hi, rinv, g, va);
      epi1_group<TYPE>(p, acc, mi, 2 * j + 1, s, hi, rinv, g, vb);
      if (TYPE == 3) {
        const int gate = (col0 >= C_GB) ? 1 : 0, gc = col0 - (gate ? C_GB : C_GA);
        const int rb = (rowb >> 5) + mi, lane_ = hi * 32 + r32;
#pragma unroll
        for (int ni = 0; ni < 4; ++ni) *(u32x4*)(p.gbuf + gbuf_off(gate, rb, (gc >> 4) + ni * 2 + j, lane_)) = pack8(va[ni], vb[ni]);
      } else {
#pragma unroll
        for (int ni = 0; ni < 4; ++ni) *(u32x4*)(dst + ni * 32 + 16 * j) = pack8(va[ni], vb[ni]);
      }
    }
    asm volatile("" ::: "memory");
  }
}

__device__ __forceinline__ void phase_gemm1(const Params& p, char* lds) {
  const int tid = threadIdx.x, wid = tid >> 6, lane = tid & 63, wm = wid >> 1, wn = wid & 1;
  const int b = blockIdx.x;
  const bool has_tail = b < 128;
  {
    pg8::Gemm g{p.h, p.winT, MTOK, CT, DM};
    SchedG1 S{b}; EpiG1 E{p.proj, p.gbuf, p.rope, p.qn_g, p.kn_g, (float*)(lds + 131072 + 64)};
    pg8::gemm_phase<EpiG1, SchedG1, true, true>((LAS unsigned char*)lds, g, S, E);
  }
  const int nmine = 0;
#define MINE_ID(i_) (b)
#define MINE_PN(id_) (16 + ((id_) >> 5))
  if (nmine > 0) { const int id0 = MINE_ID(0); gemm_prefetch<4>(p.h + (size_t)(id0 & 31) * 256 * DM, DM, p.winT + (size_t)MINE_PN(id0) * 256 * DM, DM, lds); }
  for (int i = 0; i < nmine; ++i) {
    const int id = MINE_ID(i);
    const int pm = id & 31, pn = MINE_PN(id);
    f32x16 acc[2][4];
#pragma unroll
    for (int mi = 0; mi < 2; ++mi)
#pragma unroll
      for (int ni = 0; ni < 4; ++ni) acc[mi][ni] = f32x16{};
    gemm_mainloop<4, true>(p.h + (size_t)pm * 256 * DM, DM, p.winT + (size_t)pn * 256 * DM, DM, DM, acc, lds);
    if (i + 1 < nmine) { const int idn = MINE_ID(i + 1); gemm_prefetch<4>(p.h + (size_t)(idn & 31) * 256 * DM, DM, p.winT + (size_t)MINE_PN(idn) * 256 * DM, DM, lds); }
    else if (has_tail) gemm_prefetch<2>(p.h + (size_t)(b & 31) * 256 * DM, DM, p.winT + (size_t)(40 * 256 + (b >> 5) * 128) * DM, DM, lds);
    const int l2 = launder(lane), r32 = l2 & 31, hi = l2 >> 5;
    const int col0 = pn * 256 + wn * 128;
    const int rowb = pm * 256 + wm * 64;
    if (col0 < C_KB) epi1<1>(p, acc, rowb, col0, r32, hi, p.qn_g);
    else epi1<1>(p, acc, rowb, col0, r32, hi, p.kn_g);
  }
  if (nmine == 0 && has_tail) gemm_prefetch<2>(p.h + (size_t)(b & 31) * 256 * DM, DM, p.winT + (size_t)(40 * 256 + (b >> 5) * 128) * DM, DM, lds);
#undef MINE_ID
#undef MINE_PN
  if (!has_tail) transpose_late_weights(p, lds, (int)blockIdx.x - 128, (int)gridDim.x - 128);
  if (has_tail) {
    const int u = blockIdx.x;
    const int pm = u & 31, cbase = 40 * 256 + (u >> 5) * 128;
    f32x16 acc[2][2];
#pragma unroll
    for (int mi = 0; mi < 2; ++mi)
#pragma unroll
      for (int ni = 0; ni < 2; ++ni) acc[mi][ni] = f32x16{};
    gemm_mainloop<2, true>(p.h + (size_t)pm * 256 * DM, DM, p.winT + (size_t)cbase * DM, DM, DM, acc, lds);
    const int l2 = launder(lane), r32 = l2 & 31, hi = l2 >> 5;
    const int col0 = cbase + wn * 64;
    const int rowb = pm * 256 + wm * 64;
#pragma unroll
    for (int mi = 0; mi < 2; ++mi) {
      const int rb = (rowb >> 5) + mi, cb0 = (col0 - C_GB) >> 4;
#pragma unroll
      for (int ni = 0; ni < 2; ++ni) {
        float o[4][4];
#pragma unroll
        for (int gq = 0; gq < 4; ++gq)
#pragma unroll
          for (int e = 0; e < 4; ++e) o[gq][e] = sigmoidf_(acc[mi][ni][4 * gq + e]);
        *(u32x4*)(p.gbuf + gbuf_off(1, rb, cb0 + ni * 2, l2)) = pack8(o[0], o[1]);
        *(u32x4*)(p.gbuf + gbuf_off(1, rb, cb0 + ni * 2 + 1, l2)) = pack8(o[2], o[3]);
      }
    }
  }
}

struct EpiG2 {
  static constexpr bool PERM = true, AFTER_DRAIN = false, COLMAP = false;
  const bf16_t* gbuf; bf16_t* merged;
  __device__ __forceinline__ void operator()(const pg8::f32x4 (&acc)[2][2][4][2], const pg8::Unit& u, int wr, int wc, int fr, int fq) const {
    const int pass = u.pm >> 5, pm = u.pm & 31, pn = u.pn & 7;
#pragma unroll
    for (int ai = 0; ai < 2; ++ai)
#pragma unroll
      for (int m = 0; m < 4; ++m) {
        const int row = pm * 256 + ai * 128 + wr * 64 + m * 16 + fr;
#pragma unroll
        for (int bj = 0; bj < 2; ++bj) {
          const int col8 = pn * 256 + bj * 128 + wc * 32 + 8 * fq;
          const u32x4 gw = __builtin_nontemporal_load((const u32x4*)(gbuf + gbuf_off(pass, row >> 5, col8 >> 4, ((col8 >> 3) & 1) * 32 + (row & 31))));
          bf16_t* mp = merged + (size_t)row * DM + col8;
          float sg[8], o[8];
#pragma unroll
          for (int i = 0; i < 4; ++i) { sg[2 * i] = __uint_as_float(gw[i] << 16); sg[2 * i + 1] = __uint_as_float(gw[i] & 0xffff0000u); }
#pragma unroll
          for (int e = 0; e < 4; ++e) { o[e] = sg[e] * acc[ai][bj][m][0][e]; o[4 + e] = sg[4 + e] * acc[ai][bj][m][1][e]; }
          if (pass) {
            const u32x4 tw = *(const u32x4*)mp;
#pragma unroll
            for (int i = 0; i < 4; ++i) { o[2 * i] += __uint_as_float(tw[i] << 16); o[2 * i + 1] += __uint_as_float(tw[i] & 0xffff0000u); }
          }
          u32x4 w; w[0] = cvtpk(o[0], o[1]); w[1] = cvtpk(o[2], o[3]); w[2] = cvtpk(o[4], o[5]); w[3] = cvtpk(o[6], o[7]);
          *(u32x4*)mp = w;
        }
        asm volatile("" ::: "memory");
      }
  }
};
struct SchedG2 {
  int b;
  __device__ __forceinline__ bool next(int i, pg8::Unit& u) const { if (i >= 2) return false; u.pm = (b & 31) + 32 * i; u.pn = (b >> 5) + 8 * i; return true; }
  __device__ __forceinline__ void a_ready(const pg8::Unit&) const {}
  __device__ __forceinline__ void done(const pg8::Unit&) const {}
};
__device__ __forceinline__ void phase_gemm2(const Params& p, char* lds) {
  pg8::Gemm g{p.U, p.waT, 2 * MTOK, 2 * DM, BW};
  SchedG2 S{(int)blockIdx.x}; EpiG2 E{p.gbuf, p.merged};
  pg8::gemm_phase<EpiG2, SchedG2, true, true>((LAS unsigned char*)lds, g, S, E);
}

struct EpiG3 {
  static constexpr bool PERM = true, AFTER_DRAIN = true, COLMAP = false;
  const float* x; float* out; float* ssq; const float* fg; const XcdBarrier* xb;
  __device__ __forceinline__ void fused(pg8::f32x4 (&acc)[2][2][4][2], const pg8::Unit& u, int wr, int wc, int fr, int fq, LAS unsigned char*, int, int) const {
    const int colw = u.pn * 256 + wc * 32 + 8 * fq;
#pragma unroll
    for (int ai = 0; ai < 2; ++ai)
#pragma unroll
      for (int m = 0; m < 4; ++m) {
        const int row = u.pm * 256 + ai * 128 + wr * 64 + m * 16 + fr;
        float ss = 0.f;
#pragma unroll
        for (int bj = 0; bj < 2; ++bj) {
          const float* xp = x + (size_t)row * DM + colw + bj * 128;
          const f32x4 xa = __builtin_nontemporal_load((const f32x4*)xp), xc = __builtin_nontemporal_load((const f32x4*)(xp + 4));
#pragma unroll
          for (int e = 0; e < 4; ++e) { const float y0 = acc[ai][bj][m][0][e] + xa[e], y1 = acc[ai][bj][m][1][e] + xc[e]; acc[ai][bj][m][0][e] = y0; acc[ai][bj][m][1][e] = y1; ss += y0 * y0 + y1 * y1; }
        }
        ss += __shfl_xor(ss, 16); ss += __shfl_xor(ss, 32);
        if (fq == 0) ssq[row * 32 + u.pn * 4 + wc] = ss;
        asm volatile("" ::: "memory");
      }
    xcd_barrier(*xb);
#pragma unroll
    for (int ai = 0; ai < 2; ++ai)
#pragma unroll
      for (int m = 0; m < 4; ++m) {
        const int row = u.pm * 256 + ai * 128 + wr * 64 + m * 16 + fr;
        const f32x4* sp = (const f32x4*)(ssq + row * 32);
        float tot = 0.f;
#pragma unroll
        for (int q = 0; q < 8; ++q) { const f32x4 t = sp[q]; tot += (t[0] + t[1]) + (t[2] + t[3]); }
        const float rinv = rsqrtf(tot * (1.0f / DM) + EPS);
#pragma unroll
        for (int bj = 0; bj < 2; ++bj) {
          const int col = colw + bj * 128;
          const f32x4 g0 = *(const f32x4*)(fg + col), g1 = *(const f32x4*)(fg + col + 4);
          f32x4 o0, o1;
#pragma unroll
          for (int e = 0; e < 4; ++e) { o0[e] = acc[ai][bj][m][0][e] * rinv * g0[e]; o1[e] = acc[ai][bj][m][1][e] * rinv * g1[e]; }
          float* op = out + (size_t)row * DM + col;
          __builtin_nontemporal_store(o0, (f32x4*)op); __builtin_nontemporal_store(o1, (f32x4*)(op + 4));
        }
        asm volatile("" ::: "memory");
      }
  }
};
struct SchedOne {
  int b;
  __device__ __forceinline__ bool next(int i, pg8::Unit& u) const { if (i >= 1) return false; u.pm = b & 31; u.pn = b >> 5; return true; }
  __device__ __forceinline__ void a_ready(const pg8::Unit&) const {}
  __device__ __forceinline__ void done(const pg8::Unit&) const {}
};
__device__ __forceinline__ void phase_gemm3_final(const Params& p, char* lds, const XcdBarrier& xb) {
  pg8::Gemm g{p.merged, p.woT, MTOK, DM, DM};
  SchedOne S{(int)blockIdx.x}; EpiG3 E{p.x, p.out, p.ssq, p.final_g, &xb};
  pg8::gemm_phase<EpiG3, SchedOne, false, true>((LAS unsigned char*)lds, g, S, E);
}

constexpr int KVBLK = 64;
constexpr size_t SHM_V = KVBLK * 128 * 2, SHM_K = KVBLK * 128 * 2;
constexpr int ATT_TILE = 32768, ATT_WS = 131072 + 64;
constexpr float THR = 8.f;
#define KSWZ(row, colB) ((row) * 256 + ((colB) ^ (((row) & 7) << 4)))

template <int DQK> struct AttnC { static constexpr float SCALE = (DQK == 64) ? 0.125f : 0.088388347648318440f; };

template <int DQK>
__device__ __forceinline__ void partialSM(f32x16& p0, f32x16& p1, float& m_reg, float& mn, float& alpha) {
  constexpr float SCALE = AttnC<DQK>::SCALE;
  constexpr float C = SCALE * 1.4426950408889634f;
  float pmax = p0[0];
#pragma unroll
  for (int r = 1; r < 16; ++r) pmax = fmaxf(pmax, p0[r]);
#pragma unroll
  for (int r = 0; r < 16; ++r) pmax = fmaxf(pmax, p1[r]);
  { auto rr = __builtin_amdgcn_permlane32_swap(__float_as_uint(pmax), __float_as_uint(pmax), false, false);
    pmax = fmaxf(__uint_as_float(rr[0]), __uint_as_float(rr[1])); }
  if (__builtin_expect(__all(pmax - m_reg <= THR / SCALE), 1)) { mn = m_reg; alpha = 1.f; }
  else { mn = fmaxf(m_reg, pmax); alpha = __builtin_amdgcn_exp2f((m_reg - mn) * C); m_reg = mn; }
  const float mnC = -mn * C;
#pragma unroll
  for (int r = 0; r < 16; ++r) p0[r] = fmaf(p0[r], C, mnC);
#pragma unroll
  for (int r = 0; r < 16; ++r) p1[r] = fmaf(p1[r], C, mnC);
#pragma unroll
  for (int r = 0; r < 16; ++r) p0[r] = __builtin_amdgcn_exp2f(p0[r]);
}
__device__ __forceinline__ void finishSM(f32x16& p0, f32x16& p1, float alpha, float& l_reg, bf16x8& pa0, bf16x8& pa1, bf16x8& pa2, bf16x8& pa3) {
#pragma unroll
  for (int r = 0; r < 16; ++r) p1[r] = __builtin_amdgcn_exp2f(p1[r]);
  float ps = 0;
#pragma unroll
  for (int r = 0; r < 16; ++r) ps += p0[r];
#pragma unroll
  for (int r = 0; r < 16; ++r) ps += p1[r];
  { auto rr = __builtin_amdgcn_permlane32_swap(__float_as_uint(ps), __float_as_uint(ps), false, false);
    ps = __uint_as_float(rr[0]) + __uint_as_float(rr[1]); }
  l_reg = l_reg * alpha + ps;
#define PK4(P, BASE, OUT) do { unsigned a0 = cvtpk(P[BASE + 0], P[BASE + 1]), a1 = cvtpk(P[BASE + 2], P[BASE + 3]);   \
    unsigned b0 = cvtpk(P[BASE + 4], P[BASE + 5]), b1 = cvtpk(P[BASE + 6], P[BASE + 7]);                              \
    auto r0 = __builtin_amdgcn_permlane32_swap(a0, b0, false, false); auto r1 = __builtin_amdgcn_permlane32_swap(a1, b1, false, false); \
    u32x4 w = {r0[0], r1[0], r0[1], r1[1]}; OUT = *reinterpret_cast<bf16x8*>(&w); } while (0)
  PK4(p0, 0, pa0); PK4(p0, 8, pa1); PK4(p1, 0, pa2); PK4(p1, 8, pa3);
#undef PK4
}
template <int DQK>
__device__ __forceinline__ void qkt(f32x16& p0, f32x16& p1, const LAS char* Ks, const bf16x8* qr, int r32, int hi) {
  constexpr int PITCH = DQK * 2;
  const int sw = (DQK == 128) ? (r32 & 7) : ((r32 >> 1) & 7);
  p0 = f32x16{}; p1 = f32x16{};
#pragma unroll
  for (int d0 = 0; d0 < DQK / 16; ++d0) { const int co = ((d0 * 2 + hi) ^ sw) << 4;
    bf16x8 b0 = *reinterpret_cast<const LAS bf16x8*>(Ks + r32 * PITCH + co);
    bf16x8 b1 = *reinterpret_cast<const LAS bf16x8*>(Ks + (32 + r32) * PITCH + co);
    p0 = __builtin_amdgcn_mfma_f32_32x32x16_bf16(b0, qr[d0], p0, 0, 0, 0);
    p1 = __builtin_amdgcn_mfma_f32_32x32x16_bf16(b1, qr[d0], p1, 0, 0, 0); }
}
__device__ __forceinline__ int v_st(int k, int c) { const int kk = (k & ~0xC) | ((k & 4) << 1) | ((k & 8) >> 1); return ((kk >> 3) * 4 + (c >> 5)) * 512 + ((kk & 7) * 32 + (c & 31)) * 2; }
__device__ __forceinline__ int v_rd_base(int lane) { return ((lane & 3) << 3) | (((lane >> 2) & 3) << 6) | (((lane >> 4) & 1) << 5) | (((lane >> 5) & 1) << 8); }
constexpr int v_rd_off(int d0, int ks, int half) { return d0 * 512 + ks * 4096 + half * 2048; }
template <int OFF> __device__ __forceinline__ s16x4 tr_read(int vb) {
  s16x4 r; asm volatile("ds_read_b64_tr_b16 %0, %1 offset:%2" : "=&v"(r) : "v"(vb), "i"(OFF) : "memory"); return r;
}
template <int D0> __device__ __forceinline__ void pv_one(f32x16& od, int vb, bf16x8 pa0, bf16x8 pa1, bf16x8 pa2, bf16x8 pa3) {
  const s16x4 l0 = tr_read<v_rd_off(D0, 0, 0)>(vb), h0 = tr_read<v_rd_off(D0, 0, 1)>(vb), l1 = tr_read<v_rd_off(D0, 1, 0)>(vb), h1 = tr_read<v_rd_off(D0, 1, 1)>(vb);
  const s16x4 l2 = tr_read<v_rd_off(D0, 2, 0)>(vb), h2 = tr_read<v_rd_off(D0, 2, 1)>(vb), l3 = tr_read<v_rd_off(D0, 3, 0)>(vb), h3 = tr_read<v_rd_off(D0, 3, 1)>(vb);
  asm volatile("s_waitcnt lgkmcnt(0)" ::: "memory"); SBAR();
#define PK(L, H) (bf16x8){L[0], L[1], L[2], L[3], H[0], H[1], H[2], H[3]}
  od = __builtin_amdgcn_mfma_f32_32x32x16_bf16(pa0, PK(l0, h0), od, 0, 0, 0);
  od = __builtin_amdgcn_mfma_f32_32x32x16_bf16(pa1, PK(l1, h1), od, 0, 0, 0);
  od = __builtin_amdgcn_mfma_f32_32x32x16_bf16(pa2, PK(l2, h2), od, 0, 0, 0);
  od = __builtin_amdgcn_mfma_f32_32x32x16_bf16(pa3, PK(l3, h3), od, 0, 0, 0);
#undef PK
}
template <int DQK, class ISS>
__device__ __forceinline__ void pv_sm(f32x16 (&o)[4], int vb, bf16x8 pa0, bf16x8 pa1, bf16x8 pa2, bf16x8 pa3,
                                      f32x16& p0, f32x16& p1, float& m_reg, float& mn, float& alpha, const ISS& iss) {
  constexpr float SCALE = AttnC<DQK>::SCALE;
  constexpr float C = SCALE * 1.4426950408889634f;
#define PK(L, H) (bf16x8){L[0], L[1], L[2], L[3], H[0], H[1], H[2], H[3]}
#define PV_READS(D0) const s16x4 l0 = tr_read<v_rd_off(D0, 0, 0)>(vb), h0 = tr_read<v_rd_off(D0, 0, 1)>(vb), l1 = tr_read<v_rd_off(D0, 1, 0)>(vb), h1 = tr_read<v_rd_off(D0, 1, 1)>(vb); \
    const s16x4 l2 = tr_read<v_rd_off(D0, 2, 0)>(vb), h2 = tr_read<v_rd_off(D0, 2, 1)>(vb), l3 = tr_read<v_rd_off(D0, 3, 0)>(vb), h3 = tr_read<v_rd_off(D0, 3, 1)>(vb); \
    asm volatile("s_waitcnt lgkmcnt(0)" ::: "memory"); SBAR();
#define PV_MMA(D0) o[D0] = __builtin_amdgcn_mfma_f32_32x32x16_bf16(pa0, PK(l0, h0), o[D0], 0, 0, 0); o[D0] = __builtin_amdgcn_mfma_f32_32x32x16_bf16(pa1, PK(l1, h1), o[D0], 0, 0, 0); \
    o[D0] = __builtin_amdgcn_mfma_f32_32x32x16_bf16(pa2, PK(l2, h2), o[D0], 0, 0, 0); o[D0] = __builtin_amdgcn_mfma_f32_32x32x16_bf16(pa3, PK(l3, h3), o[D0], 0, 0, 0);
  float pmax, mnC;
  { PV_READS(0)
    iss(0);
    pmax = p0[0];
#pragma unroll
    for (int r = 1; r < 16; ++r) pmax = fmaxf(pmax, p0[r]);
    PV_MMA(0) }
  { PV_READS(1)
    iss(1);
#pragma unroll
    for (int r = 0; r < 16; ++r) pmax = fmaxf(pmax, p1[r]);
    { auto rr = __builtin_amdgcn_permlane32_swap(__float_as_uint(pmax), __float_as_uint(pmax), false, false);
      pmax = fmaxf(__uint_as_float(rr[0]), __uint_as_float(rr[1])); }
    const bool keep = __all(pmax - m_reg <= THR / SCALE);
    mn = keep ? m_reg : fmaxf(m_reg, pmax);
    alpha = __builtin_amdgcn_exp2f((m_reg - mn) * C);
    m_reg = mn; mnC = -mn * C;
    PV_MMA(1) }
  { PV_READS(2)
    iss(2);
#pragma unroll
    for (int r = 0; r < 16; ++r) p0[r] = fmaf(p0[r], C, mnC);
#pragma unroll
    for (int r = 0; r < 16; ++r) p1[r] = fmaf(p1[r], C, mnC);
    PV_MMA(2) }
  { PV_READS(3)
    iss(3);
#pragma unroll
    for (int r = 0; r < 16; ++r) p0[r] = __builtin_amdgcn_exp2f(p0[r]);
    PV_MMA(3) }
#undef PK
#undef PV_READS
#undef PV_MMA
}
__device__ __forceinline__ void pv_d0(f32x16 (&o)[4], int vb, bf16x8 pa0, bf16x8 pa1, bf16x8 pa2, bf16x8 pa3) {
  pv_one<0>(o[0], vb, pa0, pa1, pa2, pa3); pv_one<1>(o[1], vb, pa0, pa1, pa2, pa3); pv_one<2>(o[2], vb, pa0, pa1, pa2, pa3); pv_one<3>(o[3], vb, pa0, pa1, pa2, pa3);
}

template <int DQK>
__device__ __forceinline__ void attn_body(const bf16_t* __restrict__ Qb, const bf16_t* __restrict__ Kh, const bf16_t* __restrict__ Vh,
                                          char* lds, f32x16 (&o)[4], float& l_out) {
  constexpr int LD = CT;
  constexpr int NQ = DQK / 16, PK = DQK / 64, P = 2 + PK;
  const int tid = threadIdx.x, wid = __builtin_amdgcn_readfirstlane(tid >> 6), lane = tid & 63, r32 = lane & 31, hi = lane >> 5;
  LAS char* ldsl = (LAS char*)lds;
  float* ws = (float*)(lds + ATT_WS) + wid * 64; float* al_l = ws + 32;
  float m_reg = -1e30f, l_reg = 0;
#pragma unroll
  for (int d = 0; d < 4; ++d) o[d] = f32x16{};
  bf16x8 qr[NQ];
  const bf16_t* Qw = Qb + (size_t)(wid * 32 + r32) * LD + hi * 8;
#pragma unroll
  for (int d0 = 0; d0 < NQ; ++d0) qr[d0] = __builtin_nontemporal_load((const bf16x8*)(Qw + d0 * 16));
  unsigned vgo[2], kgo[2];
#pragma unroll
  for (int i = 0; i < 2; ++i) {
    const int kk = (i * 4 + (tid >> 7)) * 8 + ((tid & 31) >> 2), c = ((tid >> 5) & 3) * 32 + (tid & 3) * 8;
    const int k = (kk & ~0xC) | ((kk & 4) << 1) | ((kk & 8) >> 1);
    vgo[i] = (unsigned)(k * LD + c) * 2u;
    if (DQK == 128) { const int row = i * 32 + (tid >> 4), lc = (tid & 15) ^ (row & 7); kgo[i] = (unsigned)(row * LD + lc * 8) * 2u; }
    else { const int row = tid >> 3, lc = (tid & 7) ^ ((row >> 1) & 7); kgo[i] = (unsigned)(row * LD + lc * 8) * 2u; }
  }
  const char* Vb = (const char*)Vh; const char* Kb = (const char*)Kh;
#define A_ISSUE(t_) do { const size_t ko_ = (size_t)(t_) * (KVBLK * LD * 2); LAS char* bb_ = ldsl + ((t_) & 3) * ATT_TILE + wid * 1024; \
    __builtin_amdgcn_global_load_lds((const unsigned*)(Vb + ko_ + vgo[0]), (LAS unsigned*)(bb_), 16, 0, 0); \
    __builtin_amdgcn_global_load_lds((const unsigned*)(Vb + ko_ + vgo[1]), (LAS unsigned*)(bb_ + 8192), 16, 0, 0); \
    __builtin_amdgcn_global_load_lds((const unsigned*)(Kb + ko_ + kgo[0]), (LAS unsigned*)(bb_ + 16384), 16, 0, 0); \
    if constexpr (DQK == 128) __builtin_amdgcn_global_load_lds((const unsigned*)(Kb + ko_ + kgo[1]), (LAS unsigned*)(bb_ + 16384 + 8192), 16, 0, 0); } while (0)
  auto a_piece = [&](int t_, int j_) {
    const size_t ko_ = (size_t)t_ * (KVBLK * LD * 2); LAS char* bb_ = ldsl + (t_ & 3) * ATT_TILE + wid * 1024;
    if (j_ == 0) __builtin_amdgcn_global_load_lds((const unsigned*)(Vb + ko_ + vgo[0]), (LAS unsigned*)(bb_), 16, 0, 0);
    else if (j_ == 1) __builtin_amdgcn_global_load_lds((const unsigned*)(Vb + ko_ + vgo[1]), (LAS unsigned*)(bb_ + 8192), 16, 0, 0);
    else if (j_ == 2) __builtin_amdgcn_global_load_lds((const unsigned*)(Kb + ko_ + kgo[0]), (LAS unsigned*)(bb_ + 16384), 16, 0, 0);
    else if (DQK == 128) __builtin_amdgcn_global_load_lds((const unsigned*)(Kb + ko_ + kgo[1]), (LAS unsigned*)(bb_ + 16384 + 8192), 16, 0, 0);
  };
#define A_WAITBAR(N) do { asm volatile("s_waitcnt vmcnt(%0)" :: "n"(N) : "memory"); __builtin_amdgcn_s_barrier(); asm volatile("" ::: "memory"); } while (0)
#define KBUF(t_) ((const LAS char*)(ldsl + ((t_) & 3) * ATT_TILE + 16384))
#define VBUF(t_) ((int)(uintptr_t)(ldsl + ((t_) & 3) * ATT_TILE) + vrb)
#define RESC(a) do { if (__any((a) < 1.f)) { if (hi == 0) al_l[r32] = (a); asm volatile("s_waitcnt lgkmcnt(0)" ::: "memory"); \
    _Pragma("unroll") for (int d = 0; d < 4; ++d) _Pragma("unroll") for (int r = 0; r < 16; ++r) o[d][r] *= al_l[crow(r, hi)]; } } while (0)
  const int vrb = v_rd_base(lane);
  f32x16 pA0, pA1, pB0, pB1; float mnA, mnB, alA, alB; bf16x8 pa0, pa1, pa2, pa3; constexpr int NT = SEQ / KVBLK;
  A_ISSUE(0); A_ISSUE(1);
  A_WAITBAR(P);
  qkt<DQK>(pA0, pA1, KBUF(0), qr, r32, hi); partialSM<DQK>(pA0, pA1, m_reg, mnA, alA);
  A_ISSUE(2);
  A_WAITBAR(P);
  for (int n = 1; n + 1 < NT; n += 2) {
    SBAR(); qkt<DQK>(pB0, pB1, KBUF(n), qr, r32, hi);
    finishSM(pA0, pA1, alA, l_reg, pa0, pa1, pa2, pa3); SBAR();
    pv_sm<DQK>(o, VBUF(n - 1), pa0, pa1, pa2, pa3, pB0, pB1, m_reg, mnB, alB, [&](int j_) { a_piece(n + 2, j_); });
    A_WAITBAR(P);
    RESC(alB);
    SBAR(); qkt<DQK>(pA0, pA1, KBUF(n + 1), qr, r32, hi);
    finishSM(pB0, pB1, alB, l_reg, pa0, pa1, pa2, pa3); SBAR();
    { const bool more_ = (n + 3 < NT); pv_sm<DQK>(o, VBUF(n), pa0, pa1, pa2, pa3, pA0, pA1, m_reg, mnA, alA, [&](int j_) { if (more_) a_piece(n + 3, j_); }); }
    if (n + 3 < NT) A_WAITBAR(P); else A_WAITBAR(0);
    RESC(alA);
  }
  SBAR(); qkt<DQK>(pB0, pB1, KBUF(NT - 1), qr, r32, hi);
  finishSM(pA0, pA1, alA, l_reg, pa0, pa1, pa2, pa3); SBAR();
  pv_sm<DQK>(o, VBUF(NT - 2), pa0, pa1, pa2, pa3, pB0, pB1, m_reg, mnB, alB, [](int) {});
  RESC(alB);
  finishSM(pB0, pB1, alB, l_reg, pa0, pa1, pa2, pa3); SBAR();
  pv_d0(o, VBUF(NT - 1), pa0, pa1, pa2, pa3);
  l_out = l_reg;
#undef A_ISSUE
#undef A_WAITBAR
#undef KBUF
#undef VBUF
#undef RESC
}

__device__ __forceinline__ void attn_rli(float l_reg, char* lds, float (&rli)[16]) {
  const int tid = threadIdx.x, wid = tid >> 6, lane = tid & 63, r32 = lane & 31, hi = lane >> 5;
  float* li_l = (float*)(lds + ATT_WS) + wid * 64;
  if (hi == 0) li_l[r32] = l_reg;
  asm volatile("s_waitcnt lgkmcnt(0)" ::: "memory");
#pragma unroll
  for (int r = 0; r < 16; ++r) rli[r] = __builtin_amdgcn_rcpf(li_l[crow(r, hi)]);
  asm volatile("s_waitcnt lgkmcnt(0)" ::: "memory");
}

constexpr int EPI_RS = 68, EPI_WAVE_BYTES = 32 * EPI_RS * 4;
__device__ __forceinline__ void epi_put_half(const f32x16 (&o)[4], const float (&rli)[16], float* sc, int half, int r32, int hi) {
#pragma unroll
  for (int d0h = 0; d0h < 2; ++d0h)
#pragma unroll
    for (int r = 0; r < 16; ++r) sc[crow(r, hi) * EPI_RS + d0h * 32 + r32] = o[half * 2 + d0h][r] * rli[r];
}
__device__ __forceinline__ void epi_get(const float* sc, int q, int lane, float (&v)[8]) {
  const f32x4* sp = (const f32x4*)(sc + (q * 8 + (lane >> 3)) * EPI_RS + (lane & 7) * 8);
  const f32x4 a = sp[0], bq = sp[1];
  v[0] = a[0]; v[1] = a[1]; v[2] = a[2]; v[3] = a[3]; v[4] = bq[0]; v[5] = bq[1]; v[6] = bq[2]; v[7] = bq[3];
}
__device__ __forceinline__ void unpack8(const u32x4 w, float (&z)[8]) {
#pragma unroll
  for (int i = 0; i < 4; ++i) { z[2 * i] = __uint_as_float(w[i] << 16); z[2 * i + 1] = __uint_as_float(w[i] & 0xffff0000u); }
}

__device__ __forceinline__ void phase_attn(const Params& p, char* lds) {
  const int tid = threadIdx.x, wid = tid >> 6, lane = tid & 63;
  float* sc = (float*)(lds + (wid < 7 ? wid * EPI_WAVE_BYTES : 131072 + 64 + 4096));
  for (int it = blockIdx.x; it < 512; it += gridDim.x) {
    const int j = it & 255, xcd = j & 7, slot = j >> 3;
    const int bh = xcd * 2 + (slot >> 4), qblk = slot & 15;
    const int b = bh >> 3, h = bh & 7;
    const size_t tok0 = (size_t)b * SEQ;
    const size_t rowq = tok0 + qblk * 256;
    const int rowbase = (int)rowq + wid * 32;
    f32x16 o[4]; float l_reg; float rli[16];
    if (it < 256) {
      const int kvh = h >> 2;
      attn_body<128>(p.proj + rowq * CT + C_QB + h * 128, p.proj + tok0 * CT + C_KB + kvh * 128, p.proj + tok0 * CT + C_VB + kvh * 128, lds, o, l_reg);
      attn_rli(l_reg, lds, rli);
      const int l2 = launder(lane), r32 = l2 & 31, hi = l2 >> 5;
#pragma unroll
      for (int half = 0; half < 2; ++half) {
        epi_put_half(o, rli, sc, half, r32, hi);
#pragma unroll
        for (int q = 0; q < 4; ++q) {
          float v[8], z[8]; epi_get(sc, q, l2, v);
          const size_t row = (size_t)(rowbase + q * 8 + (l2 >> 3)); const int col = h * 128 + half * 64 + (l2 & 7) * 8;
          unpack8(__builtin_nontemporal_load((const u32x4*)(p.proj + row * CT + C_ZB + col)), z);
          u32x4 w; w[0] = cvtpk(v[0] * z[0], v[1] * z[1]); w[1] = cvtpk(v[2] * z[2], v[3] * z[3]); w[2] = cvtpk(v[4] * z[4], v[5] * z[5]); w[3] = cvtpk(v[6] * z[6], v[7] * z[7]);
          *(u32x4*)(p.U + (size_t)MTOK * BW + row * BW + (col - h * 128) + h * 128) = w;
        }
      }
    } else {
      const bf16_t* Vp = p.proj + tok0 * CT + C_VA + h * 128;
      attn_body<64>(p.proj + rowq * CT + C_QA + h * 128, p.proj + tok0 * CT + C_KA + h * 128, Vp, lds, o, l_reg);
      attn_rli(l_reg, lds, rli);
      float* o1w = p.o1 + ((size_t)(rowbase >> 5) * 8 + h) * 4096 + launder(lane) * 4;
#pragma unroll
      for (int d0 = 0; d0 < 4; ++d0)
#pragma unroll
        for (int gq = 0; gq < 4; ++gq) {
          f32x4 v4; v4[0] = o[d0][4 * gq + 0] * rli[4 * gq + 0]; v4[1] = o[d0][4 * gq + 1] * rli[4 * gq + 1]; v4[2] = o[d0][4 * gq + 2] * rli[4 * gq + 2]; v4[3] = o[d0][4 * gq + 3] * rli[4 * gq + 3];
          *(f32x4*)(o1w + (d0 * 4 + gq) * 256) = v4;
        }
      asm volatile("" ::: "memory");
      attn_body<64>(p.proj + rowq * CT + C_QA + h * 128 + 64, p.proj + tok0 * CT + C_KA + h * 128 + 64, Vp, lds, o, l_reg);
      attn_rli(l_reg, lds, rli);
      const int l2 = launder(lane), r32 = l2 & 31, hi = l2 >> 5;
      float d1 = 0.f, d2 = 0.f;
      for (int i = 0; i < 64; ++i) { d1 += p.lq1[i] * p.lk1[i]; d2 += p.lq2[i] * p.lk2[i]; }
      const float lam = __expf(d1) - __expf(d2) + 0.2f;
      {
        const float* o1r = p.o1 + ((size_t)(rowbase >> 5) * 8 + h) * 4096 + l2 * 4;
#pragma unroll
        for (int d0 = 0; d0 < 4; ++d0)
#pragma unroll
          for (int gq = 0; gq < 4; ++gq) {
            const f32x4 v4 = *(const f32x4*)(o1r + (d0 * 4 + gq) * 256);
#pragma unroll
            for (int e = 0; e < 4; ++e) o[d0][4 * gq + e] = v4[e] - lam * (o[d0][4 * gq + e] * rli[4 * gq + e]);
          }
#pragma unroll
        for (int r = 0; r < 16; ++r) rli[r] = 1.f;
      }
      float t[2][4][8]; float ss[4] = {0.f, 0.f, 0.f, 0.f};
#pragma unroll
      for (int half = 0; half < 2; ++half) {
        epi_put_half(o, rli, sc, half, r32, hi);
#pragma unroll
        for (int q = 0; q < 4; ++q) {
          float v[8]; epi_get(sc, q, l2, v);
#pragma unroll
          for (int e = 0; e < 8; ++e) { const float tv = v[e]; t[half][q][e] = tv; ss[q] += tv * tv; }
        }
      }
      float rinv[4];
#pragma unroll
      for (int q = 0; q < 4; ++q) { float x = ss[q]; x += __shfl_xor(x, 1); x += __shfl_xor(x, 2); x += __shfl_xor(x, 4); rinv[q] = rsqrtf(x * (1.0f / 128.0f) + EPS) * 0.8f; }
#pragma unroll
      for (int half = 0; half < 2; ++half) {
        const int colh = half * 64 + (l2 & 7) * 8;
        const f32x4 g0 = *(const f32x4*)(p.subln_g + colh), g1 = *(const f32x4*)(p.subln_g + colh + 4);
        const float sg[8] = {g0[0], g0[1], g0[2], g0[3], g1[0], g1[1], g1[2], g1[3]};
#pragma unroll
        for (int q = 0; q < 4; ++q) {
          const size_t row = (size_t)(rowbase + q * 8 + (l2 >> 3)); const int col = h * 128 + colh;
          float z[8]; unpack8(__builtin_nontemporal_load((const u32x4*)(p.proj + row * CT + C_ZA + col)), z);
          float ov[8];
#pragma unroll
          for (int e = 0; e < 8; ++e) ov[e] = t[half][q][e] * rinv[q] * sg[e] * z[e];
          u32x4 w; w[0] = cvtpk(ov[0], ov[1]); w[1] = cvtpk(ov[2], ov[3]); w[2] = cvtpk(ov[4], ov[5]); w[3] = cvtpk(ov[6], ov[7]);
          *(u32x4*)(p.U + row * BW + col) = w;
        }
      }
    }
    __syncthreads();
  }
}

__global__ void __launch_bounds__(512) mega(Params p) {
  extern __shared__ __attribute__((aligned(16))) char lds[];
  cg::grid_group grid = cg::this_grid();
  if (p.phase_lo < 0) grid.sync();
  volatile LAS unsigned* xst = (volatile LAS unsigned*)((LAS char*)lds + 131072);
  if (threadIdx.x < 4) xst[threadIdx.x] = 0u;
  __syncthreads();
  XcdBarrier xb = xcd_barrier_post(p.bar, xst);
  const int hi = p.phase_hi;
  if (hi >= 0) phase_prologue(p, lds);
  xcd_barrier(xb);
  if (hi >= 1) phase_gemm1(p, lds);
  xcd_barrier(xb);
  if (hi >= 2) phase_attn(p, lds);
  xcd_barrier(xb);
  if (hi >= 3) phase_gemm2(p, lds);
  xcd_barrier(xb);
  if (hi >= 4) phase_gemm3_final(p, lds, xb);
}

extern "C" void kernel_launch(void* const* d_in, const int* in_sizes, int n_in, void* d_out, int out_size, void* d_ws, size_t ws_size, hipStream_t stream) {
  static int grid_blocks = 0;
  if (!grid_blocks) {
    hipFuncSetAttribute((const void*)mega, hipFuncAttributeMaxDynamicSharedMemorySize, LDS_BYTES);
    int dev = 0, cus = 0, per_cu = 0;
    hipGetDevice(&dev);
    hipDeviceGetAttribute(&cus, hipDeviceAttributeMultiprocessorCount, dev);
    hipOccupancyMaxActiveBlocksPerMultiprocessor(&per_cu, mega, 512, LDS_BYTES);
    if (per_cu < 1) { fprintf(stderr, "occupancy query returned %d\n", per_cu); per_cu = 1; }
    grid_blocks = cus * per_cu;
    if (grid_blocks > 256) grid_blocks = 256;
    if (grid_blocks != 256) fprintf(stderr, "unexpected grid %d (need 256)\n", grid_blocks);
  }
  Params p{};
  p.x = (const float*)d_in[0]; p.norm_g = (const float*)d_in[1]; p.w_in = (const float*)d_in[2];
  p.lq1 = (const float*)d_in[3]; p.lk1 = (const float*)d_in[4]; p.lq2 = (const float*)d_in[5]; p.lk2 = (const float*)d_in[6];
  p.subln_g = (const float*)d_in[7]; p.qn_g = (const float*)d_in[8]; p.kn_g = (const float*)d_in[9];
  p.w_out_a = (const float*)d_in[10]; p.w_out_b = (const float*)d_in[11]; p.w_o = (const float*)d_in[12]; p.final_g = (const float*)d_in[13];
  p.out = (float*)d_out;
  char* w = (char*)d_ws; size_t off = 0;
  auto take = [&](size_t bytes) { char* r = w + off; off += (bytes + 255) & ~(size_t)255; return r; };
  p.h      = (bf16_t*)take((size_t)MTOK * DM * 2);
  p.o1     = (float*)p.h;
  p.merged = (bf16_t*)p.h;
  p.winT   = (bf16_t*)take((size_t)CT * DM * 2);
  p.waT    = (bf16_t*)take((size_t)DM * BW * 2);
  p.wbT    = (bf16_t*)take((size_t)DM * BW * 2);
  p.woT    = (bf16_t*)take((size_t)DM * DM * 2);
  p.proj   = (bf16_t*)take((size_t)MTOK * CT * 2);
  p.U      = (bf16_t*)d_out;
  p.gbuf   = (bf16_t*)take((size_t)2 * MTOK * DM * 2);
  p.rope   = (float2*)take((size_t)SEQ * 32 * 8);
  p.ssq    = (float*)take((size_t)MTOK * 32 * 4);
  p.bar    = (unsigned*)take(XCD_BAR_WORDS * 4);
  if (off > ws_size) { fprintf(stderr, "workspace too small: need %zu have %zu\n", off, ws_size); return; }
  if (grid_blocks != 256) return;
  p.phase_lo = 0; p.phase_hi = 5;
  hipMemsetAsync(p.bar, 0, XCD_BAR_WORDS * 4, stream);
  void* args[] = {&p};
  hipError_t e = hipLaunchCooperativeKernel((void*)mega, dim3(grid_blocks), dim3(512), args, LDS_BYTES, stream);
  if (e != hipSuccess) fprintf(stderr, "cooperative launch failed: %s (grid %d)\n", hipGetErrorString(e), grid_blocks);
}
```
